# Optimizing an MI355X kernel written in HIP

```python
import math
import jax, jax.numpy as jnp
from jax import lax
import numpy as np

D_MODEL = 1024
BATCH = 8
SEQ = 2048
DEPTH = 2

CTX_LEN = 256
GRID_W = 64
HEAD_DIM = 64
D_MIX = D_MODEL
NA_HEADS = D_MIX // (4 * HEAD_DIM)
NA_WIDTH = NA_HEADS * HEAD_DIM
CONV_CH = D_MIX // 4
WA_HEADS = D_MIX // (2 * HEAD_DIM)
WA_KV_HEADS = WA_HEADS // 4
WA_QW = WA_HEADS * HEAD_DIM
WA_KVW = WA_KV_HEADS * HEAD_DIM
NA_WIN_ROWS = 8
NA_WIN_COLS = 16
CONV_WIDTH = 3
WA_WINDOW = 128
WA_BLOCK = 128
FFN_DIM = 4 * D_MODEL
ROPE_BASE = 10000.0
EPS = 1e-6
NEG_INF = -1e30
IN_SPLITS = (NA_WIDTH, NA_WIDTH, NA_WIDTH, CONV_CH, CONV_CH, CONV_CH, WA_QW, WA_KVW, WA_KVW)
IN_OFF = tuple(int(v) for v in np.cumsum((0,) + IN_SPLITS))
IN_WIDTH = IN_OFF[-1]

kernel_name = "hymba_natten_shortconv_swa_prefix_dit"


def rms_norm(x, gain):
    x32 = x.astype(jnp.float32)
    y = x32 * lax.rsqrt(jnp.mean(x32 * x32, axis=-1, keepdims=True) + EPS)
    return (y * gain.astype(jnp.float32)).astype(x.dtype)


def split_heads(t, n_heads):
    return t.reshape(*t.shape[:-1], n_heads, HEAD_DIM)


def split_proj(p):
    return jnp.split(p, list(IN_OFF[1:-1]), axis=-1)


def modulation(cond, w, b):
    return jnp.split(jax.nn.silu(cond) @ w + b, 6, axis=-1)


def axial_rope(t, row_pos, col_pos):
    quarter = HEAD_DIM // 4
    half = HEAD_DIM // 2
    inv = ROPE_BASE ** (-jnp.arange(quarter, dtype=jnp.float32) / quarter)

    def rot(u, pos):
        ang = pos[:, None] * inv[None, :]
        cos = jnp.cos(ang)[None, :, None, :]
        sin = jnp.sin(ang)[None, :, None, :]
        u1, u2 = u[..., :quarter], u[..., quarter:]
        return jnp.concatenate([u1 * cos - u2 * sin, u2 * cos + u1 * sin], axis=-1)

    t32 = t.astype(jnp.float32)
    out = jnp.concatenate([rot(t32[..., :half], row_pos), rot(t32[..., half:], col_pos)], axis=-1)
    return out.astype(t.dtype)


def neighborhood_attention(q, k, v, k_ctx, v_ctx, rpb, rows):
    B, S, H, hd = q.shape
    kr = min(NA_WIN_ROWS, rows)
    kc = NA_WIN_COLS
    scale = hd ** -0.5
    qg = q.reshape(B, rows, GRID_W, H, hd)
    kg = k.reshape(B, rows, GRID_W, H, hd)
    vg = v.reshape(B, rows, GRID_W, H, hd)
    r = jnp.arange(rows)
    row_idx = jnp.clip(r - kr // 2, 0, rows - kr)[:, None] + jnp.arange(kr)[None, :]
    k_loc = jnp.take(kg, row_idx, axis=1)
    v_loc = jnp.take(vg, row_idx, axis=1)
    col = jnp.arange(GRID_W)
    col_start = jnp.clip(col - kc // 2, 0, GRID_W - kc)
    col_ok = (col[None, :] >= col_start[:, None]) & (col[None, :] < col_start[:, None] + kc)
    dr = row_idx - r[:, None] + (NA_WIN_ROWS - 1)
    dc = jnp.clip(col[None, :] - col[:, None], -(kc - 1), kc - 1) + (kc - 1)
    bias = rpb[:, dr[:, None, :, None], dc[None, :, None, :]]
    bias = jnp.transpose(bias, (1, 0, 2, 3, 4)).astype(jnp.float32)
    s_loc = jnp.einsum('brqhd,brjkhd->brhqjk', qg, k_loc).astype(jnp.float32) * scale + bias[None]
    s_loc = jnp.where(col_ok[:, None, :], s_loc, NEG_INF).reshape(B, rows, H, GRID_W, kr * GRID_W)
    s_ctx = jnp.einsum('brqhd,bchd->brhqc', qg, k_ctx).astype(jnp.float32) * scale
    p = jax.nn.softmax(jnp.concatenate([s_ctx, s_loc], axis=-1), axis=-1).astype(v.dtype)
    lc = k_ctx.shape[1]
    p_ctx = p[..., :lc]
    p_loc = p[..., lc:].reshape(B, rows, H, GRID_W, kr, GRID_W)
    out = (jnp.einsum('brhqc,bchd->brqhd', p_ctx, v_ctx)
           + jnp.einsum('brhqjk,brjkhd->brqhd', p_loc, v_loc))
    return out.reshape(B, S, H * hd)


def window_attention(q, k, v, k_ctx, v_ctx, sink):
    B, S, H, hd = q.shape
    kvh = k.shape[2]
    g = H // kvh
    nb = S // WA_BLOCK
    scale = hd ** -0.5
    qb = q.reshape(B, nb, WA_BLOCK, kvh, g, hd)

    def band(t):
        tp = jnp.pad(t, ((0, 0), (WA_BLOCK, WA_BLOCK), (0, 0), (0, 0))).reshape(B, nb + 2, WA_BLOCK, kvh, hd)
        return jnp.concatenate([tp[:, :-2], tp[:, 1:-1], tp[:, 2:]], axis=2)

    kb, vb = band(k), band(v)
    i = jnp.arange(WA_BLOCK)[:, None]
    j = jnp.arange(3 * WA_BLOCK)[None, :]
    kpos = (jnp.arange(nb) * WA_BLOCK - WA_BLOCK)[:, None, None] + j[None]
    mask = (jnp.abs(j - WA_BLOCK - i) <= WA_WINDOW)[None] & (kpos >= 0) & (kpos < S)
    s_loc = jnp.einsum('bnqkgd,bnjkd->bnkgqj', qb, kb).astype(jnp.float32) * scale
    s_loc = jnp.where(mask[None, :, None, None], s_loc, NEG_INF)
    s_ctx = jnp.einsum('bnqkgd,bckd->bnkgqc', qb, k_ctx).astype(jnp.float32) * scale
    s_sink = jnp.broadcast_to(sink.astype(jnp.float32).reshape(1, 1, kvh, g, 1, 1), s_ctx.shape[:-1] + (1,))
    p = jax.nn.softmax(jnp.concatenate([s_sink, s_ctx, s_loc], axis=-1), axis=-1).astype(v.dtype)
    lc = k_ctx.shape[1]
    out = (jnp.einsum('bnkgqc,bckd->bnqkgd', p[..., 1:1 + lc], v_ctx)
           + jnp.einsum('bnkgqj,bnjkd->bnqkgd', p[..., 1 + lc:], vb))
    return out.reshape(B, S, H * hd)


def context_attention(q, k, v, sink=None):
    B, L, H, hd = q.shape
    kvh = k.shape[2]
    g = H // kvh
    qg = q.reshape(B, L, kvh, g, hd)
    s = jnp.einsum('bqkgd,bckd->bkgqc', qg, k).astype(jnp.float32) * (hd ** -0.5)
    if sink is not None:
        s_sink = jnp.broadcast_to(sink.astype(jnp.float32).reshape(1, kvh, g, 1, 1), s.shape[:-1] + (1,))
        p = jax.nn.softmax(jnp.concatenate([s_sink, s], axis=-1), axis=-1)[..., 1:]
    else:
        p = jax.nn.softmax(s, axis=-1)
    out = jnp.einsum('bkgqc,bckd->bqkgd', p.astype(v.dtype), v)
    return out.reshape(B, L, H * hd)


def short_conv(u, w, b):
    pad = CONV_WIDTH // 2
    length = u.shape[1]
    up = jnp.pad(u, ((0, 0), (pad, pad), (0, 0)))
    y = b
    for tap in range(CONV_WIDTH):
        y = y + w[tap] * up[:, tap:tap + length]
    return y


def mix_out(o_na, o_cv, o_wa, g_out, w_o):
    o = jnp.concatenate([
        rms_norm(o_na, g_out[:NA_WIDTH]),
        rms_norm(o_cv, g_out[NA_WIDTH:NA_WIDTH + CONV_CH]),
        rms_norm(o_wa, g_out[NA_WIDTH + CONV_CH:]),
    ], axis=-1)
    return o @ w_o


def sq_relu_mlp(h, w1, w2):
    return jnp.square(jax.nn.relu(h @ w1)) @ w2


def setup_inputs(seed: int = 0) -> dict:
    key = jax.random.key(seed)
    ks = jax.random.split(key, 21)
    f32 = jnp.float32

    def nrm(k, shape, s):
        return jax.random.normal(k, shape, f32) * s

    return {
        "x": nrm(ks[0], (BATCH, SEQ, D_MODEL), 1.0),
        "c": nrm(ks[1], (BATCH, D_MODEL), 1.0),
        "ctx": nrm(ks[2], (BATCH, CTX_LEN, D_MODEL), 1.0),
        "c_ctx": nrm(ks[3], (D_MODEL,), 1.0),
        "w_mod": nrm(ks[4], (DEPTH, D_MODEL, 6 * D_MODEL), 0.5 * D_MODEL ** -0.5),
        "b_mod": nrm(ks[5], (DEPTH, 6 * D_MODEL), 0.02),
        "g_norm1": 1.0 + nrm(ks[6], (DEPTH, D_MODEL), 0.02),
        "g_norm2": 1.0 + nrm(ks[7], (DEPTH, D_MODEL), 0.02),
        "w_in": nrm(ks[8], (DEPTH, D_MODEL, IN_WIDTH), D_MODEL ** -0.5),
        "na_q_gain": 1.0 + nrm(ks[9], (DEPTH, HEAD_DIM), 0.02),
        "na_k_gain": 1.0 + nrm(ks[10], (DEPTH, HEAD_DIM), 0.02),
        "na_rpb": nrm(ks[11], (DEPTH, NA_HEADS, 2 * NA_WIN_ROWS - 1, 2 * NA_WIN_COLS - 1), 0.1),
        "conv_w": nrm(ks[12], (DEPTH, CONV_WIDTH, CONV_CH), CONV_WIDTH ** -0.5),
        "conv_bias": nrm(ks[13], (DEPTH, CONV_CH), 0.02),
        "wa_q_gain": 1.0 + nrm(ks[14], (DEPTH, HEAD_DIM), 0.02),
        "wa_k_gain": 1.0 + nrm(ks[15], (DEPTH, HEAD_DIM), 0.02),
        "wa_sink": nrm(ks[16], (DEPTH, WA_HEADS), 0.5),
        "g_out": 1.0 + nrm(ks[17], (DEPTH, D_MIX), 0.02),
        "w_o": nrm(ks[18], (DEPTH, D_MIX, D_MODEL), D_MIX ** -0.5),
        "w_fc1": nrm(ks[19], (DEPTH, D_MODEL, FFN_DIM), D_MODEL ** -0.5),
        "w_fc2": nrm(ks[20], (DEPTH, FFN_DIM, D_MODEL), FFN_DIM ** -0.5),
    }


def reference(x, c, ctx, c_ctx, w_mod, b_mod, g_norm1, g_norm2, w_in, na_q_gain, na_k_gain, na_rpb,
              conv_w, conv_bias, wa_q_gain, wa_k_gain, wa_sink, g_out, w_o, w_fc1, w_fc2):
    S = x.shape[1]
    rows = S // GRID_W
    t = jnp.arange(S)
    row_pos = (t // GRID_W).astype(jnp.float32)
    col_pos = (t % GRID_W).astype(jnp.float32)
    for l in range(DEPTH):
        last = l == DEPTH - 1
        sh1, sc1, gt1, sh2, sc2, gt2 = [m[:, None, :] for m in modulation(c, w_mod[l], b_mod[l])]
        csh1, csc1, cgt1, csh2, csc2, cgt2 = modulation(c_ctx, w_mod[l], b_mod[l])

        h = rms_norm(x, g_norm1[l]) * (1 + sc1) + sh1
        hc = rms_norm(ctx, g_norm1[l]) * (1 + csc1) + csh1
        na_q, na_k, na_v, cv_x, cv_b, cv_c, wa_q, wa_k, wa_v = split_proj(h @ w_in[l])
        if last:
            na_kc, na_vc, wa_kc, wa_vc = [hc @ w_in[l][:, IN_OFF[i]:IN_OFF[i + 1]] for i in (1, 2, 7, 8)]
        else:
            na_qc, na_kc, na_vc, cv_xc, cv_bc, cv_cc, wa_qc, wa_kc, wa_vc = split_proj(hc @ w_in[l])

        na_kc = rms_norm(split_heads(na_kc, NA_HEADS), na_k_gain[l])
        na_vc = split_heads(na_vc, NA_HEADS)
        wa_kc = rms_norm(split_heads(wa_kc, WA_KV_HEADS), wa_k_gain[l])
        wa_vc = split_heads(wa_vc, WA_KV_HEADS)

        o_na = neighborhood_attention(
            rms_norm(split_heads(na_q, NA_HEADS), na_q_gain[l]),
            rms_norm(split_heads(na_k, NA_HEADS), na_k_gain[l]),
            split_heads(na_v, NA_HEADS), na_kc, na_vc, na_rpb[l], rows)
        o_cv = cv_b * short_conv(cv_c * cv_x, conv_w[l], conv_bias[l])
        o_wa = window_attention(
            axial_rope(rms_norm(split_heads(wa_q, WA_HEADS), wa_q_gain[l]), row_pos, col_pos),
            axial_rope(rms_norm(split_heads(wa_k, WA_KV_HEADS), wa_k_gain[l]), row_pos, col_pos),
            split_heads(wa_v, WA_KV_HEADS), wa_kc, wa_vc, wa_sink[l])
        x = x + gt1 * mix_out(o_na, o_cv, o_wa, g_out[l], w_o[l])

        if not last:
            oc_na = context_attention(rms_norm(split_heads(na_qc, NA_HEADS), na_q_gain[l]), na_kc, na_vc)
            oc_cv = cv_bc * short_conv(cv_cc * cv_xc, conv_w[l], conv_bias[l])
            oc_wa = context_attention(rms_norm(split_heads(wa_qc, WA_HEADS), wa_q_gain[l]), wa_kc, wa_vc,
                                      wa_sink[l])
            ctx = ctx + cgt1 * mix_out(oc_na, oc_cv, oc_wa, g_out[l], w_o[l])

        x = x + gt2 * sq_relu_mlp(rms_norm(x, g_norm2[l]) * (1 + sc2) + sh2, w_fc1[l], w_fc2[l])
        if not last:
            ctx = ctx + cgt2 * sq_relu_mlp(rms_norm(ctx, g_norm2[l]) * (1 + csc2) + csh2, w_fc1[l], w_fc2[l])
    return x
```

```cpp
#include <hip/hip_runtime.h>
#include <cstdio>
#include <cstdint>
namespace pg8 {
#define PG8_LAS __attribute__((address_space(3)))
typedef unsigned short bf16_t;
typedef short bf16x8 __attribute__((ext_vector_type(8)));
typedef float f32x4 __attribute__((ext_vector_type(4)));
typedef unsigned u32x4 __attribute__((ext_vector_type(4)));
constexpr int BM = 256, BK = 64, HALF = 128, HTB = HALF * BK * 2  , STAGE_BYTES = 8 * HTB, NXCD = 8, WGM = 8;

__host__ __device__ __forceinline__ int lds_byte(int r, int c) { const int st = (r >> 4) * 2 + (c >> 5), rr = r & 15, cc = c & 31, ob = rr * 64 + cc * 2; return st * 1024 + (ob ^ (((ob >> 9) & 1) << 5)); }
__host__ __device__ __forceinline__ void stage_rc(int b, int& R, int& C) { const int st = b / 1024, sb = b % 1024, swz = sb ^ (((sb >> 9) & 1) << 5); R = (st >> 1) * 16 + swz / 64; C = (st & 1) * 32 + (swz % 64) / 2; }
__host__ __device__ __forceinline__ int perm32(int rho) { const int n = rho >> 4, i = rho & 15; return 8 * (i >> 2) + 4 * n + (i & 3); }

struct Unit { int pm, pn; };
struct Gemm { const bf16_t* A; const bf16_t* Bt; int M, N, K; };

struct StaticOrder {
    int nM, nN, nwg, G, c;
    __host__ __device__ void init(int M, int N, int G_, int c_) { nM = M / BM; nN = N / BM; nwg = nM * nN; G = G_; c = c_; }
    __host__ __device__ bool next(int i, Unit& u) const {
        const long L = (long)i * G + c; if (L >= nwg) return false;
        int wgid = (int)L; { const int q = nwg / NXCD, r = nwg % NXCD, xcd = wgid % NXCD, off = wgid / NXCD; wgid = (xcd < r ? xcd * (q + 1) : r * (q + 1) + (xcd - r) * q) + off; }
        const int nig = WGM * nN, gid = wgid / nig, fm = gid * WGM, gsz = (nM - fm) < WGM ? (nM - fm) : WGM;
        u.pm = fm + ((wgid % nig) % gsz); u.pn = (wgid % nig) / gsz; return true;
    }
    __device__ __forceinline__ void a_ready(const Unit&) const {}
    __device__ __forceinline__ void done(const Unit&) const {}
};
__device__ __forceinline__ unsigned cvt_pk_bf16(float lo, float hi) { unsigned r; asm volatile("v_cvt_pk_bf16_f32 %0, %1, %2" : "=v"(r) : "v"(lo), "v"(hi)); return r; }
typedef float f32x2 __attribute__((ext_vector_type(2)));
template <class Epi, class Sched, bool ALIGN_EPI = false, bool SP2 = false>
__device__ __forceinline__ void gemm_phase(PG8_LAS unsigned char* lds, const Gemm g, const Sched& S, const Epi& E) {
    int tid_ = threadIdx.x; asm volatile("" : "+v"(tid_));
    const int tid = tid_, wid = __builtin_amdgcn_readfirstlane(tid >> 6), lane = tid & 63, wr = wid >> 2, wc = wid & 3, fr = lane & 15, fq = lane >> 4;
    const int K = g.K, nt = K / BK;
    unsigned voffA[2], voffB[2];
#pragma unroll
    for (int i = 0; i < 2; ++i) { int R, C; stage_rc(tid * 16 + i * 8192, R, C); const int Rb = Epi::PERM ? ((R & ~31) + perm32(R & 31)) : R;
        voffA[i] = (unsigned)(R * K + C) * 2u; voffB[i] = (unsigned)(Rb * K + C) * 2u; }
    const size_t kstep = (size_t)(BK * 2);
    const size_t hstep = (size_t)HALF * K * 2;
    const size_t tstep = 2 * hstep;
    const unsigned ldsw = (unsigned)wid * 1024u;
    const int aoff = lds_byte(wr * 64 + fr, fq * 8), boff = lds_byte(wc * 32 + fr, fq * 8);
#define PG8_SA(b, h) (((b) * 2 + (h)) * HTB)
#define PG8_SB(b, h) ((4 + (b) * 2 + (h)) * HTB)
#define PG8_STAGE(bufoff, gbase, voff) do { _Pragma("unroll") for (int _i = 0; _i < 2; ++_i) \
        __builtin_amdgcn_global_load_lds((const unsigned*)((const char*)(gbase) + (voff)[_i]), (PG8_LAS unsigned*)(lds + (bufoff) + ldsw + _i * 8192), 16, 0, 0); } while (0)
#define PG8_LDA(dst, b, h) do { _Pragma("unroll") for (int m = 0; m < 4; ++m) _Pragma("unroll") for (int k = 0; k < 2; ++k) dst[m][k] = *(const PG8_LAS bf16x8*)(lds + PG8_SA(b, h) + aoff + m * 2048 + k * 1024); } while (0)
#define PG8_LDB(dst, b, h) do { _Pragma("unroll") for (int n = 0; n < 2; ++n) _Pragma("unroll") for (int k = 0; k < 2; ++k) dst[n][k] = *(const PG8_LAS bf16x8*)(lds + PG8_SB(b, h) + boff + n * 2048 + k * 1024); } while (0)
#define PG8_MMA(ai, bj, At, Bt) do { __builtin_amdgcn_s_setprio(1); _Pragma("unroll") for (int m = 0; m < 4; ++m) _Pragma("unroll") for (int n = 0; n < 2; ++n) _Pragma("unroll") for (int k = 0; k < 2; ++k) \
        acc[ai][bj][m][n] = __builtin_amdgcn_mfma_f32_16x16x32_bf16(Bt[n][k], At[m][k], acc[ai][bj][m][n], 0, 0, 0); __builtin_amdgcn_s_setprio(0); } while (0)
#define PG8_WAIT_V(n) asm volatile("s_waitcnt vmcnt(" #n ")" ::: "memory")
#define PG8_WAIT_L(n) asm volatile("s_waitcnt lgkmcnt(" #n ")" ::: "memory")
#define PG8_BAR __builtin_amdgcn_s_barrier()
#define PG8_SCHED __builtin_amdgcn_sched_barrier(0)
    Unit cur, nxt; int ui = 0;
    if (!S.next(0, cur)) return;
    f32x4 acc[2][2][4][2];
#pragma unroll
    for (int a = 0; a < 2; ++a)
#pragma unroll
        for (int b = 0; b < 2; ++b)
#pragma unroll
            for (int m = 0; m < 4; ++m)
#pragma unroll
                for (int n = 0; n < 2; ++n) acc[a][b][m][n] = (f32x4){0.f, 0.f, 0.f, 0.f};
    bf16x8 At[4][2], B0[2][2], B1[2][2];
    const char* cA = (const char*)g.A + (size_t)cur.pm * tstep; const char* cB = (const char*)g.Bt + (size_t)cur.pn * tstep;
    S.a_ready(cur);
    if constexpr (SP2) {
        PG8_STAGE(PG8_SB(0, 0), cB, voffB); PG8_STAGE(PG8_SB(0, 1), cB + hstep, voffB); PG8_STAGE(PG8_SA(0, 0), cA, voffA); PG8_STAGE(PG8_SA(0, 1), cA + hstep, voffA);
        if (wr == 1) PG8_BAR;
        PG8_WAIT_V(2); PG8_BAR;
        PG8_STAGE(PG8_SB(1, 0), cB + kstep, voffB); PG8_STAGE(PG8_SA(1, 0), cA + kstep, voffA); PG8_STAGE(PG8_SB(1, 1), cB + hstep + kstep, voffB);
        PG8_WAIT_V(6); PG8_BAR;
    } else {
        PG8_STAGE(PG8_SB(0, 0), cB, voffB); PG8_STAGE(PG8_SA(0, 0), cA, voffA); PG8_STAGE(PG8_SB(0, 1), cB + hstep, voffB); PG8_STAGE(PG8_SA(0, 1), cA + hstep, voffA);
        if (wr == 1) PG8_BAR;
        PG8_WAIT_V(4); PG8_BAR;
        PG8_STAGE(PG8_SB(1, 0), cB + kstep, voffB); PG8_STAGE(PG8_SA(1, 0), cA + kstep, voffA); PG8_STAGE(PG8_SB(1, 1), cB + hstep + kstep, voffB);
        PG8_WAIT_V(6); PG8_BAR;
    }
    for (;;) {
        const bool has_next = S.next(ui + 1, nxt);
        const char* nA = has_next ? (const char*)g.A + (size_t)nxt.pm * tstep : cA; const char* nB = has_next ? (const char*)g.Bt + (size_t)nxt.pn * tstep : cB;
        for (int t = 0; t < nt; t += 2) {
            const bool last = (t == nt - 2);
            const char* a1 = cA + (size_t)(t + 1) * kstep;
            const char* a2 = last ? nA : cA + (size_t)(t + 2) * kstep; const char* b2 = last ? nB : cB + (size_t)(t + 2) * kstep;
            const char* a3 = a2 + kstep; const char* b3 = b2 + kstep;
            if (last && has_next) S.a_ready(nxt);
            if constexpr (SP2) {
            PG8_LDB(B0, 0, 0); PG8_LDB(B1, 0, 1); PG8_SCHED; PG8_LDA(At, 0, 0); PG8_STAGE(PG8_SA(1, 1), a1 + hstep, voffA);
            PG8_WAIT_V(8); PG8_WAIT_L(0); PG8_BAR; PG8_MMA(0, 0, At, B0); PG8_MMA(0, 1, At, B1); PG8_BAR; PG8_SCHED;
            PG8_LDA(At, 0, 1); PG8_STAGE(PG8_SB(0, 0), b2, voffB); PG8_STAGE(PG8_SB(0, 1), b2 + hstep, voffB); PG8_STAGE(PG8_SA(0, 0), a2, voffA);
            PG8_WAIT_V(8); PG8_WAIT_L(0); PG8_BAR; PG8_MMA(1, 0, At, B0); PG8_MMA(1, 1, At, B1); PG8_BAR; PG8_SCHED;
            PG8_LDB(B0, 1, 0); PG8_LDB(B1, 1, 1); PG8_SCHED; PG8_LDA(At, 1, 0); PG8_STAGE(PG8_SA(0, 1), a2 + hstep, voffA);
            PG8_WAIT_V(8); PG8_WAIT_L(0); PG8_BAR; PG8_MMA(0, 0, At, B0); PG8_MMA(0, 1, At, B1); PG8_BAR; PG8_SCHED;
            PG8_LDA(At, 1, 1); PG8_STAGE(PG8_SB(1, 0), b3, voffB); PG8_STAGE(PG8_SB(1, 1), b3 + hstep, voffB); PG8_STAGE(PG8_SA(1, 0), a3, voffA);
            PG8_WAIT_V(8); PG8_WAIT_L(0); PG8_BAR; PG8_MMA(1, 0, At, B0); PG8_MMA(1, 1, At, B1); PG8_BAR; PG8_SCHED;
            } else {
            PG8_LDB(B0, 0, 0); PG8_SCHED; PG8_LDA(At, 0, 0); PG8_STAGE(PG8_SA(1, 1), a1 + hstep, voffA);
            PG8_WAIT_L(8); PG8_BAR; PG8_WAIT_L(0); PG8_MMA(0, 0, At, B0); PG8_BAR; PG8_SCHED;
            PG8_LDB(B1, 0, 1); PG8_STAGE(PG8_SB(0, 0), b2, voffB);
            PG8_BAR; PG8_WAIT_L(0); PG8_MMA(0, 1, At, B1); PG8_BAR;
            PG8_LDA(At, 0, 1); PG8_STAGE(PG8_SA(0, 0), a2, voffA);
            PG8_BAR; PG8_WAIT_L(0); PG8_MMA(1, 0, At, B0); PG8_BAR; PG8_SCHED;
            PG8_STAGE(PG8_SB(0, 1), b2 + hstep, voffB);
            PG8_WAIT_V(6); PG8_BAR; PG8_MMA(1, 1, At, B1); PG8_BAR;
            PG8_LDB(B0, 1, 0); PG8_SCHED; PG8_LDA(At, 1, 0); PG8_STAGE(PG8_SA(0, 1), a2 + hstep, voffA);
            PG8_WAIT_L(8); PG8_BAR; PG8_WAIT_L(0); PG8_MMA(0, 0, At, B0); PG8_BAR; PG8_SCHED;
            PG8_LDB(B1, 1, 1); PG8_STAGE(PG8_SB(1, 0), b3, voffB);
            PG8_BAR; PG8_WAIT_L(0); PG8_MMA(0, 1, At, B1); PG8_BAR;
            PG8_LDA(At, 1, 1); PG8_STAGE(PG8_SA(1, 0), a3, voffA);
            PG8_BAR; PG8_WAIT_L(0); PG8_MMA(1, 0, At, B0); PG8_BAR; PG8_SCHED;
            PG8_STAGE(PG8_SB(1, 1), b3 + hstep, voffB);
            PG8_WAIT_V(6); PG8_BAR; PG8_MMA(1, 1, At, B1); PG8_BAR;
            }
        }
        if constexpr (ALIGN_EPI) { if (wr == 0) PG8_BAR; }
        if constexpr (!Epi::AFTER_DRAIN) { E(acc, cur, wr, wc, fr, fq); S.done(cur); }
        if (!has_next) break;
#pragma unroll
        for (int a = 0; a < 2; ++a)
#pragma unroll
            for (int b = 0; b < 2; ++b)
#pragma unroll
                for (int m = 0; m < 4; ++m)
#pragma unroll
                    for (int n = 0; n < 2; ++n) acc[a][b][m][n] = (f32x4){0.f, 0.f, 0.f, 0.f};
        cur = nxt; cA = nA; cB = nB; ++ui;
        if constexpr (ALIGN_EPI) { if (wr == 1) PG8_BAR; }
    }
    PG8_WAIT_V(0);
    if constexpr (!ALIGN_EPI) { if (wr == 0) PG8_BAR; }
    PG8_BAR;
    if constexpr (Epi::AFTER_DRAIN) { E.fused(acc, cur, wr, wc, fr, fq, lds, wid, lane); S.done(cur); }
#undef PG8_SA
#undef PG8_SB
#undef PG8_STAGE
#undef PG8_LDA
#undef PG8_LDB
#undef PG8_MMA
#undef PG8_WAIT_V
#undef PG8_WAIT_L
#undef PG8_BAR
#undef PG8_SCHED
}
}

namespace pg8 {
typedef unsigned u32x2 __attribute__((ext_vector_type(2)));
template <int ACT> struct EpiStore {
    static constexpr bool PERM = true, AFTER_DRAIN = false;
    bf16_t* O; int ldc;
    __device__ __forceinline__ void operator()(const f32x4 (&acc)[2][2][4][2], const Unit& u, int wr, int wc, int fr, int fq) const {
        const int row0 = u.pm * BM + wr * 64 + fr, col0 = u.pn * BM + wc * 32 + 8 * fq;
#pragma unroll
        for (int ai = 0; ai < 2; ++ai)
#pragma unroll
            for (int m = 0; m < 4; ++m) { bf16_t* rowp = O + (size_t)(row0 + ai * HALF + m * 16) * ldc + col0;
#pragma unroll
                for (int bj = 0; bj < 2; ++bj) { f32x4 v0 = acc[ai][bj][m][0], v1 = acc[ai][bj][m][1];
                    if (ACT == 2) {
#pragma unroll
                        for (int e = 0; e < 4; ++e) { const float a = fmaxf(v0[e], 0.f), b = fmaxf(v1[e], 0.f); v0[e] = a * a; v1[e] = b * b; } }
                    u32x4 w; w.x = cvt_pk_bf16(v0[0], v0[1]); w.y = cvt_pk_bf16(v0[2], v0[3]); w.z = cvt_pk_bf16(v1[0], v1[1]); w.w = cvt_pk_bf16(v1[2], v1[3]);
                    *(u32x4*)(rowp + bj * HALF) = w; } }
    }
};


__device__ __forceinline__ float row_rstd(const float* rs, int row) {
    const f32x4* p = (const f32x4*)(rs + (size_t)row * 16); const f32x4 a = p[0], b = p[1], c = p[2], d = p[3];
    const float s = ((a[0] + a[1]) + (a[2] + a[3])) + ((b[0] + b[1]) + (b[2] + b[3])) + ((c[0] + c[1]) + (c[2] + c[3])) + ((d[0] + d[1]) + (d[2] + d[3]));
    return 1.0f / sqrtf(s * (1.0f / 1024.0f) + 1e-6f);
}
struct EpiFc1 {
    static constexpr bool PERM = true, AFTER_DRAIN = false;
    bf16_t* O; int ldc; const float* rs; const float* bias;
    __device__ __forceinline__ void operator()(const f32x4 (&acc)[2][2][4][2], const Unit& u, int wr, int wc, int fr_in, int fq_in) const {
        int fr = fr_in, fq = fq_in; asm volatile("" : "+v"(fr), "+v"(fq));
        const int row0 = u.pm * BM + wr * 64 + fr, col0 = u.pn * BM + wc * 32 + 8 * fq; const int b = (u.pm < 64) ? (u.pm >> 3) : 8;
        f32x4 bv[2][2];
#pragma unroll
        for (int bj = 0; bj < 2; ++bj)
#pragma unroll
            for (int n = 0; n < 2; ++n) bv[bj][n] = *(const f32x4*)(bias + (size_t)b * ldc + col0 + bj * HALF + 4 * n);
#pragma unroll
        for (int ai = 0; ai < 2; ++ai)
#pragma unroll
            for (int m = 0; m < 4; ++m) { const int row = row0 + ai * HALF + m * 16; const float rstd = row_rstd(rs, row); bf16_t* rowp = O + (size_t)row * ldc + col0;
#pragma unroll
                for (int bj = 0; bj < 2; ++bj) { f32x4 v0 = acc[ai][bj][m][0] * rstd + bv[bj][0], v1 = acc[ai][bj][m][1] * rstd + bv[bj][1];
#pragma unroll
                    for (int e = 0; e < 4; ++e) { const float a = fmaxf(v0[e], 0.f), c = fmaxf(v1[e], 0.f); v0[e] = a * a; v1[e] = c * c; }
                    u32x4 w; w.x = cvt_pk_bf16(v0[0], v0[1]); w.y = cvt_pk_bf16(v0[2], v0[3]); w.z = cvt_pk_bf16(v1[0], v1[1]); w.w = cvt_pk_bf16(v1[2], v1[3]);
                    *(u32x4*)(rowp + bj * HALF) = w; }
                asm volatile("" ::: "memory"); }
    }
};

struct EpiResid {
    static constexpr bool PERM = false, AFTER_DRAIN = false;
    const float* base_lat; const float* base_ctx; float* out_lat; float* out_ctx; const float* gate;
    bf16_t* aout; const float* gn; const float* scn; float* rsout;
    __device__ __forceinline__ void operator()(const f32x4 (&acc)[2][2][4][2], const Unit& u, int wr, int wc, int fr_in, int fq_in) const {
        int fr = fr_in, fq = fq_in; asm volatile("" : "+v"(fr), "+v"(fq));
        const bool lat = u.pm < 64;
        const int b = lat ? (u.pm >> 3) : 8;
        const size_t roff = (size_t)(lat ? u.pm : u.pm - 64) * BM * 1024;
        const float* base = (lat ? base_lat : base_ctx) + roff; float* out = (lat ? out_lat : out_ctx) + roff;
        const int col0 = u.pn * BM + wc * 32 + 4 * fq;
        f32x4 gv[2][2];
#pragma unroll
        for (int bj = 0; bj < 2; ++bj)
#pragma unroll
            for (int n = 0; n < 2; ++n) gv[bj][n] = *(const f32x4*)(gate + (size_t)b * 6144 + col0 + bj * HALF + n * 16);
        if (aout == nullptr) {
#pragma unroll
            for (int ai = 0; ai < 2; ++ai)
#pragma unroll
                for (int m = 0; m < 4; ++m) { const size_t off = (size_t)(ai * HALF + wr * 64 + m * 16 + fr) * 1024 + col0;
#pragma unroll
                    for (int bj = 0; bj < 2; ++bj)
#pragma unroll
                        for (int n = 0; n < 2; ++n) { const f32x4 bs = *(const f32x4*)(base + off + bj * HALF + n * 16);
                            *(f32x4*)(out + off + bj * HALF + n * 16) = bs + gv[bj][n] * acc[ai][bj][m][n]; }
                    asm volatile("" ::: "memory"); }
            return;
        }
        f32x4 Gv[2][2];
#pragma unroll
        for (int bj = 0; bj < 2; ++bj)
#pragma unroll
            for (int n = 0; n < 2; ++n) Gv[bj][n] = *(const f32x4*)(gn + col0 + bj * HALF + n * 16) * (*(const f32x4*)(scn + (size_t)b * 6144 + col0 + bj * HALF + n * 16) + 1.0f);
        const size_t grow0 = (size_t)u.pm * BM;
#pragma unroll
        for (int ai = 0; ai < 2; ++ai)
#pragma unroll
            for (int m = 0; m < 4; ++m) { const int rl = ai * HALF + wr * 64 + m * 16 + fr; const size_t off = (size_t)rl * 1024 + col0; float ss = 0.f;
                bf16_t* ap = aout + (grow0 + rl) * 1024 + col0;
#pragma unroll
                for (int bj = 0; bj < 2; ++bj)
#pragma unroll
                    for (int n = 0; n < 2; ++n) { const f32x4 bs = *(const f32x4*)(base + off + bj * HALF + n * 16);
                        const f32x4 x = bs + gv[bj][n] * acc[ai][bj][m][n];
                        *(f32x4*)(out + off + bj * HALF + n * 16) = x;
                        ss += (x[0] * x[0] + x[1] * x[1]) + (x[2] * x[2] + x[3] * x[3]);
                        const f32x4 y = x * Gv[bj][n]; u32x2 w; w.x = cvt_pk_bf16(y[0], y[1]); w.y = cvt_pk_bf16(y[2], y[3]);
                        *(u32x2*)(ap + bj * HALF + n * 16) = w; }
                ss += __shfl_xor(ss, 16); ss += __shfl_xor(ss, 32);
                if (fq == 0) rsout[(grow0 + rl) * 16 + u.pn * 4 + wc] = ss;
                asm volatile("" ::: "memory"); }
    }
};

struct EpiProj {
    static constexpr bool PERM = true, AFTER_DRAIN = false;
    bf16_t* O; const float* gains;
    const float* rs; const float* bias;
    __device__ __forceinline__ void operator()(const f32x4 (&acc)[2][2][4][2], const Unit& u, int wr, int wc, int fr_in, int fq_in) const {
        int fr = fr_in, fq = fq_in; asm volatile("" : "+v"(fr), "+v"(fq));
        const int pn = u.pn; const int row0 = u.pm * BM + wr * 64 + fr; const int b = (u.pm < 64) ? (u.pm >> 3) : 8;
        f32x4 bv[2][2];
#pragma unroll
        for (int bj = 0; bj < 2; ++bj)
#pragma unroll
            for (int n = 0; n < 2; ++n) bv[bj][n] = *(const f32x4*)(bias + (size_t)b * 2304 + pn * BM + bj * HALF + wc * 32 + 8 * fq + 4 * n);
        if (pn >= 2 && pn <= 5) {
            const int col0 = pn * BM + wc * 32 + 8 * fq;
#pragma unroll
            for (int ai = 0; ai < 2; ++ai)
#pragma unroll
                for (int m = 0; m < 4; ++m) { bf16_t* rowp = O + (size_t)(row0 + ai * HALF + m * 16) * 2304 + col0; const float rstd = row_rstd(rs, row0 + ai * HALF + m * 16);
#pragma unroll
                    for (int bj = 0; bj < 2; ++bj) { const f32x4 v0 = acc[ai][bj][m][0] * rstd + bv[bj][0], v1 = acc[ai][bj][m][1] * rstd + bv[bj][1];
                        u32x4 w; w.x = cvt_pk_bf16(v0[0], v0[1]); w.y = cvt_pk_bf16(v0[2], v0[3]); w.z = cvt_pk_bf16(v1[0], v1[1]); w.w = cvt_pk_bf16(v1[2], v1[3]);
                        *(u32x4*)(rowp + bj * HALF) = w; } }
            return;
        }
        const int colh = pn * BM + wc * 64 + 8 * fq;
        const bool vhead = (pn == 8) && (wc >= 2);
        if (vhead) {
#pragma unroll
            for (int ai = 0; ai < 2; ++ai)
#pragma unroll
                for (int m = 0; m < 4; ++m) { bf16_t* rowp = O + (size_t)(row0 + ai * HALF + m * 16) * 2304 + colh; const float rstd = row_rstd(rs, row0 + ai * HALF + m * 16);
#pragma unroll
                    for (int bj = 0; bj < 2; ++bj) { const f32x4 v0 = acc[ai][bj][m][0] * rstd + bv[bj][0], v1 = acc[ai][bj][m][1] * rstd + bv[bj][1];
                        u32x4 w; w.x = cvt_pk_bf16(v0[0], v0[1]); w.y = cvt_pk_bf16(v0[2], v0[3]); w.z = cvt_pk_bf16(v1[0], v1[1]); w.w = cvt_pk_bf16(v1[2], v1[3]);
                        *(u32x4*)(rowp + bj * 32) = w; } }
            return;
        }
        const float* gp = gains + 64 * ((pn == 0) ? 0 : (pn == 1) ? 1 : (pn == 8) ? 3 : 2);
        const float qs = (pn == 1 || pn == 8) ? 1.0f : 0.18033688011112042f;
        const bool rope = (pn >= 6) && (u.pm < 64);
        f32x4 gv[2][2];
#pragma unroll
        for (int bj = 0; bj < 2; ++bj)
#pragma unroll
            for (int n = 0; n < 2; ++n) gv[bj][n] = *(const f32x4*)(gp + 32 * bj + 16 * n + 4 * fq);
        float invrev[4];
#pragma unroll
        for (int e = 0; e < 4; ++e) invrev[e] = __builtin_amdgcn_exp2f(-(float)(4 * fq + e) * (13.287712379549449f / 16.0f)) * 0.15915494309189535f;
#pragma unroll
        for (int ai = 0; ai < 2; ++ai)
#pragma unroll
            for (int m = 0; m < 4; ++m) {
                const int row = row0 + ai * HALF + m * 16; const float rstd0 = row_rstd(rs, row);
                f32x4 v[2][2]; float ss = 0.f;
#pragma unroll
                for (int bj = 0; bj < 2; ++bj)
#pragma unroll
                    for (int n = 0; n < 2; ++n) v[bj][n] = acc[ai][bj][m][n] * rstd0 + bv[bj][n];
                asm volatile("" : "+v"(v[0][0]), "+v"(v[0][1]), "+v"(v[1][0]), "+v"(v[1][1]));
#pragma unroll
                for (int bj = 0; bj < 2; ++bj)
#pragma unroll
                    for (int n = 0; n < 2; ++n) { const f32x4 x = v[bj][n]; ss += (x[0] * x[0] + x[1] * x[1]) + (x[2] * x[2] + x[3] * x[3]); }
                ss += __shfl_xor(ss, 16); ss += __shfl_xor(ss, 32);
                const float rstd = 1.0f / sqrtf(ss * (1.0f / 64.0f) + 1e-6f);
#pragma unroll
                for (int bj = 0; bj < 2; ++bj)
#pragma unroll
                    for (int n = 0; n < 2; ++n) v[bj][n] = v[bj][n] * rstd * gv[bj][n];
                if (rope) {
                    const int t = row & 2047;
#pragma unroll
                    for (int bj = 0; bj < 2; ++bj) { const float pos = (float)(bj == 0 ? (t >> 6) : (t & 63));
#pragma unroll
                        for (int e = 0; e < 4; ++e) { float rev = pos * invrev[e]; rev = rev - floorf(rev);
                            const float cs = __builtin_amdgcn_cosf(rev), sn = __builtin_amdgcn_sinf(rev);
                            const float u1 = v[bj][0][e], u2 = v[bj][1][e];
                            v[bj][0][e] = u1 * cs - u2 * sn; v[bj][1][e] = u2 * cs + u1 * sn; } }
                }
                bf16_t* rowp = O + (size_t)row * 2304 + colh;
#pragma unroll
                for (int bj = 0; bj < 2; ++bj) { const f32x4 v0 = v[bj][0] * qs, v1 = v[bj][1] * qs;
                    u32x4 w; w.x = cvt_pk_bf16(v0[0], v0[1]); w.y = cvt_pk_bf16(v0[2], v0[3]); w.z = cvt_pk_bf16(v1[0], v1[1]); w.w = cvt_pk_bf16(v1[2], v1[3]);
                    *(u32x4*)(rowp + bj * 32) = w; }
                asm volatile("" ::: "memory");
            }
    }
};
}

#define LAS __attribute__((address_space(3)))
typedef unsigned short bf16_t;
typedef short bf16x8 __attribute__((ext_vector_type(8)));
typedef short s16x4 __attribute__((ext_vector_type(4)));
typedef float f32x16 __attribute__((ext_vector_type(16)));
typedef float f32x4 __attribute__((ext_vector_type(4)));
typedef unsigned u32x4 __attribute__((ext_vector_type(4)));
typedef unsigned u32x2 __attribute__((ext_vector_type(2)));

constexpr int DM = 1024, NB = 8, SEQ = 2048, CTXL = 256, FFN = 4096, INW = 2304;
constexpr int MLAT = NB * SEQ, MCTX = NB * CTXL, MALL = MLAT + MCTX;
constexpr float EPSN = 1e-6f, LOG2E = 1.4426950408889634f, NEGBIG = -1e30f;
constexpr int MODW = 6 * DM;
constexpr size_t MiB = (size_t)1 << 20;
constexpr size_t WS_MOD = 0;
constexpr size_t WS_GAIN = 512 * 1024;
constexpr size_t WS_BAR = 768 * 1024;
constexpr size_t WS_WIN = 1 * MiB;
constexpr size_t WS_WO = 10 * MiB;
constexpr size_t WS_W1 = 14 * MiB;
constexpr size_t WS_W2 = 30 * MiB;
constexpr size_t WS_CTX = 46 * MiB;
constexpr size_t WS_HN2 = 54 * MiB;
constexpr size_t WS_HN = 207 * MiB;
constexpr size_t WS_H1 = 90 * MiB;
constexpr size_t WS_PROJ = 90 * MiB;
constexpr size_t WS_OB = 171 * MiB;
constexpr size_t WS_RS1 = 243 * MiB;
constexpr size_t WS_RS2 = 245 * MiB;
constexpr size_t WS_BIN = 247 * MiB;
constexpr size_t WS_B1 = 248 * MiB;
constexpr size_t WS_END = 249 * MiB;

__device__ __forceinline__ float wave_sum(float v) {
#pragma unroll
    for (int o = 1; o < 64; o <<= 1) v += __shfl_xor(v, o);
    return v;
}
__device__ __forceinline__ float half_sum(float v) {
#pragma unroll
    for (int o = 1; o < 32; o <<= 1) v += __shfl_xor(v, o);
    return v;
}
__device__ __forceinline__ unsigned f2bf(float f) { unsigned u = __builtin_bit_cast(unsigned, f); return (u + 0x7fffu + ((u >> 16) & 1u)) >> 16; }
__device__ __forceinline__ unsigned pk2(float lo, float hi) { return f2bf(lo) | (f2bf(hi) << 16); }
__device__ __forceinline__ float bf_lo(unsigned u) { return __builtin_bit_cast(float, u << 16); }
__device__ __forceinline__ float bf_hi(unsigned u) { return __builtin_bit_cast(float, u & 0xffff0000u); }

namespace att {
constexpr int KROWB = 144, VROWB = 128, WL_V = 64 * KROWB, WL_A = WL_V + 64 * VROWB, WL_TAB = WL_A + 128 + 192, WAVE_LDS = WL_TAB + 15 * 32 * 4;
typedef float f32x2_t __attribute__((ext_vector_type(2))); typedef __bf16 bf16x2_t __attribute__((ext_vector_type(2)));
typedef short v4i16_t __attribute__((ext_vector_type(4)));
__device__ __forceinline__ unsigned cvtpk(float lo, float hi) { f32x2_t v = {lo, hi}; bf16x2_t b = __builtin_convertvector(v, bf16x2_t); return __builtin_bit_cast(unsigned, b); }
__device__ __forceinline__ s16x4 vtr(LAS const unsigned char* p) { return __builtin_bit_cast(s16x4, __builtin_amdgcn_ds_read_tr16_b64_v4i16((LAS v4i16_t*)p)); }
struct AU { int qrow0, qcol, kcol, vcol, ocol, ctxrow0, nloc, locrow0, a0, a1; float m0, l0; const float* rpb; };
template <int KIND> __device__ __forceinline__ void attn_unit(LAS unsigned char* wl, const bf16_t* __restrict__ proj, bf16_t* __restrict__ obuf, const AU u, const int lane) {
    const int r32 = lane & 31, hi = lane >> 5;
    LAS float* sc = (LAS float*)(wl + WL_A);
    LAS float* tab = (LAS float*)(wl + WL_TAB);
    bf16x8 qr[4];
    { const bf16_t* qp = proj + (size_t)(u.qrow0 + r32) * INW + u.qcol + hi * 8;
#pragma unroll
      for (int d0 = 0; d0 < 4; ++d0) qr[d0] = *(const bf16x8*)(qp + d0 * 16); }
    if (KIND == 0) { for (int i = lane; i < 15 * 31; i += 64) { const int a = i / 31, b = i - a * 31; tab[a * 32 + b] = u.rpb[i] * LOG2E; } }
    f32x16 o0, o1;
#pragma unroll
    for (int r = 0; r < 16; ++r) { o0[r] = 0.f; o1[r] = 0.f; }
    float m = u.m0, l = (hi == 0) ? u.l0 : 0.f;
    const int nt = 4 + u.nloc;
    const int lrow = lane >> 3, lch = lane & 7;
    u32x4 kreg[8], vreg[8];
#define ATT_LOAD_TILE(t) do { const int row0_ = ((t) < 4) ? u.ctxrow0 + 64 * (t) : u.locrow0 + 64 * ((t) - 4); const bf16_t* bp_ = proj + (size_t)(row0_ + lrow) * INW + lch * 8; \
        _Pragma("unroll") for (int i_ = 0; i_ < 8; ++i_) { kreg[i_] = *(const u32x4*)(bp_ + (size_t)i_ * 8 * INW + u.kcol); vreg[i_] = *(const u32x4*)(bp_ + (size_t)i_ * 8 * INW + u.vcol); } } while (0)
    ATT_LOAD_TILE(0);
    LAS unsigned char* kw = wl + lrow * KROWB + lch * 16;
    LAS unsigned char* vw = wl + WL_V + lrow * VROWB + lch * 16;
    LAS const unsigned char* kf = wl + r32 * KROWB + hi * 16;
    LAS const unsigned char* vf = wl + WL_V + (4 * hi + ((lane & 15) >> 2)) * VROWB + ((lane >> 4) & 1) * 32 + (lane & 3) * 8;
    for (int t = 0; t < nt; ++t) {
#pragma unroll
        for (int i = 0; i < 8; ++i) { *(LAS u32x4*)(kw + i * 8 * KROWB) = kreg[i]; *(LAS u32x4*)(vw + i * 8 * VROWB) = vreg[i]; }
        if (t + 1 < nt) ATT_LOAD_TILE(t + 1);
        f32x16 p0, p1;
#pragma unroll
        for (int r = 0; r < 16; ++r) { p0[r] = 0.f; p1[r] = 0.f; }
#pragma unroll
        for (int d0 = 0; d0 < 4; ++d0) {
            const bf16x8 a0 = *(LAS const bf16x8*)(kf + d0 * 32), a1 = *(LAS const bf16x8*)(kf + 32 * KROWB + d0 * 32);
            p0 = __builtin_amdgcn_mfma_f32_32x32x16_bf16(a0, qr[d0], p0, 0, 0, 0);
            p1 = __builtin_amdgcn_mfma_f32_32x32x16_bf16(a1, qr[d0], p1, 0, 0, 0);
        }
        if (KIND == 0) { if (t >= 4) {
            const int dr = u.a0 + (t - 4), qc = u.a1 + r32; const int cs = min(max(qc - 8, 0), 48);
            const int kb = 4 * hi - cs; LAS const float* tb = tab + dr * 32 + 15 - qc + 4 * hi;
#pragma unroll
            for (int r = 0; r < 16; ++r) { const int kc = (r & 3) + 8 * (r >> 2);
                p0[r] = ((unsigned)(kb + kc) < 16u) ? p0[r] + tb[kc] : NEGBIG;
                p1[r] = ((unsigned)(kb + kc + 32) < 16u) ? p1[r] + tb[kc + 32] : NEGBIG; } } }
        if (KIND == 1) { if (t >= 4) {
            const int d0_ = u.a0 + 64 * (t - 4) + 4 * hi - r32 + 128;
#pragma unroll
            for (int r = 0; r < 16; ++r) { const int kc = (r & 3) + 8 * (r >> 2);
                p0[r] = ((unsigned)(d0_ + kc) <= 256u) ? p0[r] : NEGBIG;
                p1[r] = ((unsigned)(d0_ + kc + 32) <= 256u) ? p1[r] : NEGBIG; } } }
        float mx = fmaxf(p0[0], p1[0]);
#pragma unroll
        for (int r = 1; r < 16; ++r) mx = fmaxf(mx, fmaxf(p0[r], p1[r]));
        mx = fmaxf(mx, __shfl_xor(mx, 32));
        const float mnew = fmaxf(m, mx); const float alpha = __builtin_amdgcn_exp2f(m - mnew); m = mnew;
        float rs = 0.f;
#pragma unroll
        for (int r = 0; r < 16; ++r) { p0[r] = __builtin_amdgcn_exp2f(p0[r] - mnew); p1[r] = __builtin_amdgcn_exp2f(p1[r] - mnew); rs += p0[r] + p1[r]; }
        l = l * alpha + rs;
        if (hi == 0) sc[r32] = alpha;
#pragma unroll
        for (int g = 0; g < 4; ++g) { const f32x4 a = *(LAS const f32x4*)(sc + 8 * g + 4 * hi);
#pragma unroll
            for (int i = 0; i < 4; ++i) { o0[4 * g + i] *= a[i]; o1[4 * g + i] *= a[i]; } }
        u32x4 pa[4];
#pragma unroll
        for (int j = 0; j < 4; ++j) { pa[0][j] = cvtpk(p0[2 * j], p0[2 * j + 1]); pa[1][j] = cvtpk(p0[8 + 2 * j], p0[8 + 2 * j + 1]); pa[2][j] = cvtpk(p1[2 * j], p1[2 * j + 1]); pa[3][j] = cvtpk(p1[8 + 2 * j], p1[8 + 2 * j + 1]); }
#pragma unroll
        for (int ks = 0; ks < 4; ++ks) {
            const s16x4 l0 = vtr(vf + ks * 16 * VROWB), h0 = vtr(vf + ks * 16 * VROWB + 8 * VROWB);
            const s16x4 l1 = vtr(vf + ks * 16 * VROWB + 64), h1 = vtr(vf + ks * 16 * VROWB + 8 * VROWB + 64);
            const bf16x8 b0 = (bf16x8){l0[0], l0[1], l0[2], l0[3], h0[0], h0[1], h0[2], h0[3]}, b1 = (bf16x8){l1[0], l1[1], l1[2], l1[3], h1[0], h1[1], h1[2], h1[3]};
            o0 = __builtin_amdgcn_mfma_f32_32x32x16_bf16(__builtin_bit_cast(bf16x8, pa[ks]), b0, o0, 0, 0, 0);
            o1 = __builtin_amdgcn_mfma_f32_32x32x16_bf16(__builtin_bit_cast(bf16x8, pa[ks]), b1, o1, 0, 0, 0);
        }
    }
#undef ATT_LOAD_TILE
    const float lt = l + __shfl_xor(l, 32);
    if (hi == 0) sc[r32] = 1.0f / lt;
    bf16_t* ob = obuf + (size_t)u.qrow0 * DM + u.ocol + r32;
#pragma unroll
    for (int g = 0; g < 4; ++g) { const f32x4 a = *(LAS const f32x4*)(sc + 8 * g + 4 * hi);
#pragma unroll
        for (int i = 0; i < 4; ++i) { const int q = i + 8 * g + 4 * hi; bf16_t* op = ob + (size_t)q * DM;
            op[0] = (bf16_t)f2bf(o0[4 * g + i] * a[i]); op[32] = (bf16_t)f2bf(o1[4 * g + i] * a[i]); } }
}

__device__ __forceinline__ void attn_phase(LAS unsigned char* wl, const bf16_t* proj, bf16_t* obuf, const float* rpb_l, const float* sink_l, bool with_ctx, int gw, int ngw, int lane) {
    const int total = 2048 + 4096 + (with_ctx ? 768 : 0);
    for (int i0 = gw; i0 < total; i0 += ngw) {
        int i = i0; AU u;
        if (i < 2048) {
            const int half = i & 1, h = (i >> 1) & 3, r = (i >> 3) & 31, b = i >> 8; const int rs = min(max(r - 4, 0), 24);
            u.qrow0 = b * SEQ + r * 64 + 32 * half; u.qcol = 64 * h; u.kcol = 256 + 64 * h; u.vcol = 512 + 64 * h; u.ocol = 64 * h; u.ctxrow0 = MLAT + b * CTXL;
            u.nloc = 8; u.locrow0 = b * SEQ + rs * 64; u.a0 = rs - r + 7; u.a1 = 32 * half; u.m0 = NEGBIG; u.l0 = 0.f; u.rpb = rpb_l + h * (15 * 31);
            attn_unit<0>(wl, proj, obuf, u, lane);
            continue;
        }
        i -= 2048;
        if (i < 4096) {
            const int ch = i & 63, h = (i >> 6) & 7, b = i >> 9; const int qpos0 = 32 * ch;
            const int kt0 = max(0, (qpos0 - 128) >> 6), kt1 = min(31, (qpos0 + 159) >> 6);
            u.qrow0 = b * SEQ + qpos0; u.qcol = 1536 + 64 * h; u.kcol = 2048 + 64 * (h >> 2); u.vcol = 2176 + 64 * (h >> 2); u.ocol = 512 + 64 * h; u.ctxrow0 = MLAT + b * CTXL;
            u.nloc = kt1 - kt0 + 1; u.locrow0 = b * SEQ + 64 * kt0; u.a0 = 64 * kt0 - qpos0; u.a1 = 0; u.m0 = sink_l[h] * LOG2E; u.l0 = 1.f; u.rpb = nullptr;
            attn_unit<1>(wl, proj, obuf, u, lane);
            continue;
        }
        i -= 4096;
        if (i < 256) {
            const int ch = i & 7, h = (i >> 3) & 3, b = i >> 5;
            u.qrow0 = MLAT + b * CTXL + 32 * ch; u.qcol = 64 * h; u.kcol = 256 + 64 * h; u.vcol = 512 + 64 * h; u.ocol = 64 * h; u.m0 = NEGBIG; u.l0 = 0.f; u.ctxrow0 = MLAT + b * CTXL;
        } else {
            i -= 256; const int ch = i & 7, h = (i >> 3) & 7, b = i >> 6;
            u.qrow0 = MLAT + b * CTXL + 32 * ch; u.qcol = 1536 + 64 * h; u.kcol = 2048 + 64 * (h >> 2); u.vcol = 2176 + 64 * (h >> 2); u.ocol = 512 + 64 * h; u.m0 = sink_l[h] * LOG2E; u.l0 = 1.f; u.ctxrow0 = MLAT + b * CTXL;
        }
        u.nloc = 0; u.locrow0 = 0; u.a0 = 0; u.a1 = 0; u.rpb = nullptr;
        attn_unit<2>(wl, proj, obuf, u, lane);
    }
}
}

__device__ __forceinline__ void prep_pass(const float* xlat, const float* xctx, const float* g, const float* modl, int scoff, bf16_t* hn, float* rs, int gw, int ngw, int lane) {
    for (int m = gw; m < MALL; m += ngw) {
        const bool lat = m < MLAT; const float* xr = lat ? xlat + (size_t)m * DM : xctx + (size_t)(m - MLAT) * DM; const int b = lat ? (m >> 11) : 8;
        f32x4 v[4]; float ss = 0.f;
#pragma unroll
        for (int j = 0; j < 4; ++j) { v[j] = *(const f32x4*)(xr + 4 * lane + 256 * j); ss += (v[j][0] * v[j][0] + v[j][1] * v[j][1]) + (v[j][2] * v[j][2] + v[j][3] * v[j][3]); }
        ss = wave_sum(ss);
        if (lane < 16) rs[(size_t)m * 16 + lane] = (lane == 0) ? ss : 0.f;
        const float* mb = modl + (size_t)b * MODW;
#pragma unroll
        for (int j = 0; j < 4; ++j) { const int c = 4 * lane + 256 * j;
            const f32x4 gg = *(const f32x4*)(g + c), scv = *(const f32x4*)(mb + scoff + c);
            const f32x4 y = v[j] * gg * (scv + 1.0f);
            u32x2 w; w.x = pk2(y[0], y[1]); w.y = pk2(y[2], y[3]);
            *(u32x2*)(hn + (size_t)m * DM + c) = w; }
    }
}
__device__ __forceinline__ void bias_cols(const bf16_t* Wt, int N, const float* modl, int shoff, float* bias, int gw, int ngw, int lane) {
    for (int n = gw; n < N; n += ngw) {
        const u32x4 w0 = *(const u32x4*)(Wt + (size_t)n * DM + 16 * lane), w1 = *(const u32x4*)(Wt + (size_t)n * DM + 16 * lane + 8);
        float wf[16];
#pragma unroll
        for (int j = 0; j < 4; ++j) { wf[2 * j] = bf_lo(w0[j]); wf[2 * j + 1] = bf_hi(w0[j]); wf[8 + 2 * j] = bf_lo(w1[j]); wf[8 + 2 * j + 1] = bf_hi(w1[j]); }
#pragma unroll 1
        for (int b = 0; b < 9; ++b) { const float* sp = modl + (size_t)b * MODW + shoff + 16 * lane; float s = 0.f;
#pragma unroll
            for (int j = 0; j < 4; ++j) { const f32x4 x = *(const f32x4*)(sp + 4 * j); s += (x[0] * wf[4 * j] + x[1] * wf[4 * j + 1]) + (x[2] * wf[4 * j + 2] + x[3] * wf[4 * j + 3]); }
            s = wave_sum(s);
            if (lane == 0) bias[(size_t)b * N + n] = s; }
    }
}

__device__ __forceinline__ void mix_pass(const bf16_t* proj, const bf16_t* obuf, const float* convw, const float* convb, const float* gout, bf16_t* abuf, int nrows, int gw, int ngw, int lane) {
    for (int m = gw; m < nrows; m += ngw) {
        float va[8];
        if (lane < 32) {
            const u32x4 raw = *(const u32x4*)(obuf + (size_t)m * DM + 8 * lane);
#pragma unroll
            for (int j = 0; j < 4; ++j) { va[2 * j] = bf_lo(raw[j]); va[2 * j + 1] = bf_hi(raw[j]); }
        } else {
            const int c = 8 * (lane - 32); const bool lat = m < MLAT; const int t = lat ? (m & (SEQ - 1)) : ((m - MLAT) & (CTXL - 1)); const int L = lat ? SEQ : CTXL;
            const bf16_t* pr = proj + (size_t)m * INW;
            const u32x4 cx = *(const u32x4*)(pr + 768 + c), cb = *(const u32x4*)(pr + 1024 + c), cc = *(const u32x4*)(pr + 1280 + c);
            u32x4 pxm = {0u, 0u, 0u, 0u}, pcm = {0u, 0u, 0u, 0u}, pxp = {0u, 0u, 0u, 0u}, pcp = {0u, 0u, 0u, 0u};
            if (t > 0) { pxm = *(const u32x4*)(pr - INW + 768 + c); pcm = *(const u32x4*)(pr - INW + 1280 + c); }
            if (t < L - 1) { pxp = *(const u32x4*)(pr + INW + 768 + c); pcp = *(const u32x4*)(pr + INW + 1280 + c); }
            const f32x4 w0a = *(const f32x4*)(convw + c), w0b = *(const f32x4*)(convw + c + 4), w1a = *(const f32x4*)(convw + 256 + c), w1b = *(const f32x4*)(convw + 256 + c + 4),
                        w2a = *(const f32x4*)(convw + 512 + c), w2b = *(const f32x4*)(convw + 512 + c + 4), bba = *(const f32x4*)(convb + c), bbb = *(const f32x4*)(convb + c + 4);
#pragma unroll
            for (int j = 0; j < 4; ++j) {
                const float w0l = j < 2 ? w0a[2 * j] : w0b[2 * j - 4], w0h = j < 2 ? w0a[2 * j + 1] : w0b[2 * j - 3];
                const float w1l = j < 2 ? w1a[2 * j] : w1b[2 * j - 4], w1h = j < 2 ? w1a[2 * j + 1] : w1b[2 * j - 3];
                const float w2l = j < 2 ? w2a[2 * j] : w2b[2 * j - 4], w2h = j < 2 ? w2a[2 * j + 1] : w2b[2 * j - 3];
                const float bl = j < 2 ? bba[2 * j] : bbb[2 * j - 4], bh = j < 2 ? bba[2 * j + 1] : bbb[2 * j - 3];
                const float ul = bf_lo(cc[j]) * bf_lo(cx[j]), uh = bf_hi(cc[j]) * bf_hi(cx[j]);
                const float uml = bf_lo(pcm[j]) * bf_lo(pxm[j]), umh = bf_hi(pcm[j]) * bf_hi(pxm[j]);
                const float upl = bf_lo(pcp[j]) * bf_lo(pxp[j]), uph = bf_hi(pcp[j]) * bf_hi(pxp[j]);
                va[2 * j] = bf_lo(cb[j]) * (bl + w0l * uml + w1l * ul + w2l * upl);
                va[2 * j + 1] = bf_hi(cb[j]) * (bh + w0h * umh + w1h * uh + w2h * uph);
            }
        }
        float ssa = 0.f;
#pragma unroll
        for (int j = 0; j < 8; ++j) ssa += va[j] * va[j];
        ssa = half_sum(ssa); const float rsa = 1.0f / sqrtf(ssa * (1.0f / 256.0f) + EPSN);
        { const f32x4 g0 = *(const f32x4*)(gout + 8 * lane), g1 = *(const f32x4*)(gout + 8 * lane + 4);
          u32x4 w; w.x = pk2(va[0] * rsa * g0[0], va[1] * rsa * g0[1]); w.y = pk2(va[2] * rsa * g0[2], va[3] * rsa * g0[3]); w.z = pk2(va[4] * rsa * g1[0], va[5] * rsa * g1[1]); w.w = pk2(va[6] * rsa * g1[2], va[7] * rsa * g1[3]);
          *(u32x4*)(abuf + (size_t)m * DM + 8 * lane) = w; }
        float vb[8];
        { const u32x4 raw = *(const u32x4*)(obuf + (size_t)m * DM + 512 + 8 * lane);
#pragma unroll
          for (int j = 0; j < 4; ++j) { vb[2 * j] = bf_lo(raw[j]); vb[2 * j + 1] = bf_hi(raw[j]); } }
        float ssb = 0.f;
#pragma unroll
        for (int j = 0; j < 8; ++j) ssb += vb[j] * vb[j];
        ssb = wave_sum(ssb); const float rsb = 1.0f / sqrtf(ssb * (1.0f / 512.0f) + EPSN);
        { const f32x4 g0 = *(const f32x4*)(gout + 512 + 8 * lane), g1 = *(const f32x4*)(gout + 512 + 8 * lane + 4);
          u32x4 w; w.x = pk2(vb[0] * rsb * g0[0], vb[1] * rsb * g0[1]); w.y = pk2(vb[2] * rsb * g0[2], vb[3] * rsb * g0[3]); w.z = pk2(vb[4] * rsb * g1[0], vb[5] * rsb * g1[1]); w.w = pk2(vb[6] * rsb * g1[2], vb[7] * rsb * g1[3]);
          *(u32x4*)(abuf + (size_t)m * DM + 512 + 8 * lane) = w; }
    }
}

__device__ __forceinline__ void mod_item(int item, const float* c, const float* cctx, const float* wmod, const float* bmod, float* mod, LAS unsigned char* lds, int tid, int wave, int lane) {
    LAS float* sl = (LAS float*)lds;
    LAS float* red = (LAS float*)(lds + 9 * 1024 * 4);
    const int l = item / 96, n0 = (item % 96) * 64;
    for (int i = tid; i < 9 * 1024; i += 512) { const int r = i >> 10, k = i & 1023; const float v = r < 8 ? c[r * 1024 + k] : cctx[k]; sl[i] = v / (1.0f + __expf(-v)); }
    __syncthreads();
    float acc[9];
#pragma unroll
    for (int r = 0; r < 9; ++r) acc[r] = 0.f;
    const float* wp = wmod + ((size_t)l * 1024 + wave * 128) * MODW + n0 + lane;
#pragma unroll 8
    for (int k = 0; k < 128; ++k) { const float wv = wp[(size_t)k * MODW];
#pragma unroll
        for (int r = 0; r < 9; ++r) acc[r] += sl[r * 1024 + wave * 128 + k] * wv; }
#pragma unroll
    for (int r = 0; r < 9; ++r) red[(wave * 9 + r) * 64 + lane] = acc[r];
    __syncthreads();
    for (int i = tid; i < 9 * 64; i += 512) { const int r = i >> 6, ln = i & 63; float s = bmod[l * MODW + n0 + ln];
#pragma unroll
        for (int w = 0; w < 8; ++w) s += red[(w * 9 + r) * 64 + ln];
        mod[((size_t)l * 9 + r) * MODW + n0 + ln] = s; }
    __syncthreads();
}
__device__ __forceinline__ int rowmap_in(int c) {
    const int pn = c >> 8; if (pn >= 2 && pn <= 5) return c;
    const int wc = (c >> 6) & 3, d = c & 63, bj = d >> 5; const bool vhead = (pn == 8) && (wc >= 2);
    int n, fq; const int e = d & 3;
    if (!vhead) { n = (d >> 4) & 1; fq = (d >> 2) & 3; } else { fq = (d >> 3) & 3; n = (d >> 2) & 1; }
    return pn * 256 + bj * 128 + wc * 32 + fq * 8 + n * 4 + e;
}
template <bool MAPIN> __device__ __forceinline__ void transpose_item(const float* W, int K, int N, bf16_t* WT, LAS float* scr, int item, int lane) {
    const int nblk = N / 32, kb = item / nblk, nb = item % nblk, k0 = 64 * kb, n0 = 32 * nb;
#pragma unroll 8
    for (int i = 0; i < 32; ++i) { const int kk = 2 * i + (lane >> 5); scr[kk * 33 + (lane & 31)] = W[(size_t)(k0 + kk) * N + n0 + (lane & 31)]; }
    asm volatile("s_waitcnt lgkmcnt(0)" ::: "memory");
    const int c = lane & 7;
#pragma unroll
    for (int j = 0; j < 4; ++j) { const int n = (lane >> 3) + 8 * j; const LAS float* s = scr + (8 * c) * 33 + n;
        u32x4 o; o.x = pk2(s[0 * 33], s[1 * 33]); o.y = pk2(s[2 * 33], s[3 * 33]); o.z = pk2(s[4 * 33], s[5 * 33]); o.w = pk2(s[6 * 33], s[7 * 33]);
        const int orow = MAPIN ? rowmap_in(n0 + n) : (n0 + n);
        *(u32x4*)(WT + (size_t)orow * K + k0 + 8 * c) = o; }
    asm volatile("s_waitcnt lgkmcnt(0)" ::: "memory");
}

#define XB_TMO      128
#define XB_XCNT(j)  (256  + 64 * (j))
#define XB_XSUB(j)  (1280 + 64 * (j))
#define XB_XGEN(j)  (2304 + 64 * (j))
#define XB_TOP      3328
#define XB_TOPGEN   3392
#define XCD_BAR_WORDS 3456
#define XB_SPIN_CAP (1u << 18)

__device__ __forceinline__ unsigned xb_ld(unsigned* p)              { return __hip_atomic_load(p, __ATOMIC_RELAXED, __HIP_MEMORY_SCOPE_AGENT); }
__device__ __forceinline__ unsigned xb_add(unsigned* p, unsigned v) { return __hip_atomic_fetch_add(p, v, __ATOMIC_RELAXED, __HIP_MEMORY_SCOPE_AGENT); }
__device__ __forceinline__ unsigned xb_xcc_id() { return (unsigned)__builtin_amdgcn_s_getreg((3 << 11) | 20) & 0xFu; }
#define XB_SPIN(cond, bar) do { unsigned _sp = 0; while (cond) { __builtin_amdgcn_s_sleep(1); \
    if ((++_sp & 255u) == 0u) { if (xb_ld(&(bar)[XB_TMO])) break; if (_sp > XB_SPIN_CAP) { atomicAdd(&(bar)[XB_TMO], 1u); break; } } } } while (0)

struct XcdBarrier {
    unsigned* bar; unsigned x;
    volatile LAS unsigned* st;
};

__device__ __forceinline__ XcdBarrier xcd_barrier_post(unsigned* bar, volatile LAS unsigned* st) {
    XcdBarrier b; b.bar = bar; b.x = xb_xcc_id(); b.st = st;
    if (threadIdx.x == 0) (void)xb_add(&bar[XB_XCNT(b.x)], 1u);
    return b;
}
__device__ __forceinline__ void xcd_barrier_complete(unsigned* bar, unsigned x, unsigned& nloc, unsigned& nx) {
    const unsigned G = gridDim.x * gridDim.y * gridDim.z;
    unsigned sum, cnt, mine, sp = 0u;
    for (;;) {
        sum = 0u; cnt = 0u; mine = 0u;
#pragma unroll
        for (unsigned j = 0; j < 16; ++j) { const unsigned c = xb_ld(&bar[XB_XCNT(j)]); sum += c; cnt += (c > 0u) ? 1u : 0u; mine = (j == x) ? c : mine; }
        if (sum == G) break;
        __builtin_amdgcn_s_sleep(1);
        if ((++sp & 255u) == 0u) { if (xb_ld(&bar[XB_TMO])) break; if (sp > XB_SPIN_CAP) { atomicAdd(&bar[XB_TMO], 1u); break; } }
    }
    nloc = mine > 0u ? mine : 1u; nx = cnt > 0u ? cnt : 1u;
}

__device__ __forceinline__ void xcd_barrier(const XcdBarrier& b) {
    asm volatile("s_waitcnt vmcnt(0)" ::: "memory");
    __syncthreads();
    if (threadIdx.x == 0) {
        unsigned* bar = b.bar;
        __builtin_amdgcn_s_waitcnt(0);
        unsigned nloc = b.st[0], nx = b.st[1];
        if (nloc == 0u) { xcd_barrier_complete(bar, b.x, nloc, nx); b.st[0] = nloc; b.st[1] = nx; }
        const unsigned old = xb_add(&bar[XB_XSUB(b.x)], 1u);
        const unsigned gen = old / nloc;
        if (old + 1u == (gen + 1u) * nloc) {
            __builtin_amdgcn_fence(__ATOMIC_RELEASE, "agent");
            asm volatile("s_waitcnt vmcnt(0)" ::: "memory");
            const unsigned og = xb_add(&bar[XB_TOP], 1u);
            const unsigned tg = og / nx;
            if (og + 1u == (tg + 1u) * nx) xb_add(&bar[XB_TOPGEN], 1u);
            else XB_SPIN(xb_ld(&bar[XB_TOPGEN]) == tg, bar);
            __builtin_amdgcn_fence(__ATOMIC_ACQUIRE, "agent");
            xb_add(&bar[XB_XGEN(b.x)], 1u);
            asm volatile("s_waitcnt vmcnt(0)" ::: "memory");
        } else {
            XB_SPIN(xb_ld(&bar[XB_XGEN(b.x)]) == gen, bar);
            __builtin_amdgcn_fence(__ATOMIC_ACQUIRE, "agent");
            asm volatile("s_waitcnt vmcnt(0)" ::: "memory");
        }
    }
    __syncthreads();
}

constexpr int LDS_ST_OFF = 8 * att::WAVE_LDS + 512;
constexpr int LDS_BYTES = LDS_ST_OFF + 64;
static_assert(LDS_BYTES <= 160 * 1024 && LDS_BYTES >= pg8::STAGE_BYTES, "LDS budget");
constexpr int N_PHASES = 14;
struct Params { const float* in[21]; float* out; unsigned char* ws; int ph_lo, ph_hi; };

#ifndef REPMASK
#define REPMASK 0
#endif
#ifndef EXTRA_SYNC
#define EXTRA_SYNC 0
#endif
__global__ void __launch_bounds__(512, 2) fwd_kernel(Params P) {
    extern __shared__ __attribute__((aligned(16))) unsigned char lds_raw[];
    LAS unsigned char* lds = (LAS unsigned char*)lds_raw;
    {   volatile LAS unsigned* bst0 = (volatile LAS unsigned*)(lds + LDS_ST_OFF);
        if (threadIdx.x < 16) bst0[threadIdx.x] = 0u;
        __syncthreads();
        (void)xcd_barrier_post((unsigned*)(P.ws + WS_BAR), bst0); }
#define GRID_SYNC() do { unsigned* bp_ = (unsigned*)(P.ws + WS_BAR); asm volatile("" : "+s"(bp_)); XcdBarrier b_; b_.bar = bp_; b_.x = xb_xcc_id(); b_.st = (volatile LAS unsigned*)(lds + LDS_ST_OFF); xcd_barrier(b_); } while (0)
#define LANE_OPAQUE int ln_ = threadIdx.x & 63; asm volatile("" : "+v"(ln_)); const int tid_ = wave * 64 + ln_; (void)tid_
#define WSP(T, off) ((T*)(ws + (off)))
#define MODL (WSP(const float, WS_MOD) + (size_t)ly * 9 * MODW)
#define XL ((ly == 0) ? P.in[0] : (const float*)P.out)
#define CL ((ly == 0) ? P.in[2] : WSP(const float, WS_CTX))
#define MROWS ((ly == 0) ? MALL : MLAT)
    const int ph_hi = P.ph_hi;
#pragma unroll 1
    for (int ph = P.ph_lo; ph < ph_hi; ++ph) {
        int phv = ph; asm volatile("" : "+s"(phv));
        const int wave = __builtin_amdgcn_readfirstlane(threadIdx.x >> 6);
        int kind = 0, ly = 0;
        if (phv >= 1) { const int idx = phv - 1; if (idx < 7) { kind = idx + 1 + (idx >= 5 ? 1 : 0); } else { const int j = idx - 7; ly = 1; kind = j + 2 + (j >= 4 ? 1 : 0); } }
        const int G = gridDim.x, bx = blockIdx.x; const int vcu = (G % 8 == 0) ? (bx % 8) * (G / 8) + bx / 8 : bx; const int gw = vcu * 8 + wave, ngw = G * 8;
        unsigned char* ws = P.ws;
#pragma unroll 1
        for (int rep_ = 0; rep_ <= ((REPMASK >> kind) & 1); ++rep_) {
        if (rep_) GRID_SYNC();
        switch (kind) {
        case 0: { LANE_OPAQUE;
            if (bx == G - 1) { for (int i = tid_; i < 512; i += 512) { const int l2 = i >> 8, k = (i >> 6) & 3, d = i & 63; const float* src = P.in[k == 0 ? 9 : k == 1 ? 10 : k == 2 ? 14 : 15]; WSP(float, WS_GAIN)[i] = src[l2 * 64 + d]; } }
            if (bx < 192) mod_item(bx, P.in[1], P.in[3], P.in[4], P.in[5], WSP(float, WS_MOD), lds, tid_, wave, ln_);
            LAS float* scr = (LAS float*)(lds + wave * 16384);
            constexpr int I_IN = 16 * (INW / 32), I_O = 16 * (DM / 32), I_1 = 16 * (FFN / 32), I_2 = 64 * (DM / 32), I_L = I_IN + I_O + I_1 + I_2;
            for (int it = gw; it < 2 * I_L; it += ngw) {
                const int l2 = it / I_L; int r = it - l2 * I_L;
                if (r < I_IN) { transpose_item<true>(P.in[8] + (size_t)l2 * DM * INW, DM, INW, WSP(bf16_t, WS_WIN) + (size_t)l2 * INW * DM, scr, r, ln_); continue; } r -= I_IN;
                if (r < I_O) { transpose_item<false>(P.in[18] + (size_t)l2 * DM * DM, DM, DM, WSP(bf16_t, WS_WO) + (size_t)l2 * DM * DM, scr, r, ln_); continue; } r -= I_O;
                if (r < I_1) { transpose_item<false>(P.in[19] + (size_t)l2 * DM * FFN, DM, FFN, WSP(bf16_t, WS_W1) + (size_t)l2 * FFN * DM, scr, r, ln_); continue; } r -= I_1;
                transpose_item<false>(P.in[20] + (size_t)l2 * FFN * DM, FFN, DM, WSP(bf16_t, WS_W2) + (size_t)l2 * DM * FFN, scr, r, ln_);
            }
        } break;
        case 1: { LANE_OPAQUE;
            prep_pass(P.in[0], P.in[2], P.in[6], WSP(const float, WS_MOD), DM, WSP(bf16_t, WS_HN2), WSP(float, WS_RS1), gw, ngw, ln_);
#pragma unroll 1
            for (int l2 = 0; l2 < 2; ++l2) { const float* m2 = WSP(const float, WS_MOD) + (size_t)l2 * 9 * MODW;
                bias_cols(WSP(bf16_t, WS_WIN) + (size_t)l2 * INW * DM, INW, m2, 0, WSP(float, WS_BIN) + (size_t)l2 * 9 * INW, gw, ngw, ln_);
                bias_cols(WSP(bf16_t, WS_W1) + (size_t)l2 * FFN * DM, FFN, m2, 3 * DM, WSP(float, WS_B1) + (size_t)l2 * 9 * FFN, gw, ngw, ln_); }
        } break;
        case 2: { LANE_OPAQUE;
            pg8::Gemm g{WSP(bf16_t, WS_HN2), WSP(bf16_t, WS_WIN) + (size_t)ly * INW * DM, MALL, INW, DM}; pg8::StaticOrder S; S.init(MALL, INW, G, bx);
            pg8::EpiProj E{WSP(bf16_t, WS_PROJ), WSP(const float, WS_GAIN) + ly * 256, WSP(const float, WS_RS1), WSP(const float, WS_BIN) + (size_t)ly * 9 * INW};
            pg8::gemm_phase<pg8::EpiProj, pg8::StaticOrder, true, true>(lds, g, S, E);
        } break;
        case 3: { LANE_OPAQUE;
            att::attn_phase(lds + wave * att::WAVE_LDS + 256, WSP(bf16_t, WS_PROJ), WSP(bf16_t, WS_OB), P.in[11] + (size_t)ly * 4 * 15 * 31, P.in[16] + ly * 8, ly == 0, gw, ngw, ln_);
        } break;
        case 4: { LANE_OPAQUE;
            mix_pass(WSP(bf16_t, WS_PROJ), WSP(bf16_t, WS_OB), P.in[12] + (size_t)ly * 3 * 256, P.in[13] + ly * 256, P.in[17] + ly * DM, WSP(bf16_t, WS_HN), MROWS, gw, ngw, ln_);
        } break;
        case 5: { LANE_OPAQUE;
            pg8::Gemm g{WSP(bf16_t, WS_HN), WSP(bf16_t, WS_WO) + (size_t)ly * DM * DM, MROWS, DM, DM}; pg8::StaticOrder S; S.init(MROWS, DM, G, bx);
            pg8::EpiResid E{XL, CL, P.out, WSP(float, WS_CTX), MODL + 2 * DM, WSP(bf16_t, WS_HN2), P.in[7] + ly * DM, MODL + 4 * DM, WSP(float, WS_RS2)};
            pg8::gemm_phase<pg8::EpiResid, pg8::StaticOrder, true, true>(lds, g, S, E);
        } break;
        case 7: { LANE_OPAQUE;
            pg8::Gemm g{WSP(bf16_t, WS_HN2), WSP(bf16_t, WS_W1) + (size_t)ly * FFN * DM, MROWS, FFN, DM}; pg8::StaticOrder S; S.init(MROWS, FFN, G, bx);
            pg8::EpiFc1 E{WSP(bf16_t, WS_H1), FFN, WSP(const float, WS_RS2), WSP(const float, WS_B1) + (size_t)ly * 9 * FFN};
            pg8::gemm_phase<pg8::EpiFc1, pg8::StaticOrder, true, true>(lds, g, S, E);
        } break;
        default: { LANE_OPAQUE;
            pg8::Gemm g{WSP(bf16_t, WS_H1), WSP(bf16_t, WS_W2) + (size_t)ly * DM * FFN, MROWS, DM, FFN}; pg8::StaticOrder S; S.init(MROWS, DM, G, bx);
            pg8::EpiResid E{P.out, WSP(float, WS_CTX), P.out, WSP(float, WS_CTX), MODL + 5 * DM, (ly == 0) ? WSP(bf16_t, WS_HN2) : (bf16_t*)nullptr, P.in[6] + DM, WSP(const float, WS_MOD) + (size_t)9 * MODW + DM, WSP(float, WS_RS1)};
            pg8::gemm_phase<pg8::EpiResid, pg8::StaticOrder, true, true>(lds, g, S, E);
        } break;
        }
        }
        for (int es_ = 0; es_ < EXTRA_SYNC; ++es_) GRID_SYNC();
        if (ph + 1 < ph_hi) GRID_SYNC();
    }
}

#ifndef MK_MULTI_LAUNCH
#define MK_MULTI_LAUNCH 0
#endif
extern "C" void kernel_launch(void* const* d_in, const int* in_sizes, int n_in, void* d_out, int out_size, void* d_ws, size_t ws_size, hipStream_t stream) {
    static int grid = 0;
    if (grid == 0) {
        if (n_in != 21 || out_size != MLAT * DM || ws_size < WS_END) { fprintf(stderr, "kernel_launch: unexpected shapes (n_in %d out %d ws %zu)\n", n_in, out_size, ws_size); grid = -1; return; }
        int dev = 0, cus = 0, per_cu = 0;
        if (hipGetDevice(&dev) != hipSuccess || hipDeviceGetAttribute(&cus, hipDeviceAttributeMultiprocessorCount, dev) != hipSuccess) { grid = -1; return; }
        if (hipFuncSetAttribute((const void*)fwd_kernel, hipFuncAttributeMaxDynamicSharedMemorySize, LDS_BYTES) != hipSuccess) { fprintf(stderr, "kernel_launch: hipFuncSetAttribute failed\n"); grid = -1; return; }
        if (hipOccupancyMaxActiveBlocksPerMultiprocessor(&per_cu, (const void*)fwd_kernel, 512, LDS_BYTES) != hipSuccess || per_cu < 1) { fprintf(stderr, "kernel_launch: occupancy query gave %d\n", per_cu); (void)hipGetLastError(); grid = -1; return; }
        grid = cus * per_cu;
    }
    if (grid < 0) return;
    Params p{};
    for (int i = 0; i < 21; ++i) p.in[i] = (const float*)d_in[i];
    p.out = (float*)d_out; p.ws = (unsigned char*)d_ws;
    if (hipMemsetAsync((char*)d_ws + WS_BAR, 0, XCD_BAR_WORDS * 4, stream) != hipSuccess) { fprintf(stderr, "kernel_launch: memset of the barrier words failed\n"); return; }
    void* args[] = {&p};
#if MK_MULTI_LAUNCH
    for (int ph = 0; ph < N_PHASES; ++ph) { p.ph_lo = ph; p.ph_hi = ph + 1;
        hipError_t e = hipLaunchCooperativeKernel((const void*)fwd_kernel, dim3(grid), dim3(512), args, LDS_BYTES, stream);
        if (e != hipSuccess) { fprintf(stderr, "launch %d failed: %s\n", ph, hipGetErrorString(e)); break; } }
#else
    p.ph_lo = 0; p.ph_hi = N_PHASES;
    hipError_t e = hipLaunchCooperativeKernel((const void*)fwd_kernel, dim3(grid), dim3(512), args, LDS_BYTES, stream);
    if (e != hipSuccess) fprintf(stderr, "cooperative launch failed: %s (grid %d)\n", hipGetErrorString(e), grid);
#endif
}
```

```cpp
#include <hip/hip_runtime.h>
#include <cstdio>
#include <cstdint>
namespace pg8 {
#define PG8_LAS __attribute__((address_space(3)))
typedef unsigned short bf16_t;
__device__ __forceinline__ int lane_id() { int r; asm volatile("v_mbcnt_lo_u32_b32 %0, -1, 0\n\tv_mbcnt_hi_u32_b32 %0, -1, %0" : "=v"(r)); return r; }
template <int K> __device__ __forceinline__ float shx(float v) { static_assert(K == 1 || K == 2 || K == 4 || K == 8 || K == 16, "xor mask"); return __builtin_bit_cast(float, __builtin_amdgcn_ds_swizzle(__builtin_bit_cast(int, v), 0x1f | (K << 10))); }
__device__ __forceinline__ void swap_halves(float& a, float& b) { asm("s_nop 1\n\tv_permlane32_swap_b32 %0, %1" : "+v"(a), "+v"(b)); }
__device__ __forceinline__ float sum_halves(float v) { float a = v, b = v; swap_halves(a, b); return a + b; }
__device__ __forceinline__ float max_halves(float v) { float a = v, b = v; swap_halves(a, b); return fmaxf(a, b); }
typedef short bf16x8 __attribute__((ext_vector_type(8)));
typedef float f32x4 __attribute__((ext_vector_type(4)));
typedef unsigned u32x4 __attribute__((ext_vector_type(4)));
constexpr int BM = 256, BK = 64, HALF = 128, HTB = HALF * BK * 2  , STAGE_BYTES = 8 * HTB, NXCD = 8, WGM = 8;

__host__ __device__ __forceinline__ int lds_byte(int r, int c) { const int st = (r >> 4) * 2 + (c >> 5), rr = r & 15, cc = c & 31, ob = rr * 64 + cc * 2; return st * 1024 + (ob ^ (((ob >> 9) & 1) << 5)); }
__host__ __device__ __forceinline__ void stage_rc(int b, int& R, int& C) { const int st = b / 1024, sb = b % 1024, swz = sb ^ (((sb >> 9) & 1) << 5); R = (st >> 1) * 16 + swz / 64; C = (st & 1) * 32 + (swz % 64) / 2; }
__host__ __device__ __forceinline__ int perm32(int rho) { const int n = rho >> 4, i = rho & 15; return 8 * (i >> 2) + 4 * n + (i & 3); }

struct Unit { int pm, pn; };
struct Gemm { const bf16_t* A; const bf16_t* Bt; int M, N, K; };

struct StaticOrder {
    int nM, nN, nwg, G, c;
    __host__ __device__ void init(int M, int N, int G_, int c_) { nM = M / BM; nN = N / BM; nwg = nM * nN; G = G_; c = c_; }
    __host__ __device__ bool next(int i, Unit& u) const {
        const long L = (long)i * G + c; if (L >= nwg) return false;
        int wgid = (int)L; { const int q = nwg / NXCD, r = nwg % NXCD, xcd = wgid % NXCD, off = wgid / NXCD; wgid = (xcd < r ? xcd * (q + 1) : r * (q + 1) + (xcd - r) * q) + off; }
        const int nig = WGM * nN, gid = wgid / nig, fm = gid * WGM, gsz = (nM - fm) < WGM ? (nM - fm) : WGM;
        u.pm = fm + ((wgid % nig) % gsz); u.pn = (wgid % nig) / gsz; return true;
    }
    __device__ __forceinline__ void a_ready(const Unit&) const {}
    __device__ __forceinline__ void done(const Unit&) const {}
};
__device__ __forceinline__ unsigned cvt_pk_bf16(float lo, float hi) { unsigned r; asm volatile("v_cvt_pk_bf16_f32 %0, %1, %2" : "=v"(r) : "v"(lo), "v"(hi)); return r; }
typedef float f32x2 __attribute__((ext_vector_type(2)));
template <class Epi, class Sched, bool ALIGN_EPI = false, bool SP2 = false>
__device__ __forceinline__ void gemm_phase(PG8_LAS unsigned char* lds, const Gemm g, const Sched& S, const Epi& E, const int wid_in) {
    int tid_ = wid_in * 64 + lane_id(); asm volatile("" : "+v"(tid_));
    const int tid = tid_, wid = __builtin_amdgcn_readfirstlane(tid >> 6), lane = tid & 63, wr = wid >> 2, wc = wid & 3, fr = lane & 15, fq = lane >> 4;
    const int K = g.K, nt = K / BK;
    unsigned voffA[2], voffB[2];
#pragma unroll
    for (int i = 0; i < 2; ++i) { int R, C; stage_rc(tid * 16 + i * 8192, R, C); const int Rb = Epi::PERM ? ((R & ~31) + perm32(R & 31)) : R;
        voffA[i] = (unsigned)(R * K + C) * 2u; voffB[i] = (unsigned)(Rb * K + C) * 2u; }
    const size_t kstep = (size_t)(BK * 2);
    const size_t hstep = (size_t)HALF * K * 2;
    const size_t tstep = 2 * hstep;
    const unsigned ldsw = (unsigned)wid * 1024u;
    const int aoff = lds_byte(wr * 64 + fr, fq * 8), boff = lds_byte(wc * 32 + fr, fq * 8);
#define PG8_SA(b, h) (((b) * 2 + (h)) * HTB)
#define PG8_SB(b, h) ((4 + (b) * 2 + (h)) * HTB)
#define PG8_STAGE(bufoff, gbase, voff) do { _Pragma("unroll") for (int _i = 0; _i < 2; ++_i) \
        __builtin_amdgcn_global_load_lds((const unsigned*)((const char*)(gbase) + (voff)[_i]), (PG8_LAS unsigned*)(lds + (bufoff) + ldsw + _i * 8192), 16, 0, 0); } while (0)
#define PG8_LDA(dst, b, h) do { _Pragma("unroll") for (int m = 0; m < 4; ++m) _Pragma("unroll") for (int k = 0; k < 2; ++k) dst[m][k] = *(const PG8_LAS bf16x8*)(lds + PG8_SA(b, h) + aoff + m * 2048 + k * 1024); } while (0)
#define PG8_LDB(dst, b, h) do { _Pragma("unroll") for (int n = 0; n < 2; ++n) _Pragma("unroll") for (int k = 0; k < 2; ++k) dst[n][k] = *(const PG8_LAS bf16x8*)(lds + PG8_SB(b, h) + boff + n * 2048 + k * 1024); } while (0)
#define PG8_MMA(ai, bj, At, Bt) do { __builtin_amdgcn_s_setprio(1); _Pragma("unroll") for (int m = 0; m < 4; ++m) _Pragma("unroll") for (int n = 0; n < 2; ++n) _Pragma("unroll") for (int k = 0; k < 2; ++k) \
        acc[ai][bj][m][n] = __builtin_amdgcn_mfma_f32_16x16x32_bf16(Bt[n][k], At[m][k], acc[ai][bj][m][n], 0, 0, 0); __builtin_amdgcn_s_setprio(0); } while (0)
#define PG8_WAIT_V(n) asm volatile("s_waitcnt vmcnt(" #n ")" ::: "memory")
#define PG8_WAIT_L(n) asm volatile("s_waitcnt lgkmcnt(" #n ")" ::: "memory")
#define PG8_BAR __builtin_amdgcn_s_barrier()
#define PG8_SCHED __builtin_amdgcn_sched_barrier(0)
    Unit cur, nxt; int ui = 0;
    if (!S.next(0, cur)) return;
    f32x4 acc[2][2][4][2];
#pragma unroll
    for (int a = 0; a < 2; ++a)
#pragma unroll
        for (int b = 0; b < 2; ++b)
#pragma unroll
            for (int m = 0; m < 4; ++m)
#pragma unroll
                for (int n = 0; n < 2; ++n) acc[a][b][m][n] = (f32x4){0.f, 0.f, 0.f, 0.f};
    bf16x8 At[4][2], B0[2][2], B1[2][2];
    const char* cA = (const char*)g.A + (size_t)cur.pm * tstep; const char* cB = (const char*)g.Bt + (size_t)cur.pn * tstep;
    S.a_ready(cur);
    if constexpr (SP2) {
        PG8_STAGE(PG8_SB(0, 0), cB, voffB); PG8_STAGE(PG8_SB(0, 1), cB + hstep, voffB); PG8_STAGE(PG8_SA(0, 0), cA, voffA); PG8_STAGE(PG8_SA(0, 1), cA + hstep, voffA);
        if (wr == 1) PG8_BAR;
        PG8_WAIT_V(2); PG8_BAR;
        PG8_STAGE(PG8_SB(1, 0), cB + kstep, voffB); PG8_STAGE(PG8_SA(1, 0), cA + kstep, voffA); PG8_STAGE(PG8_SB(1, 1), cB + hstep + kstep, voffB);
        PG8_WAIT_V(6); PG8_BAR;
    } else {
        PG8_STAGE(PG8_SB(0, 0), cB, voffB); PG8_STAGE(PG8_SA(0, 0), cA, voffA); PG8_STAGE(PG8_SB(0, 1), cB + hstep, voffB); PG8_STAGE(PG8_SA(0, 1), cA + hstep, voffA);
        if (wr == 1) PG8_BAR;
        PG8_WAIT_V(4); PG8_BAR;
        PG8_STAGE(PG8_SB(1, 0), cB + kstep, voffB); PG8_STAGE(PG8_SA(1, 0), cA + kstep, voffA); PG8_STAGE(PG8_SB(1, 1), cB + hstep + kstep, voffB);
        PG8_WAIT_V(6); PG8_BAR;
    }
    for (;;) {
        const bool has_next = S.next(ui + 1, nxt);
        const char* nA = has_next ? (const char*)g.A + (size_t)nxt.pm * tstep : cA; const char* nB = has_next ? (const char*)g.Bt + (size_t)nxt.pn * tstep : cB;
        for (int t = 0; t < nt; t += 2) {
            const bool last = (t == nt - 2);
            const char* a1 = cA + (size_t)(t + 1) * kstep;
            const char* a2 = last ? nA : cA + (size_t)(t + 2) * kstep; const char* b2 = last ? nB : cB + (size_t)(t + 2) * kstep;
            const char* a3 = a2 + kstep; const char* b3 = b2 + kstep;
            if (last && has_next) S.a_ready(nxt);
            if constexpr (SP2) {
            PG8_LDB(B0, 0, 0); PG8_LDB(B1, 0, 1); PG8_SCHED; PG8_LDA(At, 0, 0); PG8_STAGE(PG8_SA(1, 1), a1 + hstep, voffA);
            PG8_WAIT_V(8); PG8_WAIT_L(0); PG8_BAR; PG8_MMA(0, 0, At, B0); PG8_MMA(0, 1, At, B1); PG8_BAR; PG8_SCHED;
            PG8_LDA(At, 0, 1); PG8_STAGE(PG8_SB(0, 0), b2, voffB); PG8_STAGE(PG8_SB(0, 1), b2 + hstep, voffB); PG8_STAGE(PG8_SA(0, 0), a2, voffA);
            PG8_WAIT_V(8); PG8_WAIT_L(0); PG8_BAR; PG8_MMA(1, 0, At, B0); PG8_MMA(1, 1, At, B1); PG8_BAR; PG8_SCHED;
            PG8_LDB(B0, 1, 0); PG8_LDB(B1, 1, 1); PG8_SCHED; PG8_LDA(At, 1, 0); PG8_STAGE(PG8_SA(0, 1), a2 + hstep, voffA);
            PG8_WAIT_V(8); PG8_WAIT_L(0); PG8_BAR; PG8_MMA(0, 0, At, B0); PG8_MMA(0, 1, At, B1); PG8_BAR; PG8_SCHED;
            PG8_LDA(At, 1, 1); PG8_STAGE(PG8_SB(1, 0), b3, voffB); PG8_STAGE(PG8_SB(1, 1), b3 + hstep, voffB); PG8_STAGE(PG8_SA(1, 0), a3, voffA);
            PG8_WAIT_V(8); PG8_WAIT_L(0); PG8_BAR; PG8_MMA(1, 0, At, B0); PG8_MMA(1, 1, At, B1); PG8_BAR; PG8_SCHED;
            } else {
            PG8_LDB(B0, 0, 0); PG8_SCHED; PG8_LDA(At, 0, 0); PG8_STAGE(PG8_SA(1, 1), a1 + hstep, voffA);
            PG8_WAIT_L(8); PG8_BAR; PG8_WAIT_L(0); PG8_MMA(0, 0, At, B0); PG8_BAR; PG8_SCHED;
            PG8_LDB(B1, 0, 1); PG8_STAGE(PG8_SB(0, 0), b2, voffB);
            PG8_BAR; PG8_WAIT_L(0); PG8_MMA(0, 1, At, B1); PG8_BAR;
            PG8_LDA(At, 0, 1); PG8_STAGE(PG8_SA(0, 0), a2, voffA);
            PG8_BAR; PG8_WAIT_L(0); PG8_MMA(1, 0, At, B0); PG8_BAR; PG8_SCHED;
            PG8_STAGE(PG8_SB(0, 1), b2 + hstep, voffB);
            PG8_WAIT_V(6); PG8_BAR; PG8_MMA(1, 1, At, B1); PG8_BAR;
            PG8_LDB(B0, 1, 0); PG8_SCHED; PG8_LDA(At, 1, 0); PG8_STAGE(PG8_SA(0, 1), a2 + hstep, voffA);
            PG8_WAIT_L(8); PG8_BAR; PG8_WAIT_L(0); PG8_MMA(0, 0, At, B0); PG8_BAR; PG8_SCHED;
            PG8_LDB(B1, 1, 1); PG8_STAGE(PG8_SB(1, 0), b3, voffB);
            PG8_BAR; PG8_WAIT_L(0); PG8_MMA(0, 1, At, B1); PG8_BAR;
            PG8_LDA(At, 1, 1); PG8_STAGE(PG8_SA(1, 0), a3, voffA);
            PG8_BAR; PG8_WAIT_L(0); PG8_MMA(1, 0, At, B0); PG8_BAR; PG8_SCHED;
            PG8_STAGE(PG8_SB(1, 1), b3 + hstep, voffB);
            PG8_WAIT_V(6); PG8_BAR; PG8_MMA(1, 1, At, B1); PG8_BAR;
            }
        }
        if constexpr (ALIGN_EPI) { if (wr == 0) PG8_BAR; }
        if constexpr (!Epi::AFTER_DRAIN) { E(acc, cur, wr, wc, fr, fq); S.done(cur); }
        if (!has_next) break;
#pragma unroll
        for (int a = 0; a < 2; ++a)
#pragma unroll
            for (int b = 0; b < 2; ++b)
#pragma unroll
                for (int m = 0; m < 4; ++m)
#pragma unroll
                    for (int n = 0; n < 2; ++n) acc[a][b][m][n] = (f32x4){0.f, 0.f, 0.f, 0.f};
        cur = nxt; cA = nA; cB = nB; ++ui;
        if constexpr (ALIGN_EPI) { if (wr == 1) PG8_BAR; }
    }
    PG8_WAIT_V(0);
    if constexpr (!ALIGN_EPI) { if (wr == 0) PG8_BAR; }
    PG8_BAR;
    if constexpr (Epi::AFTER_DRAIN) { E.fused(acc, cur, wr, wc, fr, fq, lds, wid, lane); S.done(cur); }
#undef PG8_SA
#undef PG8_SB
#undef PG8_STAGE
#undef PG8_LDA
#undef PG8_LDB
#undef PG8_MMA
#undef PG8_WAIT_V
#undef PG8_WAIT_L
#undef PG8_BAR
#undef PG8_SCHED
}
}

namespace pg8 {
typedef unsigned u32x2 __attribute__((ext_vector_type(2)));
template <int ACT> struct EpiStore {
    static constexpr bool PERM = true, AFTER_DRAIN = false;
    bf16_t* O; int ldc;
    __device__ __forceinline__ void operator()(const f32x4 (&acc)[2][2][4][2], const Unit& u, int wr, int wc, int fr, int fq) const {
        const int row0 = u.pm * BM + wr * 64 + fr, col0 = u.pn * BM + wc * 32 + 8 * fq;
#pragma unroll
        for (int ai = 0; ai < 2; ++ai)
#pragma unroll
            for (int m = 0; m < 4; ++m) { bf16_t* rowp = O + (size_t)(row0 + ai * HALF + m * 16) * ldc + col0;
#pragma unroll
                for (int bj = 0; bj < 2; ++bj) { f32x4 v0 = acc[ai][bj][m][0], v1 = acc[ai][bj][m][1];
                    if (ACT == 2) {
#pragma unroll
                        for (int e = 0; e < 4; ++e) { const float a = fmaxf(v0[e], 0.f), b = fmaxf(v1[e], 0.f); v0[e] = a * a; v1[e] = b * b; } }
                    u32x4 w; w.x = cvt_pk_bf16(v0[0], v0[1]); w.y = cvt_pk_bf16(v0[2], v0[3]); w.z = cvt_pk_bf16(v1[0], v1[1]); w.w = cvt_pk_bf16(v1[2], v1[3]);
                    *(u32x4*)(rowp + bj * HALF) = w; } }
    }
};


__device__ __forceinline__ void rows_rstd(const float* rs, int row0, int fq, float (&rstd)[2][4]) {
    f32x4 p[2][4];
#pragma unroll
    for (int ai = 0; ai < 2; ++ai)
#pragma unroll
        for (int m = 0; m < 4; ++m) p[ai][m] = *(const f32x4*)(rs + (size_t)(row0 + ai * HALF + m * 16) * 16 + 4 * fq);
#pragma unroll
    for (int ai = 0; ai < 2; ++ai)
#pragma unroll
        for (int m = 0; m < 4; ++m) { float s = (p[ai][m][0] + p[ai][m][1]) + (p[ai][m][2] + p[ai][m][3]); s += shx<16>(s); s = sum_halves(s); rstd[ai][m] = 1.0f / sqrtf(s * (1.0f / 1024.0f) + 1e-6f); }
}
struct EpiFc1 {
    static constexpr bool PERM = true, AFTER_DRAIN = false;
    bf16_t* O; int ldc; const float* rs; const float* bias;
    __device__ __forceinline__ void operator()(const f32x4 (&acc)[2][2][4][2], const Unit& u, int wr, int wc, int fr_in, int fq_in) const {
        (void)fr_in; (void)fq_in; int ln_e = lane_id(); asm volatile("" : "+v"(ln_e)); const int fr = ln_e & 15, fq = ln_e >> 4;
        const int row0 = u.pm * BM + wr * 64 + fr, col0 = u.pn * BM + wc * 32 + 8 * fq; const int b = (u.pm < 64) ? (u.pm >> 3) : 8;
        f32x4 bv[2][2];
#pragma unroll
        for (int bj = 0; bj < 2; ++bj)
#pragma unroll
            for (int n = 0; n < 2; ++n) bv[bj][n] = *(const f32x4*)(bias + (size_t)b * ldc + col0 + bj * HALF + 4 * n);
        float rsd[2][4]; rows_rstd(rs, row0, fq, rsd);
#pragma unroll
        for (int ai = 0; ai < 2; ++ai)
#pragma unroll
            for (int m = 0; m < 4; ++m) { const int row = row0 + ai * HALF + m * 16; const float rstd = rsd[ai][m]; bf16_t* rowp = O + (size_t)row * ldc + col0;
#pragma unroll
                for (int bj = 0; bj < 2; ++bj) { f32x4 v0 = acc[ai][bj][m][0] * rstd + bv[bj][0], v1 = acc[ai][bj][m][1] * rstd + bv[bj][1];
#pragma unroll
                    for (int e = 0; e < 4; ++e) { const float a = fmaxf(v0[e], 0.f), c = fmaxf(v1[e], 0.f); v0[e] = a * a; v1[e] = c * c; }
                    u32x4 w; w.x = cvt_pk_bf16(v0[0], v0[1]); w.y = cvt_pk_bf16(v0[2], v0[3]); w.z = cvt_pk_bf16(v1[0], v1[1]); w.w = cvt_pk_bf16(v1[2], v1[3]);
                    *(u32x4*)(rowp + bj * HALF) = w; }
                asm volatile("" ::: "memory"); }
    }
};

struct EpiResid {
    static constexpr bool PERM = true, AFTER_DRAIN = false;
    const float* base_lat; const float* base_ctx; float* out_lat; float* out_ctx; const float* gate;
    bf16_t* aout; const float* gn; const float* scn; float* rsout;
    __device__ __forceinline__ void operator()(const f32x4 (&acc)[2][2][4][2], const Unit& u, int wr, int wc, int fr_in, int fq_in) const {
        (void)fr_in; (void)fq_in; int ln_e = lane_id(); asm volatile("" : "+v"(ln_e)); const int fr = ln_e & 15, fq = ln_e >> 4;
        const bool lat = u.pm < 64;
        const int b = lat ? (u.pm >> 3) : 8;
        const size_t roff = (size_t)(lat ? u.pm : u.pm - 64) * BM * 1024;
        const float* base = (lat ? base_lat : base_ctx) + roff; float* out = (lat ? out_lat : out_ctx) + roff;
        const int col0 = u.pn * BM + wc * 32 + 8 * fq;
        f32x4 gv[2][2];
#pragma unroll
        for (int bj = 0; bj < 2; ++bj)
#pragma unroll
            for (int n = 0; n < 2; ++n) gv[bj][n] = *(const f32x4*)(gate + (size_t)b * 6144 + col0 + bj * HALF + n * 4);
        if (aout == nullptr) {
#pragma unroll
            for (int ai = 0; ai < 2; ++ai)
#pragma unroll
                for (int m = 0; m < 4; ++m) { const size_t off = (size_t)(ai * HALF + wr * 64 + m * 16 + fr) * 1024 + col0;
#pragma unroll
                    for (int bj = 0; bj < 2; ++bj)
#pragma unroll
                        for (int n = 0; n < 2; ++n) { const f32x4 bs = *(const f32x4*)(base + off + bj * HALF + n * 4);
                            *(f32x4*)(out + off + bj * HALF + n * 4) = bs + gv[bj][n] * acc[ai][bj][m][n]; }
                    if (m & 1) asm volatile("" ::: "memory"); }
            return;
        }
        f32x4 Gv[2][2];
#pragma unroll
        for (int bj = 0; bj < 2; ++bj)
#pragma unroll
            for (int n = 0; n < 2; ++n) Gv[bj][n] = *(const f32x4*)(gn + col0 + bj * HALF + n * 4) * (*(const f32x4*)(scn + (size_t)b * 6144 + col0 + bj * HALF + n * 4) + 1.0f);
        const size_t grow0 = (size_t)u.pm * BM;
#pragma unroll
        for (int ai = 0; ai < 2; ++ai)
#pragma unroll
            for (int m = 0; m < 4; ++m) { const int rl = ai * HALF + wr * 64 + m * 16 + fr; const size_t off = (size_t)rl * 1024 + col0; float ss = 0.f;
                bf16_t* ap = aout + (grow0 + rl) * 1024 + col0;
#pragma unroll
                for (int bj = 0; bj < 2; ++bj) {
                    const f32x4 b0 = *(const f32x4*)(base + off + bj * HALF), b1 = *(const f32x4*)(base + off + bj * HALF + 4);
                    const f32x4 x0 = b0 + gv[bj][0] * acc[ai][bj][m][0], x1 = b1 + gv[bj][1] * acc[ai][bj][m][1];
                    *(f32x4*)(out + off + bj * HALF) = x0; *(f32x4*)(out + off + bj * HALF + 4) = x1;
                    ss += ((x0[0] * x0[0] + x0[1] * x0[1]) + (x0[2] * x0[2] + x0[3] * x0[3])) + ((x1[0] * x1[0] + x1[1] * x1[1]) + (x1[2] * x1[2] + x1[3] * x1[3]));
                    const f32x4 y0 = x0 * Gv[bj][0], y1 = x1 * Gv[bj][1];
                    u32x4 w; w.x = cvt_pk_bf16(y0[0], y0[1]); w.y = cvt_pk_bf16(y0[2], y0[3]); w.z = cvt_pk_bf16(y1[0], y1[1]); w.w = cvt_pk_bf16(y1[2], y1[3]);
                    *(u32x4*)(ap + bj * HALF) = w; }
                ss += shx<16>(ss); ss = sum_halves(ss);
                if (fq == 0) rsout[(grow0 + rl) * 16 + u.pn * 4 + wc] = ss;
                if (m & 1) asm volatile("" ::: "memory"); }
    }
};

struct EpiProj {
    static constexpr bool PERM = true, AFTER_DRAIN = false;
    bf16_t* O; const float* gains;
    const float* rs; const float* bias;
    __device__ __forceinline__ void operator()(const f32x4 (&acc)[2][2][4][2], const Unit& u, int wr, int wc, int fr_in, int fq_in) const {
        (void)fr_in; (void)fq_in; int ln_e = lane_id(); asm volatile("" : "+v"(ln_e)); const int fr = ln_e & 15, fq = ln_e >> 4;
        const int pn = u.pn; const int row0 = u.pm * BM + wr * 64 + fr; const int b = (u.pm < 64) ? (u.pm >> 3) : 8;
        f32x4 bv[2][2];
#pragma unroll
        for (int bj = 0; bj < 2; ++bj)
#pragma unroll
            for (int n = 0; n < 2; ++n) bv[bj][n] = *(const f32x4*)(bias + (size_t)b * 2304 + pn * BM + bj * HALF + wc * 32 + 8 * fq + 4 * n);
        float rsd[2][4]; rows_rstd(rs, row0, fq, rsd);
        if (pn >= 2 && pn <= 5) {
            const int col0 = pn * BM + wc * 32 + 8 * fq;
#pragma unroll
            for (int ai = 0; ai < 2; ++ai)
#pragma unroll
                for (int m = 0; m < 4; ++m) { bf16_t* rowp = O + (size_t)(row0 + ai * HALF + m * 16) * 2304 + col0; const float rstd = rsd[ai][m];
#pragma unroll
                    for (int bj = 0; bj < 2; ++bj) { const f32x4 v0 = acc[ai][bj][m][0] * rstd + bv[bj][0], v1 = acc[ai][bj][m][1] * rstd + bv[bj][1];
                        u32x4 w; w.x = cvt_pk_bf16(v0[0], v0[1]); w.y = cvt_pk_bf16(v0[2], v0[3]); w.z = cvt_pk_bf16(v1[0], v1[1]); w.w = cvt_pk_bf16(v1[2], v1[3]);
                        *(u32x4*)(rowp + bj * HALF) = w; } }
            return;
        }
        const int colh = pn * BM + wc * 64 + 8 * fq;
        const bool vhead = (pn == 8) && (wc >= 2);
        if (vhead) {
#pragma unroll
            for (int ai = 0; ai < 2; ++ai)
#pragma unroll
                for (int m = 0; m < 4; ++m) { bf16_t* rowp = O + (size_t)(row0 + ai * HALF + m * 16) * 2304 + colh; const float rstd = rsd[ai][m];
#pragma unroll
                    for (int bj = 0; bj < 2; ++bj) { const f32x4 v0 = acc[ai][bj][m][0] * rstd + bv[bj][0], v1 = acc[ai][bj][m][1] * rstd + bv[bj][1];
                        u32x4 w; w.x = cvt_pk_bf16(v0[0], v0[1]); w.y = cvt_pk_bf16(v0[2], v0[3]); w.z = cvt_pk_bf16(v1[0], v1[1]); w.w = cvt_pk_bf16(v1[2], v1[3]);
                        *(u32x4*)(rowp + bj * 32) = w; } }
            return;
        }
        const float* gp = gains + 64 * ((pn == 0) ? 0 : (pn == 1) ? 1 : (pn == 8) ? 3 : 2);
        const float qs = (pn == 1 || pn == 8) ? 1.0f : 0.18033688011112042f;
        const bool rope = (pn >= 6) && (u.pm < 64);
        f32x4 gv[2][2];
#pragma unroll
        for (int bj = 0; bj < 2; ++bj)
#pragma unroll
            for (int n = 0; n < 2; ++n) gv[bj][n] = *(const f32x4*)(gp + 32 * bj + 16 * n + 4 * fq);
        float invrev[4];
#pragma unroll
        for (int e = 0; e < 4; ++e) invrev[e] = __builtin_amdgcn_exp2f(-(float)(4 * fq + e) * (13.287712379549449f / 16.0f)) * 0.15915494309189535f;
#pragma unroll
        for (int ai = 0; ai < 2; ++ai)
#pragma unroll
            for (int m = 0; m < 4; ++m) {
                const int row = row0 + ai * HALF + m * 16; const float rstd0 = rsd[ai][m];
                f32x4 v[2][2]; float ss = 0.f;
#pragma unroll
                for (int bj = 0; bj < 2; ++bj)
#pragma unroll
                    for (int n = 0; n < 2; ++n) v[bj][n] = acc[ai][bj][m][n] * rstd0 + bv[bj][n];
                asm volatile("" : "+v"(v[0][0]), "+v"(v[0][1]), "+v"(v[1][0]), "+v"(v[1][1]));
#pragma unroll
                for (int bj = 0; bj < 2; ++bj)
#pragma unroll
                    for (int n = 0; n < 2; ++n) { const f32x4 x = v[bj][n]; ss += (x[0] * x[0] + x[1] * x[1]) + (x[2] * x[2] + x[3] * x[3]); }
                ss += shx<16>(ss); ss = sum_halves(ss);
                const float rstd = 1.0f / sqrtf(ss * (1.0f / 64.0f) + 1e-6f);
#pragma unroll
                for (int bj = 0; bj < 2; ++bj)
#pragma unroll
                    for (int n = 0; n < 2; ++n) v[bj][n] = v[bj][n] * rstd * gv[bj][n];
                if (rope) {
                    const int t = row & 2047;
#pragma unroll
                    for (int bj = 0; bj < 2; ++bj) { const float pos = (float)(bj == 0 ? (t >> 6) : (t & 63));
#pragma unroll
                        for (int e = 0; e < 4; ++e) { float rev = pos * invrev[e]; rev = rev - floorf(rev);
                            const float cs = __builtin_amdgcn_cosf(rev), sn = __builtin_amdgcn_sinf(rev);
                            const float u1 = v[bj][0][e], u2 = v[bj][1][e];
                            v[bj][0][e] = u1 * cs - u2 * sn; v[bj][1][e] = u2 * cs + u1 * sn; } }
                }
                bf16_t* rowp = O + (size_t)row * 2304 + colh;
#pragma unroll
                for (int bj = 0; bj < 2; ++bj) { const f32x4 v0 = v[bj][0] * qs, v1 = v[bj][1] * qs;
                    u32x4 w; w.x = cvt_pk_bf16(v0[0], v0[1]); w.y = cvt_pk_bf16(v0[2], v0[3]); w.z = cvt_pk_bf16(v1[0], v1[1]); w.w = cvt_pk_bf16(v1[2], v1[3]);
                    *(u32x4*)(rowp + bj * 32) = w; }
                asm volatile("" ::: "memory");
            }
    }
};
}

#define LAS __attribute__((address_space(3)))
typedef unsigned short bf16_t;
typedef short bf16x8 __attribute__((ext_vector_type(8)));
typedef short s16x4 __attribute__((ext_vector_type(4)));
typedef float f32x16 __attribute__((ext_vector_type(16)));
typedef float f32x4 __attribute__((ext_vector_type(4)));
typedef unsigned u32x4 __attribute__((ext_vector_type(4)));
typedef unsigned u32x2 __attribute__((ext_vector_type(2)));

constexpr int DM = 1024, NB = 8, SEQ = 2048, CTXL = 256, FFN = 4096, INW = 2304;
constexpr int MLAT = NB * SEQ, MCTX = NB * CTXL, MALL = MLAT + MCTX;
constexpr float EPSN = 1e-6f, LOG2E = 1.4426950408889634f, NEGBIG = -1e30f;
constexpr int MODW = 6 * DM;
constexpr size_t MiB = (size_t)1 << 20;
constexpr size_t WS_MOD = 0;
constexpr size_t WS_GAIN = 512 * 1024;
constexpr size_t WS_BAR = 768 * 1024;
constexpr size_t WS_WIN = 1 * MiB;
constexpr size_t WS_WO = 10 * MiB;
constexpr size_t WS_W1 = 14 * MiB;
constexpr size_t WS_W2 = 30 * MiB;
constexpr size_t WS_CTX = 46 * MiB;
constexpr size_t WS_HN2 = 54 * MiB;
constexpr size_t WS_HN = 207 * MiB;
constexpr size_t WS_H1 = 90 * MiB;
constexpr size_t WS_PROJ = 90 * MiB;
constexpr size_t WS_OB = 171 * MiB;
constexpr size_t WS_RS1 = 243 * MiB;
constexpr size_t WS_RS2 = 245 * MiB;
constexpr size_t WS_BIN = 247 * MiB;
constexpr size_t WS_B1 = 248 * MiB;
constexpr size_t WS_END = 249 * MiB;

__device__ __forceinline__ float half_sum(float v) { v += pg8::shx<1>(v); v += pg8::shx<2>(v); v += pg8::shx<4>(v); v += pg8::shx<8>(v); v += pg8::shx<16>(v); return v; }
__device__ __forceinline__ float wave_sum(float v) { return pg8::sum_halves(half_sum(v)); }
__device__ __forceinline__ unsigned f2bf(float f) { unsigned u = __builtin_bit_cast(unsigned, f); return (u + 0x7fffu + ((u >> 16) & 1u)) >> 16; }
__device__ __forceinline__ unsigned pk2(float lo, float hi) { return f2bf(lo) | (f2bf(hi) << 16); }
__device__ __forceinline__ float bf_lo(unsigned u) { return __builtin_bit_cast(float, u << 16); }
__device__ __forceinline__ float bf_hi(unsigned u) { return __builtin_bit_cast(float, u & 0xffff0000u); }

namespace att {
constexpr int KROWB = 144, VROWB = 128, WL_V = 64 * KROWB, WL_A = WL_V + 64 * VROWB, WL_TAB = WL_A + 128 + 192, WAVE_LDS = WL_TAB + 15 * 32 * 4;
typedef float f32x2_t __attribute__((ext_vector_type(2))); typedef __bf16 bf16x2_t __attribute__((ext_vector_type(2)));
typedef short v4i16_t __attribute__((ext_vector_type(4)));
__device__ __forceinline__ unsigned cvtpk(float lo, float hi) { f32x2_t v = {lo, hi}; bf16x2_t b = __builtin_convertvector(v, bf16x2_t); return __builtin_bit_cast(unsigned, b); }
__device__ __forceinline__ s16x4 vtr(LAS const unsigned char* p) { return __builtin_bit_cast(s16x4, __builtin_amdgcn_ds_read_tr16_b64_v4i16((LAS v4i16_t*)p)); }
struct AU { int qrow0, qcol, kcol, vcol, ocol, ctxrow0, nloc, locrow0, a0, a1; float m0, l0; const float* rpb; };
template <int KIND> __device__ __forceinline__ void attn_unit(LAS unsigned char* wl, const bf16_t* __restrict__ proj, bf16_t* __restrict__ obuf, const AU u, const int lane) {
    const int r32 = lane & 31, hi = lane >> 5;
    LAS float* sc = (LAS float*)(wl + WL_A);
    LAS float* tab = (LAS float*)(wl + WL_TAB);
    bf16x8 qr[4];
    { const bf16_t* qp = proj + (size_t)(u.qrow0 + r32) * INW + u.qcol + hi * 8;
#pragma unroll
      for (int d0 = 0; d0 < 4; ++d0) qr[d0] = *(const bf16x8*)(qp + d0 * 16); }
    if (KIND == 0) { for (int i = lane; i < 15 * 31; i += 64) { const int a = i / 31, b = i - a * 31; tab[a * 32 + b] = u.rpb[i] * LOG2E; } }
    f32x16 o0, o1;
#pragma unroll
    for (int r = 0; r < 16; ++r) { o0[r] = 0.f; o1[r] = 0.f; }
    float m = u.m0, l = (hi == 0) ? u.l0 : 0.f;
    const int nt = 4 + u.nloc;
    const int lrow = lane >> 3, lch = lane & 7;
    u32x4 kreg[8], vreg[8];
#define ATT_LOAD_TILE(t) do { const int row0_ = ((t) < 4) ? u.ctxrow0 + 64 * (t) : u.locrow0 + 64 * ((t) - 4); const bf16_t* bp_ = proj + (size_t)(row0_ + lrow) * INW + lch * 8; \
        _Pragma("unroll") for (int i_ = 0; i_ < 8; ++i_) { kreg[i_] = *(const u32x4*)(bp_ + (size_t)i_ * 8 * INW + u.kcol); vreg[i_] = *(const u32x4*)(bp_ + (size_t)i_ * 8 * INW + u.vcol); } } while (0)
    ATT_LOAD_TILE(0);
    LAS unsigned char* kw = wl + lrow * KROWB + lch * 16;
    LAS unsigned char* vw = wl + WL_V + lrow * VROWB + lch * 16;
    LAS const unsigned char* kf = wl + r32 * KROWB + hi * 16;
    LAS const unsigned char* vf = wl + WL_V + (4 * hi + ((lane & 15) >> 2)) * VROWB + ((lane >> 4) & 1) * 32 + (lane & 3) * 8;
    for (int t = 0; t < nt; ++t) {
#pragma unroll
        for (int i = 0; i < 8; ++i) { *(LAS u32x4*)(kw + i * 8 * KROWB) = kreg[i]; *(LAS u32x4*)(vw + i * 8 * VROWB) = vreg[i]; }
        if (t + 1 < nt) ATT_LOAD_TILE(t + 1);
        f32x16 p0, p1;
#pragma unroll
        for (int r = 0; r < 16; ++r) { p0[r] = 0.f; p1[r] = 0.f; }
#pragma unroll
        for (int d0 = 0; d0 < 4; ++d0) {
            const bf16x8 a0 = *(LAS const bf16x8*)(kf + d0 * 32), a1 = *(LAS const bf16x8*)(kf + 32 * KROWB + d0 * 32);
            p0 = __builtin_amdgcn_mfma_f32_32x32x16_bf16(a0, qr[d0], p0, 0, 0, 0);
            p1 = __builtin_amdgcn_mfma_f32_32x32x16_bf16(a1, qr[d0], p1, 0, 0, 0);
        }
        if (KIND == 0) { if (t >= 4) {
            const int dr = u.a0 + (t - 4), qc = u.a1 + r32; const int cs = min(max(qc - 8, 0), 48);
            const int kb = 4 * hi - cs; LAS const float* tb = tab + dr * 32 + 15 - qc + 4 * hi;
#pragma unroll
            for (int r = 0; r < 16; ++r) { const int kc = (r & 3) + 8 * (r >> 2);
                p0[r] = ((unsigned)(kb + kc) < 16u) ? p0[r] + tb[kc] : NEGBIG;
                p1[r] = ((unsigned)(kb + kc + 32) < 16u) ? p1[r] + tb[kc + 32] : NEGBIG; } } }
        if (KIND == 1) { if (t >= 4) {
            const int d0_ = u.a0 + 64 * (t - 4) + 4 * hi - r32 + 128;
#pragma unroll
            for (int r = 0; r < 16; ++r) { const int kc = (r & 3) + 8 * (r >> 2);
                p0[r] = ((unsigned)(d0_ + kc) <= 256u) ? p0[r] : NEGBIG;
                p1[r] = ((unsigned)(d0_ + kc + 32) <= 256u) ? p1[r] : NEGBIG; } } }
        float mx = fmaxf(p0[0], p1[0]);
#pragma unroll
        for (int r = 1; r < 16; ++r) mx = fmaxf(mx, fmaxf(p0[r], p1[r]));
        mx = pg8::max_halves(mx);
        const float mnew = fmaxf(m, mx); const float alpha = __builtin_amdgcn_exp2f(m - mnew); m = mnew;
        float rs = 0.f;
#pragma unroll
        for (int r = 0; r < 16; ++r) { p0[r] = __builtin_amdgcn_exp2f(p0[r] - mnew); p1[r] = __builtin_amdgcn_exp2f(p1[r] - mnew); rs += p0[r] + p1[r]; }
        l = l * alpha + rs;
        if (hi == 0) sc[r32] = alpha;
#pragma unroll
        for (int g = 0; g < 4; ++g) { const f32x4 a = *(LAS const f32x4*)(sc + 8 * g + 4 * hi);
#pragma unroll
            for (int i = 0; i < 4; ++i) { o0[4 * g + i] *= a[i]; o1[4 * g + i] *= a[i]; } }
        u32x4 pa[4];
#pragma unroll
        for (int j = 0; j < 4; ++j) { pa[0][j] = cvtpk(p0[2 * j], p0[2 * j + 1]); pa[1][j] = cvtpk(p0[8 + 2 * j], p0[8 + 2 * j + 1]); pa[2][j] = cvtpk(p1[2 * j], p1[2 * j + 1]); pa[3][j] = cvtpk(p1[8 + 2 * j], p1[8 + 2 * j + 1]); }
#pragma unroll
        for (int ks = 0; ks < 4; ++ks) {
            const s16x4 l0 = vtr(vf + ks * 16 * VROWB), h0 = vtr(vf + ks * 16 * VROWB + 8 * VROWB);
            const s16x4 l1 = vtr(vf + ks * 16 * VROWB + 64), h1 = vtr(vf + ks * 16 * VROWB + 8 * VROWB + 64);
            const bf16x8 b0 = (bf16x8){l0[0], l0[1], l0[2], l0[3], h0[0], h0[1], h0[2], h0[3]}, b1 = (bf16x8){l1[0], l1[1], l1[2], l1[3], h1[0], h1[1], h1[2], h1[3]};
            o0 = __builtin_amdgcn_mfma_f32_32x32x16_bf16(__builtin_bit_cast(bf16x8, pa[ks]), b0, o0, 0, 0, 0);
            o1 = __builtin_amdgcn_mfma_f32_32x32x16_bf16(__builtin_bit_cast(bf16x8, pa[ks]), b1, o1, 0, 0, 0);
        }
    }
#undef ATT_LOAD_TILE
    const float lt = pg8::sum_halves(l);
    if (hi == 0) sc[r32] = 1.0f / lt;
    bf16_t* ob = obuf + (size_t)u.qrow0 * DM + u.ocol + r32;
#pragma unroll
    for (int g = 0; g < 4; ++g) { const f32x4 a = *(LAS const f32x4*)(sc + 8 * g + 4 * hi);
#pragma unroll
        for (int i = 0; i < 4; ++i) { const int q = i + 8 * g + 4 * hi; bf16_t* op = ob + (size_t)q * DM;
            op[0] = (bf16_t)f2bf(o0[4 * g + i] * a[i]); op[32] = (bf16_t)f2bf(o1[4 * g + i] * a[i]); } }
}

__device__ __forceinline__ void attn_phase(LAS unsigned char* wl, const bf16_t* proj, bf16_t* obuf, const float* rpb_l, const float* sink_l, bool with_ctx, int gw, int ngw, int lane) {
    const int total = 2048 + 4096 + (with_ctx ? 768 : 0);
    for (int i0 = gw; i0 < total; i0 += ngw) {
        int i = i0; AU u;
        if (i < 2048) {
            const int half = i & 1, h = (i >> 1) & 3, r = (i >> 3) & 31, b = i >> 8; const int rs = min(max(r - 4, 0), 24);
            u.qrow0 = b * SEQ + r * 64 + 32 * half; u.qcol = 64 * h; u.kcol = 256 + 64 * h; u.vcol = 512 + 64 * h; u.ocol = 64 * h; u.ctxrow0 = MLAT + b * CTXL;
            u.nloc = 8; u.locrow0 = b * SEQ + rs * 64; u.a0 = rs - r + 7; u.a1 = 32 * half; u.m0 = NEGBIG; u.l0 = 0.f; u.rpb = rpb_l + h * (15 * 31);
            attn_unit<0>(wl, proj, obuf, u, lane);
            continue;
        }
        i -= 2048;
        if (i < 4096) {
            const int ch = i & 63, h = (i >> 6) & 7, b = i >> 9; const int qpos0 = 32 * ch;
            const int kt0 = max(0, (qpos0 - 128) >> 6), kt1 = min(31, (qpos0 + 159) >> 6);
            u.qrow0 = b * SEQ + qpos0; u.qcol = 1536 + 64 * h; u.kcol = 2048 + 64 * (h >> 2); u.vcol = 2176 + 64 * (h >> 2); u.ocol = 512 + 64 * h; u.ctxrow0 = MLAT + b * CTXL;
            u.nloc = kt1 - kt0 + 1; u.locrow0 = b * SEQ + 64 * kt0; u.a0 = 64 * kt0 - qpos0; u.a1 = 0; u.m0 = sink_l[h] * LOG2E; u.l0 = 1.f; u.rpb = nullptr;
            attn_unit<1>(wl, proj, obuf, u, lane);
            continue;
        }
        i -= 4096;
        if (i < 256) {
            const int ch = i & 7, h = (i >> 3) & 3, b = i >> 5;
            u.qrow0 = MLAT + b * CTXL + 32 * ch; u.qcol = 64 * h; u.kcol = 256 + 64 * h; u.vcol = 512 + 64 * h; u.ocol = 64 * h; u.m0 = NEGBIG; u.l0 = 0.f; u.ctxrow0 = MLAT + b * CTXL;
        } else {
            i -= 256; const int ch = i & 7, h = (i >> 3) & 7, b = i >> 6;
            u.qrow0 = MLAT + b * CTXL + 32 * ch; u.qcol = 1536 + 64 * h; u.kcol = 2048 + 64 * (h >> 2); u.vcol = 2176 + 64 * (h >> 2); u.ocol = 512 + 64 * h; u.m0 = sink_l[h] * LOG2E; u.l0 = 1.f; u.ctxrow0 = MLAT + b * CTXL;
        }
        u.nloc = 0; u.locrow0 = 0; u.a0 = 0; u.a1 = 0; u.rpb = nullptr;
        attn_unit<2>(wl, proj, obuf, u, lane);
    }
}
}

__device__ __forceinline__ void prep_pass(const float* xlat, const float* xctx, const float* g, const float* modl, int scoff, bf16_t* hn, float* rs, int gw, int ngw, int lane) {
    for (int m = gw; m < MALL; m += ngw) {
        const bool lat = m < MLAT; const float* xr = lat ? xlat + (size_t)m * DM : xctx + (size_t)(m - MLAT) * DM; const int b = lat ? (m >> 11) : 8;
        f32x4 v[4]; float ss = 0.f;
#pragma unroll
        for (int j = 0; j < 4; ++j) { v[j] = *(const f32x4*)(xr + 4 * lane + 256 * j); ss += (v[j][0] * v[j][0] + v[j][1] * v[j][1]) + (v[j][2] * v[j][2] + v[j][3] * v[j][3]); }
        ss = wave_sum(ss);
        if (lane < 16) rs[(size_t)m * 16 + lane] = (lane == 0) ? ss : 0.f;
        const float* mb = modl + (size_t)b * MODW;
#pragma unroll
        for (int j = 0; j < 4; ++j) { const int c = 4 * lane + 256 * j;
            const f32x4 gg = *(const f32x4*)(g + c), scv = *(const f32x4*)(mb + scoff + c);
            const f32x4 y = v[j] * gg * (scv + 1.0f);
            u32x2 w; w.x = pk2(y[0], y[1]); w.y = pk2(y[2], y[3]);
            *(u32x2*)(hn + (size_t)m * DM + c) = w; }
    }
}
__device__ __forceinline__ void bias_cols(const bf16_t* Wt, int N, const float* modl, int shoff, float* bias, int gw, int ngw, int lane) {
    for (int n = gw; n < N; n += ngw) {
        const u32x4 w0 = *(const u32x4*)(Wt + (size_t)n * DM + 16 * lane), w1 = *(const u32x4*)(Wt + (size_t)n * DM + 16 * lane + 8);
        float wf[16];
#pragma unroll
        for (int j = 0; j < 4; ++j) { wf[2 * j] = bf_lo(w0[j]); wf[2 * j + 1] = bf_hi(w0[j]); wf[8 + 2 * j] = bf_lo(w1[j]); wf[8 + 2 * j + 1] = bf_hi(w1[j]); }
#pragma unroll 1
        for (int b = 0; b < 9; ++b) { const float* sp = modl + (size_t)b * MODW + shoff + 16 * lane; float s = 0.f;
#pragma unroll
            for (int j = 0; j < 4; ++j) { const f32x4 x = *(const f32x4*)(sp + 4 * j); s += (x[0] * wf[4 * j] + x[1] * wf[4 * j + 1]) + (x[2] * wf[4 * j + 2] + x[3] * wf[4 * j + 3]); }
            s = wave_sum(s);
            if (lane == 0) bias[(size_t)b * N + n] = s; }
    }
}

__device__ __forceinline__ void mix_pass(const bf16_t* proj, const bf16_t* obuf, const float* convw, const float* convb, const float* gout, bf16_t* abuf, int nrows, int gw, int ngw, int lane) {
    for (int m = gw; m < nrows; m += ngw) {
        float va[8];
        if (lane < 32) {
            const u32x4 raw = *(const u32x4*)(obuf + (size_t)m * DM + 8 * lane);
#pragma unroll
            for (int j = 0; j < 4; ++j) { va[2 * j] = bf_lo(raw[j]); va[2 * j + 1] = bf_hi(raw[j]); }
        } else {
            const int c = 8 * (lane - 32); const bool lat = m < MLAT; const int t = lat ? (m & (SEQ - 1)) : ((m - MLAT) & (CTXL - 1)); const int L = lat ? SEQ : CTXL;
            const bf16_t* pr = proj + (size_t)m * INW;
            const u32x4 cx = *(const u32x4*)(pr + 768 + c), cb = *(const u32x4*)(pr + 1024 + c), cc = *(const u32x4*)(pr + 1280 + c);
            u32x4 pxm = {0u, 0u, 0u, 0u}, pcm = {0u, 0u, 0u, 0u}, pxp = {0u, 0u, 0u, 0u}, pcp = {0u, 0u, 0u, 0u};
            if (t > 0) { pxm = *(const u32x4*)(pr - INW + 768 + c); pcm = *(const u32x4*)(pr - INW + 1280 + c); }
            if (t < L - 1) { pxp = *(const u32x4*)(pr + INW + 768 + c); pcp = *(const u32x4*)(pr + INW + 1280 + c); }
            const f32x4 w0a = *(const f32x4*)(convw + c), w0b = *(const f32x4*)(convw + c + 4), w1a = *(const f32x4*)(convw + 256 + c), w1b = *(const f32x4*)(convw + 256 + c + 4),
                        w2a = *(const f32x4*)(convw + 512 + c), w2b = *(const f32x4*)(convw + 512 + c + 4), bba = *(const f32x4*)(convb + c), bbb = *(const f32x4*)(convb + c + 4);
#pragma unroll
            for (int j = 0; j < 4; ++j) {
                const float w0l = j < 2 ? w0a[2 * j] : w0b[2 * j - 4], w0h = j < 2 ? w0a[2 * j + 1] : w0b[2 * j - 3];
                const float w1l = j < 2 ? w1a[2 * j] : w1b[2 * j - 4], w1h = j < 2 ? w1a[2 * j + 1] : w1b[2 * j - 3];
                const float w2l = j < 2 ? w2a[2 * j] : w2b[2 * j - 4], w2h = j < 2 ? w2a[2 * j + 1] : w2b[2 * j - 3];
                const float bl = j < 2 ? bba[2 * j] : bbb[2 * j - 4], bh = j < 2 ? bba[2 * j + 1] : bbb[2 * j - 3];
                const float ul = bf_lo(cc[j]) * bf_lo(cx[j]), uh = bf_hi(cc[j]) * bf_hi(cx[j]);
                const float uml = bf_lo(pcm[j]) * bf_lo(pxm[j]), umh = bf_hi(pcm[j]) * bf_hi(pxm[j]);
                const float upl = bf_lo(pcp[j]) * bf_lo(pxp[j]), uph = bf_hi(pcp[j]) * bf_hi(pxp[j]);
                va[2 * j] = bf_lo(cb[j]) * (bl + w0l * uml + w1l * ul + w2l * upl);
                va[2 * j + 1] = bf_hi(cb[j]) * (bh + w0h * umh + w1h * uh + w2h * uph);
            }
        }
        float ssa = 0.f;
#pragma unroll
        for (int j = 0; j < 8; ++j) ssa += va[j] * va[j];
        ssa = half_sum(ssa); const float rsa = 1.0f / sqrtf(ssa * (1.0f / 256.0f) + EPSN);
        { const f32x4 g0 = *(const f32x4*)(gout + 8 * lane), g1 = *(const f32x4*)(gout + 8 * lane + 4);
          u32x4 w; w.x = pk2(va[0] * rsa * g0[0], va[1] * rsa * g0[1]); w.y = pk2(va[2] * rsa * g0[2], va[3] * rsa * g0[3]); w.z = pk2(va[4] * rsa * g1[0], va[5] * rsa * g1[1]); w.w = pk2(va[6] * rsa * g1[2], va[7] * rsa * g1[3]);
          *(u32x4*)(abuf + (size_t)m * DM + 8 * lane) = w; }
        float vb[8];
        { const u32x4 raw = *(const u32x4*)(obuf + (size_t)m * DM + 512 + 8 * lane);
#pragma unroll
          for (int j = 0; j < 4; ++j) { vb[2 * j] = bf_lo(raw[j]); vb[2 * j + 1] = bf_hi(raw[j]); } }
        float ssb = 0.f;
#pragma unroll
        for (int j = 0; j < 8; ++j) ssb += vb[j] * vb[j];
        ssb = wave_sum(ssb); const float rsb = 1.0f / sqrtf(ssb * (1.0f / 512.0f) + EPSN);
        { const f32x4 g0 = *(const f32x4*)(gout + 512 + 8 * lane), g1 = *(const f32x4*)(gout + 512 + 8 * lane + 4);
          u32x4 w; w.x = pk2(vb[0] * rsb * g0[0], vb[1] * rsb * g0[1]); w.y = pk2(vb[2] * rsb * g0[2], vb[3] * rsb * g0[3]); w.z = pk2(vb[4] * rsb * g1[0], vb[5] * rsb * g1[1]); w.w = pk2(vb[6] * rsb * g1[2], vb[7] * rsb * g1[3]);
          *(u32x4*)(abuf + (size_t)m * DM + 512 + 8 * lane) = w; }
    }
}

__device__ __forceinline__ void mod_item(int item, const float* c, const float* cctx, const float* wmod, const float* bmod, float* mod, LAS unsigned char* lds, int tid, int wave, int lane) {
    LAS float* sl = (LAS float*)lds;
    LAS float* red = (LAS float*)(lds + 9 * 1024 * 4);
    const int l = item / 96, n0 = (item % 96) * 64;
    for (int i = tid; i < 9 * 1024; i += 512) { const int r = i >> 10, k = i & 1023; const float v = r < 8 ? c[r * 1024 + k] : cctx[k]; sl[i] = v / (1.0f + __expf(-v)); }
    __syncthreads();
    float acc[9];
#pragma unroll
    for (int r = 0; r < 9; ++r) acc[r] = 0.f;
    const float* wp = wmod + ((size_t)l * 1024 + wave * 128) * MODW + n0 + lane;
#pragma unroll 8
    for (int k = 0; k < 128; ++k) { const float wv = wp[(size_t)k * MODW];
#pragma unroll
        for (int r = 0; r < 9; ++r) acc[r] += sl[r * 1024 + wave * 128 + k] * wv; }
#pragma unroll
    for (int r = 0; r < 9; ++r) red[(wave * 9 + r) * 64 + lane] = acc[r];
    __syncthreads();
    for (int i = tid; i < 9 * 64; i += 512) { const int r = i >> 6, ln = i & 63; float s = bmod[l * MODW + n0 + ln];
#pragma unroll
        for (int w = 0; w < 8; ++w) s += red[(w * 9 + r) * 64 + ln];
        mod[((size_t)l * 9 + r) * MODW + n0 + ln] = s; }
    __syncthreads();
}
__device__ __forceinline__ int rowmap_in(int c) {
    const int pn = c >> 8; if (pn >= 2 && pn <= 5) return c;
    const int wc = (c >> 6) & 3, d = c & 63, bj = d >> 5; const bool vhead = (pn == 8) && (wc >= 2);
    int n, fq; const int e = d & 3;
    if (!vhead) { n = (d >> 4) & 1; fq = (d >> 2) & 3; } else { fq = (d >> 3) & 3; n = (d >> 2) & 1; }
    return pn * 256 + bj * 128 + wc * 32 + fq * 8 + n * 4 + e;
}
template <bool MAPIN> __device__ __forceinline__ void transpose_item(const float* W, int K, int N, bf16_t* WT, LAS float* scr, int item, int lane) {
    const int nblk = N / 32, kb = item / nblk, nb = item % nblk, k0 = 64 * kb, n0 = 32 * nb;
#pragma unroll 8
    for (int i = 0; i < 32; ++i) { const int kk = 2 * i + (lane >> 5); scr[kk * 33 + (lane & 31)] = W[(size_t)(k0 + kk) * N + n0 + (lane & 31)]; }
    asm volatile("s_waitcnt lgkmcnt(0)" ::: "memory");
    const int c = lane & 7;
#pragma unroll
    for (int j = 0; j < 4; ++j) { const int n = (lane >> 3) + 8 * j; const LAS float* s = scr + (8 * c) * 33 + n;
        u32x4 o; o.x = pk2(s[0 * 33], s[1 * 33]); o.y = pk2(s[2 * 33], s[3 * 33]); o.z = pk2(s[4 * 33], s[5 * 33]); o.w = pk2(s[6 * 33], s[7 * 33]);
        const int orow = MAPIN ? rowmap_in(n0 + n) : (n0 + n);
        *(u32x4*)(WT + (size_t)orow * K + k0 + 8 * c) = o; }
    asm volatile("s_waitcnt lgkmcnt(0)" ::: "memory");
}

#define XB_TMO      128
#define XB_XCNT(j)  (256  + 64 * (j))
#define XB_XSUB(j)  (1280 + 64 * (j))
#define XB_XGEN(j)  (2304 + 64 * (j))
#define XB_TOP      3328
#define XB_TOPGEN   3392
#define XCD_BAR_WORDS 3456
#define XB_SPIN_CAP (1u << 18)

__device__ __forceinline__ unsigned xb_ld(unsigned* p)              { return __hip_atomic_load(p, __ATOMIC_RELAXED, __HIP_MEMORY_SCOPE_AGENT); }
__device__ __forceinline__ unsigned xb_add(unsigned* p, unsigned v) { return __hip_atomic_fetch_add(p, v, __ATOMIC_RELAXED, __HIP_MEMORY_SCOPE_AGENT); }
__device__ __forceinline__ unsigned xb_xcc_id() { return (unsigned)__builtin_amdgcn_s_getreg((3 << 11) | 20) & 0xFu; }
#define XB_SPIN(cond, bar) do { unsigned _sp = 0; while (cond) { __builtin_amdgcn_s_sleep(1); \
    if ((++_sp & 255u) == 0u) { if (xb_ld(&(bar)[XB_TMO])) break; if (_sp > XB_SPIN_CAP) { atomicAdd(&(bar)[XB_TMO], 1u); break; } } } } while (0)

struct XcdBarrier {
    unsigned* bar; unsigned x;
    volatile LAS unsigned* st;
};

__device__ __forceinline__ XcdBarrier xcd_barrier_post(unsigned* bar, volatile LAS unsigned* st) {
    XcdBarrier b; b.bar = bar; b.x = xb_xcc_id(); b.st = st;
    if (threadIdx.x == 0) (void)xb_add(&bar[XB_XCNT(b.x)], 1u);
    return b;
}
__device__ __forceinline__ void xcd_barrier_complete(unsigned* bar, unsigned x, unsigned& nloc, unsigned& nx) {
    const unsigned G = gridDim.x * gridDim.y * gridDim.z;
    unsigned sum, cnt, mine, sp = 0u;
    for (;;) {
        sum = 0u; cnt = 0u; mine = 0u;
#pragma unroll
        for (unsigned j = 0; j < 16; ++j) { const unsigned c = xb_ld(&bar[XB_XCNT(j)]); sum += c; cnt += (c > 0u) ? 1u : 0u; mine = (j == x) ? c : mine; }
        if (sum == G) break;
        __builtin_amdgcn_s_sleep(1);
        if ((++sp & 255u) == 0u) { if (xb_ld(&bar[XB_TMO])) break; if (sp > XB_SPIN_CAP) { atomicAdd(&bar[XB_TMO], 1u); break; } }
    }
    nloc = mine > 0u ? mine : 1u; nx = cnt > 0u ? cnt : 1u;
}

__device__ __forceinline__ void xcd_barrier(const XcdBarrier& b) {
    asm volatile("s_waitcnt vmcnt(0)" ::: "memory");
    __syncthreads();
    if (threadIdx.x == 0) {
        unsigned* bar = b.bar;
        __builtin_amdgcn_s_waitcnt(0);
        unsigned nloc = b.st[0], nx = b.st[1];
        if (nloc == 0u) { xcd_barrier_complete(bar, b.x, nloc, nx); b.st[0] = nloc; b.st[1] = nx; }
        const unsigned old = xb_add(&bar[XB_XSUB(b.x)], 1u);
        const unsigned gen = old / nloc;
        if (old + 1u == (gen + 1u) * nloc) {
            __builtin_amdgcn_fence(__ATOMIC_RELEASE, "agent");
            asm volatile("s_waitcnt vmcnt(0)" ::: "memory");
            const unsigned og = xb_add(&bar[XB_TOP], 1u);
            const unsigned tg = og / nx;
            if (og + 1u == (tg + 1u) * nx) xb_add(&bar[XB_TOPGEN], 1u);
            else XB_SPIN(xb_ld(&bar[XB_TOPGEN]) == tg, bar);
            __builtin_amdgcn_fence(__ATOMIC_ACQUIRE, "agent");
            xb_add(&bar[XB_XGEN(b.x)], 1u);
            asm volatile("s_waitcnt vmcnt(0)" ::: "memory");
        } else {
            XB_SPIN(xb_ld(&bar[XB_XGEN(b.x)]) == gen, bar);
            __builtin_amdgcn_fence(__ATOMIC_ACQUIRE, "agent");
            asm volatile("s_waitcnt vmcnt(0)" ::: "memory");
        }
    }
    __syncthreads();
}

constexpr int LDS_ST_OFF = 8 * att::WAVE_LDS + 512;
constexpr int LDS_BYTES = LDS_ST_OFF + 64;
static_assert(LDS_BYTES <= 160 * 1024 && LDS_BYTES >= pg8::STAGE_BYTES, "LDS budget");
constexpr int N_PHASES = 14;
struct Params { const float* in[21]; float* out; unsigned char* ws; int ph_lo, ph_hi; };

#ifndef REPMASK
#define REPMASK 0
#endif
#ifndef EXTRA_SYNC
#define EXTRA_SYNC 0
#endif
__global__ void __launch_bounds__(512, 2) fwd_kernel(Params P) {
    extern __shared__ __attribute__((aligned(16))) unsigned char lds_raw[];
    LAS unsigned char* lds = (LAS unsigned char*)lds_raw;
    {   volatile LAS unsigned* bst0 = (volatile LAS unsigned*)(lds + LDS_ST_OFF);
        if (threadIdx.x < 16) bst0[threadIdx.x] = 0u;
        __syncthreads();
        (void)xcd_barrier_post((unsigned*)(P.ws + WS_BAR), bst0); }
#define GRID_SYNC() do { unsigned* bp_ = (unsigned*)(P.ws + WS_BAR); asm volatile("" : "+s"(bp_)); XcdBarrier b_; b_.bar = bp_; b_.x = xb_xcc_id(); b_.st = (volatile LAS unsigned*)(lds + LDS_ST_OFF); xcd_barrier(b_); } while (0)
#define LANE_OPAQUE int ln_ = pg8::lane_id(); asm volatile("" : "+v"(ln_)); const int tid_ = wave * 64 + ln_; (void)tid_
#define WSP(T, off) ((T*)(ws + (off)))
#define MODL (WSP(const float, WS_MOD) + (size_t)ly * 9 * MODW)
#define XL ((ly == 0) ? P.in[0] : (const float*)P.out)
#define CL ((ly == 0) ? P.in[2] : WSP(const float, WS_CTX))
#define MROWS ((ly == 0) ? MALL : MLAT)
    const int ph_hi = P.ph_hi;
    const int wave = __builtin_amdgcn_readfirstlane(threadIdx.x >> 6);
#pragma unroll 1
    for (int ph = P.ph_lo; ph < ph_hi; ++ph) {
        int phv = ph; asm volatile("" : "+s"(phv));
        int kind = 0, ly = 0;
        if (phv >= 1) { const int idx = phv - 1; if (idx < 7) { kind = idx + 1 + (idx >= 5 ? 1 : 0); } else { const int j = idx - 7; ly = 1; kind = j + 2 + (j >= 4 ? 1 : 0); } }
        const int G = gridDim.x, bx = blockIdx.x; const int vcu = (G % 8 == 0) ? (bx % 8) * (G / 8) + bx / 8 : bx; const int gw = vcu * 8 + wave, ngw = G * 8;
        unsigned char* ws = P.ws;
#pragma unroll 1
        for (int rep_ = 0; rep_ <= ((REPMASK >> kind) & 1); ++rep_) {
        if (rep_) GRID_SYNC();
        switch (kind) {
        case 0: { LANE_OPAQUE;
            if (bx == G - 1) { for (int i = tid_; i < 512; i += 512) { const int l2 = i >> 8, k = (i >> 6) & 3, d = i & 63; const float* src = P.in[k == 0 ? 9 : k == 1 ? 10 : k == 2 ? 14 : 15]; WSP(float, WS_GAIN)[i] = src[l2 * 64 + d]; } }
            if (bx < 192) mod_item(bx, P.in[1], P.in[3], P.in[4], P.in[5], WSP(float, WS_MOD), lds, tid_, wave, ln_);
            LAS float* scr = (LAS float*)(lds + wave * 16384);
            constexpr int I_IN = 16 * (INW / 32), I_O = 16 * (DM / 32), I_1 = 16 * (FFN / 32), I_2 = 64 * (DM / 32), I_L = I_IN + I_O + I_1 + I_2;
            for (int it = gw; it < 2 * I_L; it += ngw) {
                const int l2 = it / I_L; int r = it - l2 * I_L;
                if (r < I_IN) { transpose_item<true>(P.in[8] + (size_t)l2 * DM * INW, DM, INW, WSP(bf16_t, WS_WIN) + (size_t)l2 * INW * DM, scr, r, ln_); continue; } r -= I_IN;
                if (r < I_O) { transpose_item<false>(P.in[18] + (size_t)l2 * DM * DM, DM, DM, WSP(bf16_t, WS_WO) + (size_t)l2 * DM * DM, scr, r, ln_); continue; } r -= I_O;
                if (r < I_1) { transpose_item<false>(P.in[19] + (size_t)l2 * DM * FFN, DM, FFN, WSP(bf16_t, WS_W1) + (size_t)l2 * FFN * DM, scr, r, ln_); continue; } r -= I_1;
                transpose_item<false>(P.in[20] + (size_t)l2 * FFN * DM, FFN, DM, WSP(bf16_t, WS_W2) + (size_t)l2 * DM * FFN, scr, r, ln_);
            }
        } break;
        case 1: { LANE_OPAQUE;
            prep_pass(P.in[0], P.in[2], P.in[6], WSP(const float, WS_MOD), DM, WSP(bf16_t, WS_HN2), WSP(float, WS_RS1), gw, ngw, ln_);
#pragma unroll 1
            for (int l2 = 0; l2 < 2; ++l2) { const float* m2 = WSP(const float, WS_MOD) + (size_t)l2 * 9 * MODW;
                bias_cols(WSP(bf16_t, WS_WIN) + (size_t)l2 * INW * DM, INW, m2, 0, WSP(float, WS_BIN) + (size_t)l2 * 9 * INW, gw, ngw, ln_);
                bias_cols(WSP(bf16_t, WS_W1) + (size_t)l2 * FFN * DM, FFN, m2, 3 * DM, WSP(float, WS_B1) + (size_t)l2 * 9 * FFN, gw, ngw, ln_); }
        } break;
        case 2: { LANE_OPAQUE;
            pg8::Gemm g{WSP(bf16_t, WS_HN2), WSP(bf16_t, WS_WIN) + (size_t)ly * INW * DM, MALL, INW, DM}; pg8::StaticOrder S; S.init(MALL, INW, G, bx);
            pg8::EpiProj E{WSP(bf16_t, WS_PROJ), WSP(const float, WS_GAIN) + ly * 256, WSP(const float, WS_RS1), WSP(const float, WS_BIN) + (size_t)ly * 9 * INW};
            pg8::gemm_phase<pg8::EpiProj, pg8::StaticOrder, true, true>(lds, g, S, E, wave);
        } break;
        case 3: { LANE_OPAQUE;
            att::attn_phase(lds + wave * att::WAVE_LDS + 256, WSP(bf16_t, WS_PROJ), WSP(bf16_t, WS_OB), P.in[11] + (size_t)ly * 4 * 15 * 31, P.in[16] + ly * 8, ly == 0, gw, ngw, ln_);
        } break;
        case 4: { LANE_OPAQUE;
            mix_pass(WSP(bf16_t, WS_PROJ), WSP(bf16_t, WS_OB), P.in[12] + (size_t)ly * 3 * 256, P.in[13] + ly * 256, P.in[17] + ly * DM, WSP(bf16_t, WS_HN), MROWS, gw, ngw, ln_);
        } break;
        case 5: { LANE_OPAQUE;
            pg8::Gemm g{WSP(bf16_t, WS_HN), WSP(bf16_t, WS_WO) + (size_t)ly * DM * DM, MROWS, DM, DM}; pg8::StaticOrder S; S.init(MROWS, DM, G, bx);
            pg8::EpiResid E{XL, CL, P.out, WSP(float, WS_CTX), MODL + 2 * DM, WSP(bf16_t, WS_HN2), P.in[7] + ly * DM, MODL + 4 * DM, WSP(float, WS_RS2)};
            pg8::gemm_phase<pg8::EpiResid, pg8::StaticOrder, true, true>(lds, g, S, E, wave);
        } break;
        case 7: { LANE_OPAQUE;
            pg8::Gemm g{WSP(bf16_t, WS_HN2), WSP(bf16_t, WS_W1) + (size_t)ly * FFN * DM, MROWS, FFN, DM}; pg8::StaticOrder S; S.init(MROWS, FFN, G, bx);
            pg8::EpiFc1 E{WSP(bf16_t, WS_H1), FFN, WSP(const float, WS_RS2), WSP(const float, WS_B1) + (size_t)ly * 9 * FFN};
            pg8::gemm_phase<pg8::EpiFc1, pg8::StaticOrder, true, true>(lds, g, S, E, wave);
        } break;
        default: { LANE_OPAQUE;
            pg8::Gemm g{WSP(bf16_t, WS_H1), WSP(bf16_t, WS_W2) + (size_t)ly * DM * FFN, MROWS, DM, FFN}; pg8::StaticOrder S; S.init(MROWS, DM, G, bx);
            pg8::EpiResid E{P.out, WSP(float, WS_CTX), P.out, WSP(float, WS_CTX), MODL + 5 * DM, (ly == 0) ? WSP(bf16_t, WS_HN2) : (bf16_t*)nullptr, P.in[6] + DM, WSP(const float, WS_MOD) + (size_t)9 * MODW + DM, WSP(float, WS_RS1)};
            pg8::gemm_phase<pg8::EpiResid, pg8::StaticOrder, true, true>(lds, g, S, E, wave);
        } break;
        }
        }
        for (int es_ = 0; es_ < EXTRA_SYNC; ++es_) GRID_SYNC();
        if (ph + 1 < ph_hi) GRID_SYNC();
    }
}

#ifndef MK_MULTI_LAUNCH
#define MK_MULTI_LAUNCH 0
#endif
extern "C" void kernel_launch(void* const* d_in, const int* in_sizes, int n_in, void* d_out, int out_size, void* d_ws, size_t ws_size, hipStream_t stream) {
    static int grid = 0;
    if (grid == 0) {
        if (n_in != 21 || out_size != MLAT * DM || ws_size < WS_END) { fprintf(stderr, "kernel_launch: unexpected shapes (n_in %d out %d ws %zu)\n", n_in, out_size, ws_size); grid = -1; return; }
        int dev = 0, cus = 0, per_cu = 0;
        if (hipGetDevice(&dev) != hipSuccess || hipDeviceGetAttribute(&cus, hipDeviceAttributeMultiprocessorCount, dev) != hipSuccess) { grid = -1; return; }
        if (hipFuncSetAttribute((const void*)fwd_kernel, hipFuncAttributeMaxDynamicSharedMemorySize, LDS_BYTES) != hipSuccess) { fprintf(stderr, "kernel_launch: hipFuncSetAttribute failed\n"); grid = -1; return; }
        if (hipOccupancyMaxActiveBlocksPerMultiprocessor(&per_cu, (const void*)fwd_kernel, 512, LDS_BYTES) != hipSuccess || per_cu < 1) { fprintf(stderr, "kernel_launch: occupancy query gave %d\n", per_cu); (void)hipGetLastError(); grid = -1; return; }
        grid = cus * per_cu;
    }
    if (grid < 0) return;
    Params p{};
    for (int i = 0; i < 21; ++i) p.in[i] = (const float*)d_in[i];
    p.out = (float*)d_out; p.ws = (unsigned char*)d_ws;
    if (hipMemsetAsync((char*)d_ws + WS_BAR, 0, XCD_BAR_WORDS * 4, stream) != hipSuccess) { fprintf(stderr, "kernel_launch: memset of the barrier words failed\n"); return; }
    void* args[] = {&p};
#if MK_MULTI_LAUNCH
    for (int ph = 0; ph < N_PHASES; ++ph) { p.ph_lo = ph; p.ph_hi = ph + 1;
        hipError_t e = hipLaunchCooperativeKernel((const void*)fwd_kernel, dim3(grid), dim3(512), args, LDS_BYTES, stream);
        if (e != hipSuccess) { fprintf(stderr, "launch %d failed: %s\n", ph, hipGetErrorString(e)); break; } }
#else
    p.ph_lo = 0; p.ph_hi = N_PHASES;
    hipError_t e = hipLaunchCooperativeKernel((const void*)fwd_kernel, dim3(grid), dim3(512), args, LDS_BYTES, stream);
    if (e != hipSuccess) fprintf(stderr, "cooperative launch failed: %s (grid %d)\n", hipGetErrorString(e), grid);
#endif
}
```

```cpp
#include <hip/hip_runtime.h>
#include <cstdio>
#include <cstdint>
namespace pg8 {
#define PG8_LAS __attribute__((address_space(3)))
typedef unsigned short bf16_t;
__device__ __forceinline__ int lane_id() { int r; asm volatile("v_mbcnt_lo_u32_b32 %0, -1, 0\n\tv_mbcnt_hi_u32_b32 %0, -1, %0" : "=v"(r)); return r; }
template <int K> __device__ __forceinline__ float shx(float v) { static_assert(K == 1 || K == 2 || K == 4 || K == 8 || K == 16, "xor mask"); return __builtin_bit_cast(float, __builtin_amdgcn_ds_swizzle(__builtin_bit_cast(int, v), 0x1f | (K << 10))); }
__device__ __forceinline__ void swap_halves(float& a, float& b) { asm("s_nop 1\n\tv_permlane32_swap_b32 %0, %1" : "+v"(a), "+v"(b)); }
__device__ __forceinline__ float sum_halves(float v) { float a = v, b = v; swap_halves(a, b); return a + b; }
__device__ __forceinline__ float max_halves(float v) { float a = v, b = v; swap_halves(a, b); return fmaxf(a, b); }
typedef short bf16x8 __attribute__((ext_vector_type(8)));
typedef float f32x4 __attribute__((ext_vector_type(4)));
typedef unsigned u32x4 __attribute__((ext_vector_type(4)));
constexpr int BM = 256, BK = 64, HALF = 128, HTB = HALF * BK * 2  , STAGE_BYTES = 8 * HTB, NXCD = 8, WGM = 8;

__host__ __device__ __forceinline__ int lds_byte(int r, int c) { const int st = (r >> 4) * 2 + (c >> 5), rr = r & 15, cc = c & 31, ob = rr * 64 + cc * 2; return st * 1024 + (ob ^ (((ob >> 9) & 1) << 5)); }
__host__ __device__ __forceinline__ void stage_rc(int b, int& R, int& C) { const int st = b / 1024, sb = b % 1024, swz = sb ^ (((sb >> 9) & 1) << 5); R = (st >> 1) * 16 + swz / 64; C = (st & 1) * 32 + (swz % 64) / 2; }
__host__ __device__ __forceinline__ int perm32(int rho) { const int n = rho >> 4, i = rho & 15; return 8 * (i >> 2) + 4 * n + (i & 3); }

struct Unit { int pm, pn; };
struct Gemm { const bf16_t* A; const bf16_t* Bt; int M, N, K; };

struct StaticOrder {
    int nM, nN, nwg, G, c;
    __host__ __device__ void init(int M, int N, int G_, int c_) { nM = M / BM; nN = N / BM; nwg = nM * nN; G = G_; c = c_; }
    __host__ __device__ bool next(int i, Unit& u) const {
        const long L = (long)i * G + c; if (L >= nwg) return false;
        int wgid = (int)L; { const int q = nwg / NXCD, r = nwg % NXCD, xcd = wgid % NXCD, off = wgid / NXCD; wgid = (xcd < r ? xcd * (q + 1) : r * (q + 1) + (xcd - r) * q) + off; }
        const int nig = WGM * nN, gid = wgid / nig, fm = gid * WGM, gsz = (nM - fm) < WGM ? (nM - fm) : WGM;
        u.pm = fm + ((wgid % nig) % gsz); u.pn = (wgid % nig) / gsz; return true;
    }
    __device__ __forceinline__ void a_ready(const Unit&) const {}
    __device__ __forceinline__ void done(const Unit&) const {}
};
__device__ __forceinline__ unsigned cvt_pk_bf16(float lo, float hi) { unsigned r; asm volatile("v_cvt_pk_bf16_f32 %0, %1, %2" : "=v"(r) : "v"(lo), "v"(hi)); return r; }
typedef float f32x2 __attribute__((ext_vector_type(2)));
template <class Epi, class Sched, bool ALIGN_EPI = false, bool SP2 = false>
__device__ __forceinline__ void gemm_phase(PG8_LAS unsigned char* lds, const Gemm g, const Sched& S, const Epi& E, const int wid_in) {
    int tid_ = wid_in * 64 + lane_id(); asm volatile("" : "+v"(tid_));
    const int tid = tid_, wid = __builtin_amdgcn_readfirstlane(tid >> 6), lane = tid & 63, wr = wid >> 2, wc = wid & 3, fr = lane & 15, fq = lane >> 4;
    const int K = g.K, nt = K / BK;
    unsigned voffA[2], voffB[2];
#pragma unroll
    for (int i = 0; i < 2; ++i) { int R, C; stage_rc(tid * 16 + i * 8192, R, C); const int Rb = Epi::PERM ? ((R & ~31) + perm32(R & 31)) : R;
        voffA[i] = (unsigned)(R * K + C) * 2u; voffB[i] = (unsigned)(Rb * K + C) * 2u; }
    const size_t kstep = (size_t)(BK * 2);
    const size_t hstep = (size_t)HALF * K * 2;
    const size_t tstep = 2 * hstep;
    const unsigned ldsw = (unsigned)wid * 1024u;
    const int aoff = lds_byte(wr * 64 + fr, fq * 8), boff = lds_byte(wc * 32 + fr, fq * 8);
#define PG8_SA(b, h) (((b) * 2 + (h)) * HTB)
#define PG8_SB(b, h) ((4 + (b) * 2 + (h)) * HTB)
#define PG8_STAGE(bufoff, gbase, voff) do { _Pragma("unroll") for (int _i = 0; _i < 2; ++_i) \
        __builtin_amdgcn_global_load_lds((const unsigned*)((const char*)(gbase) + (voff)[_i]), (PG8_LAS unsigned*)(lds + (bufoff) + ldsw + _i * 8192), 16, 0, 0); } while (0)
#define PG8_LDA(dst, b, h) do { _Pragma("unroll") for (int m = 0; m < 4; ++m) _Pragma("unroll") for (int k = 0; k < 2; ++k) dst[m][k] = *(const PG8_LAS bf16x8*)(lds + PG8_SA(b, h) + aoff + m * 2048 + k * 1024); } while (0)
#define PG8_LDB(dst, b, h) do { _Pragma("unroll") for (int n = 0; n < 2; ++n) _Pragma("unroll") for (int k = 0; k < 2; ++k) dst[n][k] = *(const PG8_LAS bf16x8*)(lds + PG8_SB(b, h) + boff + n * 2048 + k * 1024); } while (0)
#define PG8_MMA(ai, bj, At, Bt) do { __builtin_amdgcn_s_setprio(1); _Pragma("unroll") for (int m = 0; m < 4; ++m) _Pragma("unroll") for (int n = 0; n < 2; ++n) _Pragma("unroll") for (int k = 0; k < 2; ++k) \
        acc[ai][bj][m][n] = __builtin_amdgcn_mfma_f32_16x16x32_bf16(Bt[n][k], At[m][k], acc[ai][bj][m][n], 0, 0, 0); __builtin_amdgcn_s_setprio(0); } while (0)
#define PG8_WAIT_V(n) asm volatile("s_waitcnt vmcnt(" #n ")" ::: "memory")
#define PG8_WAIT_L(n) asm volatile("s_waitcnt lgkmcnt(" #n ")" ::: "memory")
#define PG8_BAR __builtin_amdgcn_s_barrier()
#define PG8_SCHED __builtin_amdgcn_sched_barrier(0)
    Unit cur, nxt; int ui = 0;
    if (!S.next(0, cur)) return;
    f32x4 acc[2][2][4][2];
#pragma unroll
    for (int a = 0; a < 2; ++a)
#pragma unroll
        for (int b = 0; b < 2; ++b)
#pragma unroll
            for (int m = 0; m < 4; ++m)
#pragma unroll
                for (int n = 0; n < 2; ++n) acc[a][b][m][n] = (f32x4){0.f, 0.f, 0.f, 0.f};
    bf16x8 At[4][2], B0[2][2], B1[2][2];
    const char* cA = (const char*)g.A + (size_t)cur.pm * tstep; const char* cB = (const char*)g.Bt + (size_t)cur.pn * tstep;
    S.a_ready(cur);
    if constexpr (SP2) {
        PG8_STAGE(PG8_SB(0, 0), cB, voffB); PG8_STAGE(PG8_SB(0, 1), cB + hstep, voffB); PG8_STAGE(PG8_SA(0, 0), cA, voffA); PG8_STAGE(PG8_SA(0, 1), cA + hstep, voffA);
        if (wr == 1) PG8_BAR;
        PG8_WAIT_V(2); PG8_BAR;
        PG8_STAGE(PG8_SB(1, 0), cB + kstep, voffB); PG8_STAGE(PG8_SA(1, 0), cA + kstep, voffA); PG8_STAGE(PG8_SB(1, 1), cB + hstep + kstep, voffB);
        PG8_WAIT_V(6); PG8_BAR;
    } else {
        PG8_STAGE(PG8_SB(0, 0), cB, voffB); PG8_STAGE(PG8_SA(0, 0), cA, voffA); PG8_STAGE(PG8_SB(0, 1), cB + hstep, voffB); PG8_STAGE(PG8_SA(0, 1), cA + hstep, voffA);
        if (wr == 1) PG8_BAR;
        PG8_WAIT_V(4); PG8_BAR;
        PG8_STAGE(PG8_SB(1, 0), cB + kstep, voffB); PG8_STAGE(PG8_SA(1, 0), cA + kstep, voffA); PG8_STAGE(PG8_SB(1, 1), cB + hstep + kstep, voffB);
        PG8_WAIT_V(6); PG8_BAR;
    }
    for (;;) {
        const bool has_next = S.next(ui + 1, nxt);
        const char* nA = has_next ? (const char*)g.A + (size_t)nxt.pm * tstep : cA; const char* nB = has_next ? (const char*)g.Bt + (size_t)nxt.pn * tstep : cB;
        for (int t = 0; t < nt; t += 2) {
            const bool last = (t == nt - 2);
            const char* a1 = cA + (size_t)(t + 1) * kstep;
            const char* a2 = last ? nA : cA + (size_t)(t + 2) * kstep; const char* b2 = last ? nB : cB + (size_t)(t + 2) * kstep;
            const char* a3 = a2 + kstep; const char* b3 = b2 + kstep;
            if (last && has_next) S.a_ready(nxt);
            if constexpr (SP2) {
            PG8_LDB(B0, 0, 0); PG8_LDB(B1, 0, 1); PG8_SCHED; PG8_LDA(At, 0, 0); PG8_STAGE(PG8_SA(1, 1), a1 + hstep, voffA);
            PG8_WAIT_V(8); PG8_WAIT_L(0); PG8_BAR; PG8_MMA(0, 0, At, B0); PG8_MMA(0, 1, At, B1); PG8_BAR; PG8_SCHED;
            PG8_LDA(At, 0, 1); PG8_STAGE(PG8_SB(0, 0), b2, voffB); PG8_STAGE(PG8_SB(0, 1), b2 + hstep, voffB); PG8_STAGE(PG8_SA(0, 0), a2, voffA);
            PG8_WAIT_V(8); PG8_WAIT_L(0); PG8_BAR; PG8_MMA(1, 0, At, B0); PG8_MMA(1, 1, At, B1); PG8_BAR; PG8_SCHED;
            PG8_LDB(B0, 1, 0); PG8_LDB(B1, 1, 1); PG8_SCHED; PG8_LDA(At, 1, 0); PG8_STAGE(PG8_SA(0, 1), a2 + hstep, voffA);
            PG8_WAIT_V(8); PG8_WAIT_L(0); PG8_BAR; PG8_MMA(0, 0, At, B0); PG8_MMA(0, 1, At, B1); PG8_BAR; PG8_SCHED;
            PG8_LDA(At, 1, 1); PG8_STAGE(PG8_SB(1, 0), b3, voffB); PG8_STAGE(PG8_SB(1, 1), b3 + hstep, voffB); PG8_STAGE(PG8_SA(1, 0), a3, voffA);
            PG8_WAIT_V(8); PG8_WAIT_L(0); PG8_BAR; PG8_MMA(1, 0, At, B0); PG8_MMA(1, 1, At, B1); PG8_BAR; PG8_SCHED;
            } else {
            PG8_LDB(B0, 0, 0); PG8_SCHED; PG8_LDA(At, 0, 0); PG8_STAGE(PG8_SA(1, 1), a1 + hstep, voffA);
            PG8_WAIT_L(8); PG8_BAR; PG8_WAIT_L(0); PG8_MMA(0, 0, At, B0); PG8_BAR; PG8_SCHED;
            PG8_LDB(B1, 0, 1); PG8_STAGE(PG8_SB(0, 0), b2, voffB);
            PG8_BAR; PG8_WAIT_L(0); PG8_MMA(0, 1, At, B1); PG8_BAR;
            PG8_LDA(At, 0, 1); PG8_STAGE(PG8_SA(0, 0), a2, voffA);
            PG8_BAR; PG8_WAIT_L(0); PG8_MMA(1, 0, At, B0); PG8_BAR; PG8_SCHED;
            PG8_STAGE(PG8_SB(0, 1), b2 + hstep, voffB);
            PG8_WAIT_V(6); PG8_BAR; PG8_MMA(1, 1, At, B1); PG8_BAR;
            PG8_LDB(B0, 1, 0); PG8_SCHED; PG8_LDA(At, 1, 0); PG8_STAGE(PG8_SA(0, 1), a2 + hstep, voffA);
            PG8_WAIT_L(8); PG8_BAR; PG8_WAIT_L(0); PG8_MMA(0, 0, At, B0); PG8_BAR; PG8_SCHED;
            PG8_LDB(B1, 1, 1); PG8_STAGE(PG8_SB(1, 0), b3, voffB);
            PG8_BAR; PG8_WAIT_L(0); PG8_MMA(0, 1, At, B1); PG8_BAR;
            PG8_LDA(At, 1, 1); PG8_STAGE(PG8_SA(1, 0), a3, voffA);
            PG8_BAR; PG8_WAIT_L(0); PG8_MMA(1, 0, At, B0); PG8_BAR; PG8_SCHED;
            PG8_STAGE(PG8_SB(1, 1), b3 + hstep, voffB);
            PG8_WAIT_V(6); PG8_BAR; PG8_MMA(1, 1, At, B1); PG8_BAR;
            }
        }
        if constexpr (ALIGN_EPI) { if (wr == 0) PG8_BAR; }
        if constexpr (!Epi::AFTER_DRAIN) { E(acc, cur, wr, wc, fr, fq); S.done(cur); }
        if (!has_next) break;
#pragma unroll
        for (int a = 0; a < 2; ++a)
#pragma unroll
            for (int b = 0; b < 2; ++b)
#pragma unroll
                for (int m = 0; m < 4; ++m)
#pragma unroll
                    for (int n = 0; n < 2; ++n) acc[a][b][m][n] = (f32x4){0.f, 0.f, 0.f, 0.f};
        cur = nxt; cA = nA; cB = nB; ++ui;
        if constexpr (ALIGN_EPI) { if (wr == 1) PG8_BAR; }
    }
    PG8_WAIT_V(0);
    if constexpr (!ALIGN_EPI) { if (wr == 0) PG8_BAR; }
    PG8_BAR;
    if constexpr (Epi::AFTER_DRAIN) { E.fused(acc, cur, wr, wc, fr, fq, lds, wid, lane); S.done(cur); }
#undef PG8_SA
#undef PG8_SB
#undef PG8_STAGE
#undef PG8_LDA
#undef PG8_LDB
#undef PG8_MMA
#undef PG8_WAIT_V
#undef PG8_WAIT_L
#undef PG8_BAR
#undef PG8_SCHED
}
}

namespace pg8 {
typedef unsigned u32x2 __attribute__((ext_vector_type(2)));
template <int ACT> struct EpiStore {
    static constexpr bool PERM = true, AFTER_DRAIN = false;
    bf16_t* O; int ldc;
    __device__ __forceinline__ void operator()(const f32x4 (&acc)[2][2][4][2], const Unit& u, int wr, int wc, int fr, int fq) const {
        const int row0 = u.pm * BM + wr * 64 + fr, col0 = u.pn * BM + wc * 32 + 8 * fq;
#pragma unroll
        for (int ai = 0; ai < 2; ++ai)
#pragma unroll
            for (int m = 0; m < 4; ++m) { bf16_t* rowp = O + (size_t)(row0 + ai * HALF + m * 16) * ldc + col0;
#pragma unroll
                for (int bj = 0; bj < 2; ++bj) { f32x4 v0 = acc[ai][bj][m][0], v1 = acc[ai][bj][m][1];
                    if (ACT == 2) {
#pragma unroll
                        for (int e = 0; e < 4; ++e) { const float a = fmaxf(v0[e], 0.f), b = fmaxf(v1[e], 0.f); v0[e] = a * a; v1[e] = b * b; } }
                    u32x4 w; w.x = cvt_pk_bf16(v0[0], v0[1]); w.y = cvt_pk_bf16(v0[2], v0[3]); w.z = cvt_pk_bf16(v1[0], v1[1]); w.w = cvt_pk_bf16(v1[2], v1[3]);
                    *(u32x4*)(rowp + bj * HALF) = w; } }
    }
};


__device__ __forceinline__ void rows_rstd(const float* rs, int row0, int fq, float (&rstd)[2][4]) {
    f32x4 p[2][4];
#pragma unroll
    for (int ai = 0; ai < 2; ++ai)
#pragma unroll
        for (int m = 0; m < 4; ++m) p[ai][m] = *(const f32x4*)(rs + (size_t)(row0 + ai * HALF + m * 16) * 16 + 4 * fq);
#pragma unroll
    for (int ai = 0; ai < 2; ++ai)
#pragma unroll
        for (int m = 0; m < 4; ++m) { float s = (p[ai][m][0] + p[ai][m][1]) + (p[ai][m][2] + p[ai][m][3]); s += shx<16>(s); s = sum_halves(s); rstd[ai][m] = 1.0f / sqrtf(s * (1.0f / 1024.0f) + 1e-6f); }
}
struct EpiFc1 {
    static constexpr bool PERM = true, AFTER_DRAIN = false;
    bf16_t* O; int ldc; const float* rs; const float* bias;
    __device__ __forceinline__ void operator()(const f32x4 (&acc)[2][2][4][2], const Unit& u, int wr, int wc, int fr_in, int fq_in) const {
        (void)fr_in; (void)fq_in; int ln_e = lane_id(); asm volatile("" : "+v"(ln_e)); const int fr = ln_e & 15, fq = ln_e >> 4;
        const int row0 = u.pm * BM + wr * 64 + fr, col0 = u.pn * BM + wc * 32 + 8 * fq; const int b = (u.pm < 64) ? (u.pm >> 3) : 8;
        f32x4 bv[2][2];
#pragma unroll
        for (int bj = 0; bj < 2; ++bj)
#pragma unroll
            for (int n = 0; n < 2; ++n) bv[bj][n] = *(const f32x4*)(bias + (size_t)b * ldc + col0 + bj * HALF + 4 * n);
        float rsd[2][4]; rows_rstd(rs, row0, fq, rsd);
#pragma unroll
        for (int ai = 0; ai < 2; ++ai)
#pragma unroll
            for (int m = 0; m < 4; ++m) { const int row = row0 + ai * HALF + m * 16; const float rstd = rsd[ai][m]; bf16_t* rowp = O + (size_t)row * ldc + col0;
#pragma unroll
                for (int bj = 0; bj < 2; ++bj) { f32x4 v0 = acc[ai][bj][m][0] * rstd + bv[bj][0], v1 = acc[ai][bj][m][1] * rstd + bv[bj][1];
#pragma unroll
                    for (int e = 0; e < 4; ++e) { const float a = fmaxf(v0[e], 0.f), c = fmaxf(v1[e], 0.f); v0[e] = a * a; v1[e] = c * c; }
                    u32x4 w; w.x = cvt_pk_bf16(v0[0], v0[1]); w.y = cvt_pk_bf16(v0[2], v0[3]); w.z = cvt_pk_bf16(v1[0], v1[1]); w.w = cvt_pk_bf16(v1[2], v1[3]);
                    *(u32x4*)(rowp + bj * HALF) = w; }
                asm volatile("" ::: "memory"); }
    }
};

struct EpiResid {
    static constexpr bool PERM = true, AFTER_DRAIN = false;
    const float* base_lat; const float* base_ctx; float* out_lat; float* out_ctx; const float* gate;
    bf16_t* aout; const float* gn; const float* scn; float* rsout;
    __device__ __forceinline__ void operator()(const f32x4 (&acc)[2][2][4][2], const Unit& u, int wr, int wc, int fr_in, int fq_in) const {
        (void)fr_in; (void)fq_in; int ln_e = lane_id(); asm volatile("" : "+v"(ln_e)); const int fr = ln_e & 15, fq = ln_e >> 4;
        const bool lat = u.pm < 64;
        const int b = lat ? (u.pm >> 3) : 8;
        const size_t roff = (size_t)(lat ? u.pm : u.pm - 64) * BM * 1024;
        const float* base = (lat ? base_lat : base_ctx) + roff; float* out = (lat ? out_lat : out_ctx) + roff;
        const int col0 = u.pn * BM + wc * 32 + 8 * fq;
        f32x4 gv[2][2];
#pragma unroll
        for (int bj = 0; bj < 2; ++bj)
#pragma unroll
            for (int n = 0; n < 2; ++n) gv[bj][n] = *(const f32x4*)(gate + (size_t)b * 6144 + col0 + bj * HALF + n * 4);
        if (aout == nullptr) {
#pragma unroll
            for (int ai = 0; ai < 2; ++ai)
#pragma unroll
                for (int m = 0; m < 4; ++m) { const size_t off = (size_t)(ai * HALF + wr * 64 + m * 16 + fr) * 1024 + col0;
#pragma unroll
                    for (int bj = 0; bj < 2; ++bj)
#pragma unroll
                        for (int n = 0; n < 2; ++n) { const f32x4 bs = *(const f32x4*)(base + off + bj * HALF + n * 4);
                            *(f32x4*)(out + off + bj * HALF + n * 4) = bs + gv[bj][n] * acc[ai][bj][m][n]; }
                    if (m & 1) asm volatile("" ::: "memory"); }
            return;
        }
        f32x4 Gv[2][2];
#pragma unroll
        for (int bj = 0; bj < 2; ++bj)
#pragma unroll
            for (int n = 0; n < 2; ++n) Gv[bj][n] = *(const f32x4*)(gn + col0 + bj * HALF + n * 4) * (*(const f32x4*)(scn + (size_t)b * 6144 + col0 + bj * HALF + n * 4) + 1.0f);
        const size_t grow0 = (size_t)u.pm * BM;
#pragma unroll
        for (int ai = 0; ai < 2; ++ai)
#pragma unroll
            for (int m = 0; m < 4; ++m) { const int rl = ai * HALF + wr * 64 + m * 16 + fr; const size_t off = (size_t)rl * 1024 + col0; float ss = 0.f;
                bf16_t* ap = aout + (grow0 + rl) * 1024 + col0;
#pragma unroll
                for (int bj = 0; bj < 2; ++bj) {
                    const f32x4 b0 = *(const f32x4*)(base + off + bj * HALF), b1 = *(const f32x4*)(base + off + bj * HALF + 4);
                    const f32x4 x0 = b0 + gv[bj][0] * acc[ai][bj][m][0], x1 = b1 + gv[bj][1] * acc[ai][bj][m][1];
                    *(f32x4*)(out + off + bj * HALF) = x0; *(f32x4*)(out + off + bj * HALF + 4) = x1;
                    ss += ((x0[0] * x0[0] + x0[1] * x0[1]) + (x0[2] * x0[2] + x0[3] * x0[3])) + ((x1[0] * x1[0] + x1[1] * x1[1]) + (x1[2] * x1[2] + x1[3] * x1[3]));
                    const f32x4 y0 = x0 * Gv[bj][0], y1 = x1 * Gv[bj][1];
                    u32x4 w; w.x = cvt_pk_bf16(y0[0], y0[1]); w.y = cvt_pk_bf16(y0[2], y0[3]); w.z = cvt_pk_bf16(y1[0], y1[1]); w.w = cvt_pk_bf16(y1[2], y1[3]);
                    *(u32x4*)(ap + bj * HALF) = w; }
                ss += shx<16>(ss); ss = sum_halves(ss);
                if (fq == 0) rsout[(grow0 + rl) * 16 + u.pn * 4 + wc] = ss;
                if (m & 1) asm volatile("" ::: "memory"); }
    }
};

struct EpiProj {
    static constexpr bool PERM = true, AFTER_DRAIN = false;
    bf16_t* O; const float* gains;
    const float* rs; const float* bias;
    __device__ __forceinline__ void operator()(const f32x4 (&acc)[2][2][4][2], const Unit& u, int wr, int wc, int fr_in, int fq_in) const {
        (void)fr_in; (void)fq_in; int ln_e = lane_id(); asm volatile("" : "+v"(ln_e)); const int fr = ln_e & 15, fq = ln_e >> 4;
        const int pn = u.pn; const int row0 = u.pm * BM + wr * 64 + fr; const int b = (u.pm < 64) ? (u.pm >> 3) : 8;
        f32x4 bv[2][2];
#pragma unroll
        for (int bj = 0; bj < 2; ++bj)
#pragma unroll
            for (int n = 0; n < 2; ++n) bv[bj][n] = *(const f32x4*)(bias + (size_t)b * 2304 + pn * BM + bj * HALF + wc * 32 + 8 * fq + 4 * n);
        float rsd[2][4]; rows_rstd(rs, row0, fq, rsd);
        if (pn >= 2 && pn <= 5) {
            const int col0 = pn * BM + wc * 32 + 8 * fq;
#pragma unroll
            for (int ai = 0; ai < 2; ++ai)
#pragma unroll
                for (int m = 0; m < 4; ++m) { bf16_t* rowp = O + (size_t)(row0 + ai * HALF + m * 16) * 2304 + col0; const float rstd = rsd[ai][m];
#pragma unroll
                    for (int bj = 0; bj < 2; ++bj) { const f32x4 v0 = acc[ai][bj][m][0] * rstd + bv[bj][0], v1 = acc[ai][bj][m][1] * rstd + bv[bj][1];
                        u32x4 w; w.x = cvt_pk_bf16(v0[0], v0[1]); w.y = cvt_pk_bf16(v0[2], v0[3]); w.z = cvt_pk_bf16(v1[0], v1[1]); w.w = cvt_pk_bf16(v1[2], v1[3]);
                        *(u32x4*)(rowp + bj * HALF) = w; } }
            return;
        }
        const int colh = pn * BM + wc * 64 + 8 * fq;
        const bool vhead = (pn == 8) && (wc >= 2);
        if (vhead) {
#pragma unroll
            for (int ai = 0; ai < 2; ++ai)
#pragma unroll
                for (int m = 0; m < 4; ++m) { bf16_t* rowp = O + (size_t)(row0 + ai * HALF + m * 16) * 2304 + colh; const float rstd = rsd[ai][m];
#pragma unroll
                    for (int bj = 0; bj < 2; ++bj) { const f32x4 v0 = acc[ai][bj][m][0] * rstd + bv[bj][0], v1 = acc[ai][bj][m][1] * rstd + bv[bj][1];
                        u32x4 w; w.x = cvt_pk_bf16(v0[0], v0[1]); w.y = cvt_pk_bf16(v0[2], v0[3]); w.z = cvt_pk_bf16(v1[0], v1[1]); w.w = cvt_pk_bf16(v1[2], v1[3]);
                        *(u32x4*)(rowp + bj * 32) = w; } }
            return;
        }
        const float* gp = gains + 64 * ((pn == 0) ? 0 : (pn == 1) ? 1 : (pn == 8) ? 3 : 2);
        const float qs = (pn == 1 || pn == 8) ? 1.0f : 0.18033688011112042f;
        const bool rope = (pn >= 6) && (u.pm < 64);
        f32x4 gv[2][2];
#pragma unroll
        for (int bj = 0; bj < 2; ++bj)
#pragma unroll
            for (int n = 0; n < 2; ++n) gv[bj][n] = *(const f32x4*)(gp + 32 * bj + 16 * n + 4 * fq);
        float invrev[4];
#pragma unroll
        for (int e = 0; e < 4; ++e) invrev[e] = __builtin_amdgcn_exp2f(-(float)(4 * fq + e) * (13.287712379549449f / 16.0f)) * 0.15915494309189535f;
#pragma unroll
        for (int ai = 0; ai < 2; ++ai)
#pragma unroll
            for (int m = 0; m < 4; ++m) {
                const int row = row0 + ai * HALF + m * 16; const float rstd0 = rsd[ai][m];
                f32x4 v[2][2]; float ss = 0.f;
#pragma unroll
                for (int bj = 0; bj < 2; ++bj)
#pragma unroll
                    for (int n = 0; n < 2; ++n) v[bj][n] = acc[ai][bj][m][n] * rstd0 + bv[bj][n];
                asm volatile("" : "+v"(v[0][0]), "+v"(v[0][1]), "+v"(v[1][0]), "+v"(v[1][1]));
#pragma unroll
                for (int bj = 0; bj < 2; ++bj)
#pragma unroll
                    for (int n = 0; n < 2; ++n) { const f32x4 x = v[bj][n]; ss += (x[0] * x[0] + x[1] * x[1]) + (x[2] * x[2] + x[3] * x[3]); }
                ss += shx<16>(ss); ss = sum_halves(ss);
                const float rstd = 1.0f / sqrtf(ss * (1.0f / 64.0f) + 1e-6f);
#pragma unroll
                for (int bj = 0; bj < 2; ++bj)
#pragma unroll
                    for (int n = 0; n < 2; ++n) v[bj][n] = v[bj][n] * rstd * gv[bj][n];
                if (rope) {
                    const int t = row & 2047;
#pragma unroll
                    for (int bj = 0; bj < 2; ++bj) { const float pos = (float)(bj == 0 ? (t >> 6) : (t & 63));
#pragma unroll
                        for (int e = 0; e < 4; ++e) { float rev = pos * invrev[e]; rev = rev - floorf(rev);
                            const float cs = __builtin_amdgcn_cosf(rev), sn = __builtin_amdgcn_sinf(rev);
                            const float u1 = v[bj][0][e], u2 = v[bj][1][e];
                            v[bj][0][e] = u1 * cs - u2 * sn; v[bj][1][e] = u2 * cs + u1 * sn; } }
                }
                bf16_t* rowp = O + (size_t)row * 2304 + colh;
#pragma unroll
                for (int bj = 0; bj < 2; ++bj) { const f32x4 v0 = v[bj][0] * qs, v1 = v[bj][1] * qs;
                    u32x4 w; w.x = cvt_pk_bf16(v0[0], v0[1]); w.y = cvt_pk_bf16(v0[2], v0[3]); w.z = cvt_pk_bf16(v1[0], v1[1]); w.w = cvt_pk_bf16(v1[2], v1[3]);
                    *(u32x4*)(rowp + bj * 32) = w; }
                asm volatile("" ::: "memory");
            }
    }
};
}

#define LAS __attribute__((address_space(3)))
typedef unsigned short bf16_t;
typedef short bf16x8 __attribute__((ext_vector_type(8)));
typedef short s16x4 __attribute__((ext_vector_type(4)));
typedef float f32x16 __attribute__((ext_vector_type(16)));
typedef float f32x4 __attribute__((ext_vector_type(4)));
typedef unsigned u32x4 __attribute__((ext_vector_type(4)));
typedef unsigned u32x2 __attribute__((ext_vector_type(2)));

constexpr int DM = 1024, NB = 8, SEQ = 2048, CTXL = 256, FFN = 4096, INW = 2304;
constexpr int MLAT = NB * SEQ, MCTX = NB * CTXL, MALL = MLAT + MCTX;
constexpr float EPSN = 1e-6f, LOG2E = 1.4426950408889634f, NEGBIG = -1e30f;
constexpr int MODW = 6 * DM;
constexpr size_t MiB = (size_t)1 << 20;
constexpr size_t WS_MOD = 0;
constexpr size_t WS_GAIN = 512 * 1024;
constexpr size_t WS_BAR = 768 * 1024;
constexpr size_t WS_WIN = 1 * MiB;
constexpr size_t WS_WO = 10 * MiB;
constexpr size_t WS_W1 = 14 * MiB;
constexpr size_t WS_W2 = 30 * MiB;
constexpr size_t WS_CTX = 46 * MiB;
constexpr size_t WS_HN2 = 54 * MiB;
constexpr size_t WS_HN = 207 * MiB;
constexpr size_t WS_H1 = 90 * MiB;
constexpr size_t WS_PROJ = 90 * MiB;
constexpr size_t WS_OB = 171 * MiB;
constexpr size_t WS_RS1 = 243 * MiB;
constexpr size_t WS_RS2 = 245 * MiB;
constexpr size_t WS_BIN = 247 * MiB;
constexpr size_t WS_B1 = 248 * MiB;
constexpr size_t WS_END = 249 * MiB;

__device__ __forceinline__ float half_sum(float v) { v += pg8::shx<1>(v); v += pg8::shx<2>(v); v += pg8::shx<4>(v); v += pg8::shx<8>(v); v += pg8::shx<16>(v); return v; }
__device__ __forceinline__ float wave_sum(float v) { return pg8::sum_halves(half_sum(v)); }
__device__ __forceinline__ unsigned f2bf(float f) { unsigned u = __builtin_bit_cast(unsigned, f); return (u + 0x7fffu + ((u >> 16) & 1u)) >> 16; }
__device__ __forceinline__ unsigned pk2(float lo, float hi) { return f2bf(lo) | (f2bf(hi) << 16); }
__device__ __forceinline__ float bf_lo(unsigned u) { return __builtin_bit_cast(float, u << 16); }
__device__ __forceinline__ float bf_hi(unsigned u) { return __builtin_bit_cast(float, u & 0xffff0000u); }

namespace att {
constexpr int KROWB = 144, VROWB = 128, WL_V = 64 * KROWB, WL_A = WL_V + 64 * VROWB, WL_TAB = WL_A + 128 + 192, WAVE_LDS = WL_TAB + 15 * 32 * 4;
typedef float f32x2_t __attribute__((ext_vector_type(2))); typedef __bf16 bf16x2_t __attribute__((ext_vector_type(2)));
typedef short v4i16_t __attribute__((ext_vector_type(4)));
__device__ __forceinline__ unsigned cvtpk(float lo, float hi) { f32x2_t v = {lo, hi}; bf16x2_t b = __builtin_convertvector(v, bf16x2_t); return __builtin_bit_cast(unsigned, b); }
__device__ __forceinline__ s16x4 vtr(LAS const unsigned char* p) { return __builtin_bit_cast(s16x4, __builtin_amdgcn_ds_read_tr16_b64_v4i16((LAS v4i16_t*)p)); }
struct AU { int qrow0, qcol, kcol, vcol, ocol, ctxrow0, nloc, locrow0, a0, a1; float m0, l0; const float* rpb; };
template <int KIND> __device__ __forceinline__ void attn_unit(LAS unsigned char* wl, const bf16_t* __restrict__ proj, bf16_t* __restrict__ obuf, const AU u, const int lane) {
    const int r32 = lane & 31, hi = lane >> 5;
    LAS float* sc = (LAS float*)(wl + WL_A);
    LAS float* tab = (LAS float*)(wl + WL_TAB);
    bf16x8 qr[4];
    { const bf16_t* qp = proj + (size_t)(u.qrow0 + r32) * INW + u.qcol + hi * 8;
#pragma unroll
      for (int d0 = 0; d0 < 4; ++d0) qr[d0] = *(const bf16x8*)(qp + d0 * 16); }
    if (KIND == 0) { for (int i = lane; i < 15 * 31; i += 64) { const int a = i / 31, b = i - a * 31; tab[a * 32 + b] = u.rpb[i] * LOG2E; } }
    f32x16 o0, o1;
#pragma unroll
    for (int r = 0; r < 16; ++r) { o0[r] = 0.f; o1[r] = 0.f; }
    float m = u.m0, l = (hi == 0) ? u.l0 : 0.f;
    const int nt = 4 + u.nloc;
    const int lrow = lane >> 3, lch = lane & 7;
    u32x4 kreg[8], vreg[8];
#define ATT_LOAD_TILE(t) do { const int row0_ = ((t) < 4) ? u.ctxrow0 + 64 * (t) : u.locrow0 + 64 * ((t) - 4); const bf16_t* bp_ = proj + (size_t)(row0_ + lrow) * INW + lch * 8; \
        _Pragma("unroll") for (int i_ = 0; i_ < 8; ++i_) { kreg[i_] = *(const u32x4*)(bp_ + (size_t)i_ * 8 * INW + u.kcol); vreg[i_] = *(const u32x4*)(bp_ + (size_t)i_ * 8 * INW + u.vcol); } } while (0)
    ATT_LOAD_TILE(0);
    LAS unsigned char* kw = wl + lrow * KROWB + lch * 16;
    LAS unsigned char* vw = wl + WL_V + lrow * VROWB + lch * 16;
    LAS const unsigned char* kf = wl + r32 * KROWB + hi * 16;
    LAS const unsigned char* vf = wl + WL_V + (4 * hi + ((lane & 15) >> 2)) * VROWB + ((lane >> 4) & 1) * 32 + (lane & 3) * 8;
    for (int t = 0; t < nt; ++t) {
#pragma unroll
        for (int i = 0; i < 8; ++i) { *(LAS u32x4*)(kw + i * 8 * KROWB) = kreg[i]; *(LAS u32x4*)(vw + i * 8 * VROWB) = vreg[i]; }
        if (t + 1 < nt) ATT_LOAD_TILE(t + 1);
        f32x16 p0, p1;
#pragma unroll
        for (int r = 0; r < 16; ++r) { p0[r] = 0.f; p1[r] = 0.f; }
#pragma unroll
        for (int d0 = 0; d0 < 4; ++d0) {
            const bf16x8 a0 = *(LAS const bf16x8*)(kf + d0 * 32), a1 = *(LAS const bf16x8*)(kf + 32 * KROWB + d0 * 32);
            p0 = __builtin_amdgcn_mfma_f32_32x32x16_bf16(a0, qr[d0], p0, 0, 0, 0);
            p1 = __builtin_amdgcn_mfma_f32_32x32x16_bf16(a1, qr[d0], p1, 0, 0, 0);
        }
        if (KIND == 0) { if (t >= 4) {
            const int dr = u.a0 + (t - 4), qc = u.a1 + r32; const int cs = min(max(qc - 8, 0), 48);
            const int kb = 4 * hi - cs; LAS const float* tb = tab + dr * 32 + 15 - qc + 4 * hi;
#pragma unroll
            for (int r = 0; r < 16; ++r) { const int kc = (r & 3) + 8 * (r >> 2);
                p0[r] = ((unsigned)(kb + kc) < 16u) ? p0[r] + tb[kc] : NEGBIG;
                p1[r] = ((unsigned)(kb + kc + 32) < 16u) ? p1[r] + tb[kc + 32] : NEGBIG; } } }
        if (KIND == 1) { if (t >= 4) {
            const int d0_ = u.a0 + 64 * (t - 4) + 4 * hi - r32 + 128;
#pragma unroll
            for (int r = 0; r < 16; ++r) { const int kc = (r & 3) + 8 * (r >> 2);
                p0[r] = ((unsigned)(d0_ + kc) <= 256u) ? p0[r] : NEGBIG;
                p1[r] = ((unsigned)(d0_ + kc + 32) <= 256u) ? p1[r] : NEGBIG; } } }
        float mx = fmaxf(p0[0], p1[0]);
#pragma unroll
        for (int r = 1; r < 16; ++r) mx = fmaxf(mx, fmaxf(p0[r], p1[r]));
        mx = pg8::max_halves(mx);
        const float mnew = fmaxf(m, mx); const float alpha = __builtin_amdgcn_exp2f(m - mnew); m = mnew;
        float rs = 0.f;
#pragma unroll
        for (int r = 0; r < 16; ++r) { p0[r] = __builtin_amdgcn_exp2f(p0[r] - mnew); p1[r] = __builtin_amdgcn_exp2f(p1[r] - mnew); rs += p0[r] + p1[r]; }
        l = l * alpha + rs;
        if (hi == 0) sc[r32] = alpha;
#pragma unroll
        for (int g = 0; g < 4; ++g) { const f32x4 a = *(LAS const f32x4*)(sc + 8 * g + 4 * hi);
#pragma unroll
            for (int i = 0; i < 4; ++i) { o0[4 * g + i] *= a[i]; o1[4 * g + i] *= a[i]; } }
        u32x4 pa[4];
#pragma unroll
        for (int j = 0; j < 4; ++j) { pa[0][j] = cvtpk(p0[2 * j], p0[2 * j + 1]); pa[1][j] = cvtpk(p0[8 + 2 * j], p0[8 + 2 * j + 1]); pa[2][j] = cvtpk(p1[2 * j], p1[2 * j + 1]); pa[3][j] = cvtpk(p1[8 + 2 * j], p1[8 + 2 * j + 1]); }
#pragma unroll
        for (int ks = 0; ks < 4; ++ks) {
            const s16x4 l0 = vtr(vf + ks * 16 * VROWB), h0 = vtr(vf + ks * 16 * VROWB + 8 * VROWB);
            const s16x4 l1 = vtr(vf + ks * 16 * VROWB + 64), h1 = vtr(vf + ks * 16 * VROWB + 8 * VROWB + 64);
            const bf16x8 b0 = (bf16x8){l0[0], l0[1], l0[2], l0[3], h0[0], h0[1], h0[2], h0[3]}, b1 = (bf16x8){l1[0], l1[1], l1[2], l1[3], h1[0], h1[1], h1[2], h1[3]};
            o0 = __builtin_amdgcn_mfma_f32_32x32x16_bf16(__builtin_bit_cast(bf16x8, pa[ks]), b0, o0, 0, 0, 0);
            o1 = __builtin_amdgcn_mfma_f32_32x32x16_bf16(__builtin_bit_cast(bf16x8, pa[ks]), b1, o1, 0, 0, 0);
        }
    }
#undef ATT_LOAD_TILE
    const float lt = pg8::sum_halves(l);
    if (hi == 0) sc[r32] = 1.0f / lt;
    bf16_t* ob = obuf + (size_t)u.qrow0 * DM + u.ocol + r32;
#pragma unroll
    for (int g = 0; g < 4; ++g) { const f32x4 a = *(LAS const f32x4*)(sc + 8 * g + 4 * hi);
#pragma unroll
        for (int i = 0; i < 4; ++i) { const int q = i + 8 * g + 4 * hi; bf16_t* op = ob + (size_t)q * DM;
            op[0] = (bf16_t)f2bf(o0[4 * g + i] * a[i]); op[32] = (bf16_t)f2bf(o1[4 * g + i] * a[i]); } }
}

__device__ __forceinline__ void attn_phase(LAS unsigned char* wl, const bf16_t* proj, bf16_t* obuf, const float* rpb_l, const float* sink_l, bool with_ctx, int gw, int ngw, int lane) {
    const int total = 2048 + 4096 + (with_ctx ? 768 : 0);
    for (int i0 = gw; i0 < total; i0 += ngw) {
        int i = i0; AU u;
        if (i < 2048) {
            const int half = i & 1, h = (i >> 1) & 3, r = (i >> 3) & 31, b = i >> 8; const int rs = min(max(r - 4, 0), 24);
            u.qrow0 = b * SEQ + r * 64 + 32 * half; u.qcol = 64 * h; u.kcol = 256 + 64 * h; u.vcol = 512 + 64 * h; u.ocol = 64 * h; u.ctxrow0 = MLAT + b * CTXL;
            u.nloc = 8; u.locrow0 = b * SEQ + rs * 64; u.a0 = rs - r + 7; u.a1 = 32 * half; u.m0 = NEGBIG; u.l0 = 0.f; u.rpb = rpb_l + h * (15 * 31);
            attn_unit<0>(wl, proj, obuf, u, lane);
            continue;
        }
        i -= 2048;
        if (i < 4096) {
            const int ch = i & 63, h = (i >> 6) & 7, b = i >> 9; const int qpos0 = 32 * ch;
            const int kt0 = max(0, (qpos0 - 128) >> 6), kt1 = min(31, (qpos0 + 159) >> 6);
            u.qrow0 = b * SEQ + qpos0; u.qcol = 1536 + 64 * h; u.kcol = 2048 + 64 * (h >> 2); u.vcol = 2176 + 64 * (h >> 2); u.ocol = 512 + 64 * h; u.ctxrow0 = MLAT + b * CTXL;
            u.nloc = kt1 - kt0 + 1; u.locrow0 = b * SEQ + 64 * kt0; u.a0 = 64 * kt0 - qpos0; u.a1 = 0; u.m0 = sink_l[h] * LOG2E; u.l0 = 1.f; u.rpb = nullptr;
            attn_unit<1>(wl, proj, obuf, u, lane);
            continue;
        }
        i -= 4096;
        if (i < 256) {
            const int ch = i & 7, h = (i >> 3) & 3, b = i >> 5;
            u.qrow0 = MLAT + b * CTXL + 32 * ch; u.qcol = 64 * h; u.kcol = 256 + 64 * h; u.vcol = 512 + 64 * h; u.ocol = 64 * h; u.m0 = NEGBIG; u.l0 = 0.f; u.ctxrow0 = MLAT + b * CTXL;
        } else {
            i -= 256; const int ch = i & 7, h = (i >> 3) & 7, b = i >> 6;
            u.qrow0 = MLAT + b * CTXL + 32 * ch; u.qcol = 1536 + 64 * h; u.kcol = 2048 + 64 * (h >> 2); u.vcol = 2176 + 64 * (h >> 2); u.ocol = 512 + 64 * h; u.m0 = sink_l[h] * LOG2E; u.l0 = 1.f; u.ctxrow0 = MLAT + b * CTXL;
        }
        u.nloc = 0; u.locrow0 = 0; u.a0 = 0; u.a1 = 0; u.rpb = nullptr;
        attn_unit<2>(wl, proj, obuf, u, lane);
    }
}
}

__device__ __forceinline__ void prep_pass(const float* xlat, const float* xctx, const float* g, const float* modl, int scoff, bf16_t* hn, float* rs, int gw, int ngw, int lane) {
    for (int m = gw; m < MALL; m += ngw) {
        const bool lat = m < MLAT; const float* xr = lat ? xlat + (size_t)m * DM : xctx + (size_t)(m - MLAT) * DM; const int b = lat ? (m >> 11) : 8;
        f32x4 v[4]; float ss = 0.f;
#pragma unroll
        for (int j = 0; j < 4; ++j) { v[j] = *(const f32x4*)(xr + 4 * lane + 256 * j); ss += (v[j][0] * v[j][0] + v[j][1] * v[j][1]) + (v[j][2] * v[j][2] + v[j][3] * v[j][3]); }
        ss = wave_sum(ss);
        if (lane < 16) rs[(size_t)m * 16 + lane] = (lane == 0) ? ss : 0.f;
        const float* mb = modl + (size_t)b * MODW;
#pragma unroll
        for (int j = 0; j < 4; ++j) { const int c = 4 * lane + 256 * j;
            const f32x4 gg = *(const f32x4*)(g + c), scv = *(const f32x4*)(mb + scoff + c);
            const f32x4 y = v[j] * gg * (scv + 1.0f);
            u32x2 w; w.x = pk2(y[0], y[1]); w.y = pk2(y[2], y[3]);
            *(u32x2*)(hn + (size_t)m * DM + c) = w; }
    }
}
__device__ __forceinline__ void bias_items(const bf16_t* win_t, const bf16_t* w1_t, const float* mod, float* bin, float* b1, int gw, int ngw, int lane) {
    constexpr int CH_IN = INW / 64, CH_1 = FFN / 64, PER_B = CH_IN + CH_1, PER_L = 9 * PER_B;
    for (int it = gw; it < 2 * PER_L; it += ngw) {
        const int l2 = it / PER_L; int r = it - l2 * PER_L; const int b = r / PER_B; r -= b * PER_B;
        const bool isin = r < CH_IN; const int ch = isin ? r : r - CH_IN;
        const bf16_t* Wt = (isin ? win_t + (size_t)l2 * INW * DM : w1_t + (size_t)l2 * FFN * DM) + (size_t)ch * 64 * DM + 16 * lane;
        const float* sp = mod + (size_t)(l2 * 9 + b) * MODW + (isin ? 0 : 3 * DM) + 16 * lane;
        float* outp = (isin ? bin + (size_t)(l2 * 9 + b) * INW : b1 + (size_t)(l2 * 9 + b) * FFN) + ch * 64;
        f32x4 sh[4];
#pragma unroll
        for (int j = 0; j < 4; ++j) sh[j] = *(const f32x4*)(sp + 4 * j);
#pragma unroll 1
        for (int c0 = 0; c0 < 64; c0 += 16) {
            u32x4 w[16][2];
#pragma unroll
            for (int j = 0; j < 16; ++j) { w[j][0] = *(const u32x4*)(Wt + (size_t)(c0 + j) * DM); w[j][1] = *(const u32x4*)(Wt + (size_t)(c0 + j) * DM + 8); }
            float res = 0.f;
#pragma unroll
            for (int j = 0; j < 16; ++j) { float s = 0.f;
#pragma unroll
                for (int q = 0; q < 2; ++q) { const u32x4 x = w[j][q];
                    s += (bf_lo(x[0]) * sh[2 * q][0] + bf_hi(x[0]) * sh[2 * q][1]) + (bf_lo(x[1]) * sh[2 * q][2] + bf_hi(x[1]) * sh[2 * q][3])
                       + (bf_lo(x[2]) * sh[2 * q + 1][0] + bf_hi(x[2]) * sh[2 * q + 1][1]) + (bf_lo(x[3]) * sh[2 * q + 1][2] + bf_hi(x[3]) * sh[2 * q + 1][3]); }
                s = wave_sum(s); res = (lane == j) ? s : res; }
            if (lane < 16) outp[c0 + lane] = res;
        }
    }
}

__device__ __forceinline__ void mix_pass(const bf16_t* proj, const bf16_t* obuf, const float* convw, const float* convb, const float* gout, bf16_t* abuf, int nrows, int gw, int ngw, int lane) {
    for (int m = gw; m < nrows; m += ngw) {
        float va[8];
        if (lane < 32) {
            const u32x4 raw = *(const u32x4*)(obuf + (size_t)m * DM + 8 * lane);
#pragma unroll
            for (int j = 0; j < 4; ++j) { va[2 * j] = bf_lo(raw[j]); va[2 * j + 1] = bf_hi(raw[j]); }
        } else {
            const int c = 8 * (lane - 32); const bool lat = m < MLAT; const int t = lat ? (m & (SEQ - 1)) : ((m - MLAT) & (CTXL - 1)); const int L = lat ? SEQ : CTXL;
            const bf16_t* pr = proj + (size_t)m * INW;
            const u32x4 cx = *(const u32x4*)(pr + 768 + c), cb = *(const u32x4*)(pr + 1024 + c), cc = *(const u32x4*)(pr + 1280 + c);
            u32x4 pxm = {0u, 0u, 0u, 0u}, pcm = {0u, 0u, 0u, 0u}, pxp = {0u, 0u, 0u, 0u}, pcp = {0u, 0u, 0u, 0u};
            if (t > 0) { pxm = *(const u32x4*)(pr - INW + 768 + c); pcm = *(const u32x4*)(pr - INW + 1280 + c); }
            if (t < L - 1) { pxp = *(const u32x4*)(pr + INW + 768 + c); pcp = *(const u32x4*)(pr + INW + 1280 + c); }
            const f32x4 w0a = *(const f32x4*)(convw + c), w0b = *(const f32x4*)(convw + c + 4), w1a = *(const f32x4*)(convw + 256 + c), w1b = *(const f32x4*)(convw + 256 + c + 4),
                        w2a = *(const f32x4*)(convw + 512 + c), w2b = *(const f32x4*)(convw + 512 + c + 4), bba = *(const f32x4*)(convb + c), bbb = *(const f32x4*)(convb + c + 4);
#pragma unroll
            for (int j = 0; j < 4; ++j) {
                const float w0l = j < 2 ? w0a[2 * j] : w0b[2 * j - 4], w0h = j < 2 ? w0a[2 * j + 1] : w0b[2 * j - 3];
                const float w1l = j < 2 ? w1a[2 * j] : w1b[2 * j - 4], w1h = j < 2 ? w1a[2 * j + 1] : w1b[2 * j - 3];
                const float w2l = j < 2 ? w2a[2 * j] : w2b[2 * j - 4], w2h = j < 2 ? w2a[2 * j + 1] : w2b[2 * j - 3];
                const float bl = j < 2 ? bba[2 * j] : bbb[2 * j - 4], bh = j < 2 ? bba[2 * j + 1] : bbb[2 * j - 3];
                const float ul = bf_lo(cc[j]) * bf_lo(cx[j]), uh = bf_hi(cc[j]) * bf_hi(cx[j]);
                const float uml = bf_lo(pcm[j]) * bf_lo(pxm[j]), umh = bf_hi(pcm[j]) * bf_hi(pxm[j]);
                const float upl = bf_lo(pcp[j]) * bf_lo(pxp[j]), uph = bf_hi(pcp[j]) * bf_hi(pxp[j]);
                va[2 * j] = bf_lo(cb[j]) * (bl + w0l * uml + w1l * ul + w2l * upl);
                va[2 * j + 1] = bf_hi(cb[j]) * (bh + w0h * umh + w1h * uh + w2h * uph);
            }
        }
        float ssa = 0.f;
#pragma unroll
        for (int j = 0; j < 8; ++j) ssa += va[j] * va[j];
        ssa = half_sum(ssa); const float rsa = 1.0f / sqrtf(ssa * (1.0f / 256.0f) + EPSN);
        { const f32x4 g0 = *(const f32x4*)(gout + 8 * lane), g1 = *(const f32x4*)(gout + 8 * lane + 4);
          u32x4 w; w.x = pk2(va[0] * rsa * g0[0], va[1] * rsa * g0[1]); w.y = pk2(va[2] * rsa * g0[2], va[3] * rsa * g0[3]); w.z = pk2(va[4] * rsa * g1[0], va[5] * rsa * g1[1]); w.w = pk2(va[6] * rsa * g1[2], va[7] * rsa * g1[3]);
          *(u32x4*)(abuf + (size_t)m * DM + 8 * lane) = w; }
        float vb[8];
        { const u32x4 raw = *(const u32x4*)(obuf + (size_t)m * DM + 512 + 8 * lane);
#pragma unroll
          for (int j = 0; j < 4; ++j) { vb[2 * j] = bf_lo(raw[j]); vb[2 * j + 1] = bf_hi(raw[j]); } }
        float ssb = 0.f;
#pragma unroll
        for (int j = 0; j < 8; ++j) ssb += vb[j] * vb[j];
        ssb = wave_sum(ssb); const float rsb = 1.0f / sqrtf(ssb * (1.0f / 512.0f) + EPSN);
        { const f32x4 g0 = *(const f32x4*)(gout + 512 + 8 * lane), g1 = *(const f32x4*)(gout + 512 + 8 * lane + 4);
          u32x4 w; w.x = pk2(vb[0] * rsb * g0[0], vb[1] * rsb * g0[1]); w.y = pk2(vb[2] * rsb * g0[2], vb[3] * rsb * g0[3]); w.z = pk2(vb[4] * rsb * g1[0], vb[5] * rsb * g1[1]); w.w = pk2(vb[6] * rsb * g1[2], vb[7] * rsb * g1[3]);
          *(u32x4*)(abuf + (size_t)m * DM + 512 + 8 * lane) = w; }
    }
}

__device__ __forceinline__ void mod_item(int item, const float* c, const float* cctx, const float* wmod, const float* bmod, float* mod, LAS unsigned char* lds, int tid, int wave, int lane) {
    LAS float* sl = (LAS float*)lds;
    LAS float* red = (LAS float*)(lds + 9 * 1024 * 4);
    const int l = item / 96, n0 = (item % 96) * 64;
    for (int i = tid; i < 9 * 1024; i += 512) { const int r = i >> 10, k = i & 1023; const float v = r < 8 ? c[r * 1024 + k] : cctx[k]; sl[i] = v / (1.0f + __expf(-v)); }
    __syncthreads();
    float acc[9];
#pragma unroll
    for (int r = 0; r < 9; ++r) acc[r] = 0.f;
    const float* wp = wmod + ((size_t)l * 1024 + wave * 128) * MODW + n0 + lane;
#pragma unroll 8
    for (int k = 0; k < 128; ++k) { const float wv = wp[(size_t)k * MODW];
#pragma unroll
        for (int r = 0; r < 9; ++r) acc[r] += sl[r * 1024 + wave * 128 + k] * wv; }
#pragma unroll
    for (int r = 0; r < 9; ++r) red[(wave * 9 + r) * 64 + lane] = acc[r];
    __syncthreads();
    for (int i = tid; i < 9 * 64; i += 512) { const int r = i >> 6, ln = i & 63; float s = bmod[l * MODW + n0 + ln];
#pragma unroll
        for (int w = 0; w < 8; ++w) s += red[(w * 9 + r) * 64 + ln];
        mod[((size_t)l * 9 + r) * MODW + n0 + ln] = s; }
    __syncthreads();
}
__device__ __forceinline__ int rowmap_in(int c) {
    const int pn = c >> 8; if (pn >= 2 && pn <= 5) return c;
    const int wc = (c >> 6) & 3, d = c & 63, bj = d >> 5; const bool vhead = (pn == 8) && (wc >= 2);
    int n, fq; const int e = d & 3;
    if (!vhead) { n = (d >> 4) & 1; fq = (d >> 2) & 3; } else { fq = (d >> 3) & 3; n = (d >> 2) & 1; }
    return pn * 256 + bj * 128 + wc * 32 + fq * 8 + n * 4 + e;
}
template <bool MAPIN> __device__ __forceinline__ void transpose_item(const float* W, int K, int N, bf16_t* WT, LAS float* scr, int item, int lane) {
    const int nblk = N / 32, kb = item / nblk, nb = item % nblk, k0 = 64 * kb, n0 = 32 * nb;
#pragma unroll 8
    for (int i = 0; i < 32; ++i) { const int kk = 2 * i + (lane >> 5); scr[kk * 33 + (lane & 31)] = W[(size_t)(k0 + kk) * N + n0 + (lane & 31)]; }
    asm volatile("s_waitcnt lgkmcnt(0)" ::: "memory");
    const int c = lane & 7;
#pragma unroll
    for (int j = 0; j < 4; ++j) { const int n = (lane >> 3) + 8 * j; const LAS float* s = scr + (8 * c) * 33 + n;
        u32x4 o; o.x = pk2(s[0 * 33], s[1 * 33]); o.y = pk2(s[2 * 33], s[3 * 33]); o.z = pk2(s[4 * 33], s[5 * 33]); o.w = pk2(s[6 * 33], s[7 * 33]);
        const int orow = MAPIN ? rowmap_in(n0 + n) : (n0 + n);
        *(u32x4*)(WT + (size_t)orow * K + k0 + 8 * c) = o; }
    asm volatile("s_waitcnt lgkmcnt(0)" ::: "memory");
}

#define XB_TMO      128
#define XB_XCNT(j)  (256  + 64 * (j))
#define XB_XSUB(j)  (1280 + 64 * (j))
#define XB_XGEN(j)  (2304 + 64 * (j))
#define XB_TOP      3328
#define XB_TOPGEN   3392
#define XCD_BAR_WORDS 3456
#define XB_SPIN_CAP (1u << 18)

__device__ __forceinline__ unsigned xb_ld(unsigned* p)              { return __hip_atomic_load(p, __ATOMIC_RELAXED, __HIP_MEMORY_SCOPE_AGENT); }
__device__ __forceinline__ unsigned xb_add(unsigned* p, unsigned v) { return __hip_atomic_fetch_add(p, v, __ATOMIC_RELAXED, __HIP_MEMORY_SCOPE_AGENT); }
__device__ __forceinline__ unsigned xb_xcc_id() { return (unsigned)__builtin_amdgcn_s_getreg((3 << 11) | 20) & 0xFu; }
#define XB_SPIN(cond, bar) do { unsigned _sp = 0; while (cond) { __builtin_amdgcn_s_sleep(1); \
    if ((++_sp & 255u) == 0u) { if (xb_ld(&(bar)[XB_TMO])) break; if (_sp > XB_SPIN_CAP) { atomicAdd(&(bar)[XB_TMO], 1u); break; } } } } while (0)

struct XcdBarrier {
    unsigned* bar; unsigned x;
    volatile LAS unsigned* st;
};

__device__ __forceinline__ XcdBarrier xcd_barrier_post(unsigned* bar, volatile LAS unsigned* st) {
    XcdBarrier b; b.bar = bar; b.x = xb_xcc_id(); b.st = st;
    if (threadIdx.x == 0) (void)xb_add(&bar[XB_XCNT(b.x)], 1u);
    return b;
}
__device__ __forceinline__ void xcd_barrier_complete(unsigned* bar, unsigned x, unsigned& nloc, unsigned& nx) {
    const unsigned G = gridDim.x * gridDim.y * gridDim.z;
    unsigned sum, cnt, mine, sp = 0u;
    for (;;) {
        sum = 0u; cnt = 0u; mine = 0u;
#pragma unroll
        for (unsigned j = 0; j < 16; ++j) { const unsigned c = xb_ld(&bar[XB_XCNT(j)]); sum += c; cnt += (c > 0u) ? 1u : 0u; mine = (j == x) ? c : mine; }
        if (sum == G) break;
        __builtin_amdgcn_s_sleep(1);
        if ((++sp & 255u) == 0u) { if (xb_ld(&bar[XB_TMO])) break; if (sp > XB_SPIN_CAP) { atomicAdd(&bar[XB_TMO], 1u); break; } }
    }
    nloc = mine > 0u ? mine : 1u; nx = cnt > 0u ? cnt : 1u;
}

__device__ __forceinline__ void xcd_barrier(const XcdBarrier& b) {
    asm volatile("s_waitcnt vmcnt(0)" ::: "memory");
    __syncthreads();
    if (threadIdx.x == 0) {
        unsigned* bar = b.bar;
        __builtin_amdgcn_s_waitcnt(0);
        unsigned nloc = b.st[0], nx = b.st[1];
        if (nloc == 0u) { xcd_barrier_complete(bar, b.x, nloc, nx); b.st[0] = nloc; b.st[1] = nx; }
        const unsigned old = xb_add(&bar[XB_XSUB(b.x)], 1u);
        const unsigned gen = old / nloc;
        if (old + 1u == (gen + 1u) * nloc) {
            __builtin_amdgcn_fence(__ATOMIC_RELEASE, "agent");
            asm volatile("s_waitcnt vmcnt(0)" ::: "memory");
            const unsigned og = xb_add(&bar[XB_TOP], 1u);
            const unsigned tg = og / nx;
            if (og + 1u == (tg + 1u) * nx) xb_add(&bar[XB_TOPGEN], 1u);
            else XB_SPIN(xb_ld(&bar[XB_TOPGEN]) == tg, bar);
            __builtin_amdgcn_fence(__ATOMIC_ACQUIRE, "agent");
            xb_add(&bar[XB_XGEN(b.x)], 1u);
            asm volatile("s_waitcnt vmcnt(0)" ::: "memory");
        } else {
            XB_SPIN(xb_ld(&bar[XB_XGEN(b.x)]) == gen, bar);
            __builtin_amdgcn_fence(__ATOMIC_ACQUIRE, "agent");
            asm volatile("s_waitcnt vmcnt(0)" ::: "memory");
        }
    }
    __syncthreads();
}

constexpr int LDS_ST_OFF = 8 * att::WAVE_LDS + 512;
constexpr int LDS_BYTES = LDS_ST_OFF + 64;
static_assert(LDS_BYTES <= 160 * 1024 && LDS_BYTES >= pg8::STAGE_BYTES, "LDS budget");
constexpr int N_PHASES = 14;
struct Params { const float* in[21]; float* out; unsigned char* ws; int ph_lo, ph_hi; };

#ifndef REPMASK
#define REPMASK 0
#endif
#ifndef EXTRA_SYNC
#define EXTRA_SYNC 0
#endif
__global__ void __launch_bounds__(512, 2) fwd_kernel(Params P) {
    extern __shared__ __attribute__((aligned(16))) unsigned char lds_raw[];
    LAS unsigned char* lds = (LAS unsigned char*)lds_raw;
    {   volatile LAS unsigned* bst0 = (volatile LAS unsigned*)(lds + LDS_ST_OFF);
        if (threadIdx.x < 16) bst0[threadIdx.x] = 0u;
        __syncthreads();
        (void)xcd_barrier_post((unsigned*)(P.ws + WS_BAR), bst0); }
#define GRID_SYNC() do { unsigned* bp_ = (unsigned*)(P.ws + WS_BAR); asm volatile("" : "+s"(bp_)); XcdBarrier b_; b_.bar = bp_; b_.x = xb_xcc_id(); b_.st = (volatile LAS unsigned*)(lds + LDS_ST_OFF); xcd_barrier(b_); } while (0)
#define LANE_OPAQUE int ln_ = pg8::lane_id(); asm volatile("" : "+v"(ln_)); const int tid_ = wave * 64 + ln_; (void)tid_
#define WSP(T, off) ((T*)(ws + (off)))
#define MODL (WSP(const float, WS_MOD) + (size_t)ly * 9 * MODW)
#define XL ((ly == 0) ? P.in[0] : (const float*)P.out)
#define CL ((ly == 0) ? P.in[2] : WSP(const float, WS_CTX))
#define MROWS ((ly == 0) ? MALL : MLAT)
    const int ph_hi = P.ph_hi;
    const int wave = __builtin_amdgcn_readfirstlane(threadIdx.x >> 6);
#pragma unroll 1
    for (int ph = P.ph_lo; ph < ph_hi; ++ph) {
        int phv = ph; asm volatile("" : "+s"(phv));
        int kind = 0, ly = 0;
        if (phv >= 1) { const int idx = phv - 1; if (idx < 7) { kind = idx + 1 + (idx >= 5 ? 1 : 0); } else { const int j = idx - 7; ly = 1; kind = j + 2 + (j >= 4 ? 1 : 0); } }
        const int G = gridDim.x, bx = blockIdx.x; const int vcu = (G % 8 == 0) ? (bx % 8) * (G / 8) + bx / 8 : bx; const int gw = vcu * 8 + wave, ngw = G * 8;
        unsigned char* ws = P.ws;
#pragma unroll 1
        for (int rep_ = 0; rep_ <= ((REPMASK >> kind) & 1); ++rep_) {
        if (rep_) GRID_SYNC();
        switch (kind) {
        case 0: { LANE_OPAQUE;
            if (bx == G - 1) { for (int i = tid_; i < 512; i += 512) { const int l2 = i >> 8, k = (i >> 6) & 3, d = i & 63; const float* src = P.in[k == 0 ? 9 : k == 1 ? 10 : k == 2 ? 14 : 15]; WSP(float, WS_GAIN)[i] = src[l2 * 64 + d]; } }
            if (bx < 192) mod_item(bx, P.in[1], P.in[3], P.in[4], P.in[5], WSP(float, WS_MOD), lds, tid_, wave, ln_);
            LAS float* scr = (LAS float*)(lds + wave * 16384);
            constexpr int I_IN = 16 * (INW / 32), I_O = 16 * (DM / 32), I_1 = 16 * (FFN / 32), I_2 = 64 * (DM / 32), I_L = I_IN + I_O + I_1 + I_2;
            for (int it = gw; it < 2 * I_L; it += ngw) {
                const int l2 = it / I_L; int r = it - l2 * I_L;
                if (r < I_IN) { transpose_item<true>(P.in[8] + (size_t)l2 * DM * INW, DM, INW, WSP(bf16_t, WS_WIN) + (size_t)l2 * INW * DM, scr, r, ln_); continue; } r -= I_IN;
                if (r < I_O) { transpose_item<false>(P.in[18] + (size_t)l2 * DM * DM, DM, DM, WSP(bf16_t, WS_WO) + (size_t)l2 * DM * DM, scr, r, ln_); continue; } r -= I_O;
                if (r < I_1) { transpose_item<false>(P.in[19] + (size_t)l2 * DM * FFN, DM, FFN, WSP(bf16_t, WS_W1) + (size_t)l2 * FFN * DM, scr, r, ln_); continue; } r -= I_1;
                transpose_item<false>(P.in[20] + (size_t)l2 * FFN * DM, FFN, DM, WSP(bf16_t, WS_W2) + (size_t)l2 * DM * FFN, scr, r, ln_);
            }
        } break;
        case 1: { LANE_OPAQUE;
            prep_pass(P.in[0], P.in[2], P.in[6], WSP(const float, WS_MOD), DM, WSP(bf16_t, WS_HN2), WSP(float, WS_RS1), gw, ngw, ln_);
            bias_items(WSP(const bf16_t, WS_WIN), WSP(const bf16_t, WS_W1), WSP(const float, WS_MOD), WSP(float, WS_BIN), WSP(float, WS_B1), gw, ngw, ln_);
        } break;
        case 2: { LANE_OPAQUE;
            pg8::Gemm g{WSP(bf16_t, WS_HN2), WSP(bf16_t, WS_WIN) + (size_t)ly * INW * DM, MALL, INW, DM}; pg8::StaticOrder S; S.init(MALL, INW, G, bx);
            pg8::EpiProj E{WSP(bf16_t, WS_PROJ), WSP(const float, WS_GAIN) + ly * 256, WSP(const float, WS_RS1), WSP(const float, WS_BIN) + (size_t)ly * 9 * INW};
            pg8::gemm_phase<pg8::EpiProj, pg8::StaticOrder, true, true>(lds, g, S, E, wave);
        } break;
        case 3: { LANE_OPAQUE;
            att::attn_phase(lds + wave * att::WAVE_LDS + 256, WSP(bf16_t, WS_PROJ), WSP(bf16_t, WS_OB), P.in[11] + (size_t)ly * 4 * 15 * 31, P.in[16] + ly * 8, ly == 0, gw, ngw, ln_);
        } break;
        case 4: { LANE_OPAQUE;
            mix_pass(WSP(bf16_t, WS_PROJ), WSP(bf16_t, WS_OB), P.in[12] + (size_t)ly * 3 * 256, P.in[13] + ly * 256, P.in[17] + ly * DM, WSP(bf16_t, WS_HN), MROWS, gw, ngw, ln_);
        } break;
        case 5: { LANE_OPAQUE;
            pg8::Gemm g{WSP(bf16_t, WS_HN), WSP(bf16_t, WS_WO) + (size_t)ly * DM * DM, MROWS, DM, DM}; pg8::StaticOrder S; S.init(MROWS, DM, G, bx);
            pg8::EpiResid E{XL, CL, P.out, WSP(float, WS_CTX), MODL + 2 * DM, WSP(bf16_t, WS_HN2), P.in[7] + ly * DM, MODL + 4 * DM, WSP(float, WS_RS2)};
            pg8::gemm_phase<pg8::EpiResid, pg8::StaticOrder, true, true>(lds, g, S, E, wave);
        } break;
        case 7: { LANE_OPAQUE;
            pg8::Gemm g{WSP(bf16_t, WS_HN2), WSP(bf16_t, WS_W1) + (size_t)ly * FFN * DM, MROWS, FFN, DM}; pg8::StaticOrder S; S.init(MROWS, FFN, G, bx);
            pg8::EpiFc1 E{WSP(bf16_t, WS_H1), FFN, WSP(const float, WS_RS2), WSP(const float, WS_B1) + (size_t)ly * 9 * FFN};
            pg8::gemm_phase<pg8::EpiFc1, pg8::StaticOrder, true, true>(lds, g, S, E, wave);
        } break;
        default: { LANE_OPAQUE;
            pg8::Gemm g{WSP(bf16_t, WS_H1), WSP(bf16_t, WS_W2) + (size_t)ly * DM * FFN, MROWS, DM, FFN}; pg8::StaticOrder S; S.init(MROWS, DM, G, bx);
            pg8::EpiResid E{P.out, WSP(float, WS_CTX), P.out, WSP(float, WS_CTX), MODL + 5 * DM, (ly == 0) ? WSP(bf16_t, WS_HN2) : (bf16_t*)nullptr, P.in[6] + DM, WSP(const float, WS_MOD) + (size_t)9 * MODW + DM, WSP(float, WS_RS1)};
            pg8::gemm_phase<pg8::EpiResid, pg8::StaticOrder, true, true>(lds, g, S, E, wave);
        } break;
        }
        }
        for (int es_ = 0; es_ < EXTRA_SYNC; ++es_) GRID_SYNC();
        if (ph + 1 < ph_hi) GRID_SYNC();
    }
}

#ifndef MK_MULTI_LAUNCH
#define MK_MULTI_LAUNCH 0
#endif
extern "C" void kernel_launch(void* const* d_in, const int* in_sizes, int n_in, void* d_out, int out_size, void* d_ws, size_t ws_size, hipStream_t stream) {
    static int grid = 0;
    if (grid == 0) {
        if (n_in != 21 || out_size != MLAT * DM || ws_size < WS_END) { fprintf(stderr, "kernel_launch: unexpected shapes (n_in %d out %d ws %zu)\n", n_in, out_size, ws_size); grid = -1; return; }
        int dev = 0, cus = 0, per_cu = 0;
        if (hipGetDevice(&dev) != hipSuccess || hipDeviceGetAttribute(&cus, hipDeviceAttributeMultiprocessorCount, dev) != hipSuccess) { grid = -1; return; }
        if (hipFuncSetAttribute((const void*)fwd_kernel, hipFuncAttributeMaxDynamicSharedMemorySize, LDS_BYTES) != hipSuccess) { fprintf(stderr, "kernel_launch: hipFuncSetAttribute failed\n"); grid = -1; return; }
        if (hipOccupancyMaxActiveBlocksPerMultiprocessor(&per_cu, (const void*)fwd_kernel, 512, LDS_BYTES) != hipSuccess || per_cu < 1) { fprintf(stderr, "kernel_launch: occupancy query gave %d\n", per_cu); (void)hipGetLastError(); grid = -1; return; }
        grid = cus * per_cu;
    }
    if (grid < 0) return;
    Params p{};
    for (int i = 0; i < 21; ++i) p.in[i] = (const float*)d_in[i];
    p.out = (float*)d_out; p.ws = (unsigned char*)d_ws;
    if (hipMemsetAsync((char*)d_ws + WS_BAR, 0, XCD_BAR_WORDS * 4, stream) != hipSuccess) { fprintf(stderr, "kernel_launch: memset of the barrier words failed\n"); return; }
    void* args[] = {&p};
#if MK_MULTI_LAUNCH
    for (int ph = 0; ph < N_PHASES; ++ph) { p.ph_lo = ph; p.ph_hi = ph + 1;
        hipError_t e = hipLaunchCooperativeKernel((const void*)fwd_kernel, dim3(grid), dim3(512), args, LDS_BYTES, stream);
        if (e != hipSuccess) { fprintf(stderr, "launch %d failed: %s\n", ph, hipGetErrorString(e)); break; } }
#else
    p.ph_lo = 0; p.ph_hi = N_PHASES;
    hipError_t e = hipLaunchCooperativeKernel((const void*)fwd_kernel, dim3(grid), dim3(512), args, LDS_BYTES, stream);
    if (e != hipSuccess) fprintf(stderr, "cooperative launch failed: %s (grid %d)\n", hipGetErrorString(e), grid);
#endif
}
```

```cpp
#include <hip/hip_runtime.h>
#include <cstdio>
#include <cstdint>
namespace pg8 {
#define PG8_LAS __attribute__((address_space(3)))
typedef unsigned short bf16_t;
__device__ __forceinline__ int lane_id() { int r; asm volatile("v_mbcnt_lo_u32_b32 %0, -1, 0\n\tv_mbcnt_hi_u32_b32 %0, -1, %0" : "=v"(r)); return r; }
template <int K> __device__ __forceinline__ float shx(float v) { static_assert(K == 1 || K == 2 || K == 4 || K == 8 || K == 16, "xor mask"); return __builtin_bit_cast(float, __builtin_amdgcn_ds_swizzle(__builtin_bit_cast(int, v), 0x1f | (K << 10))); }
__device__ __forceinline__ void swap_halves(float& a, float& b) { asm("s_nop 1\n\tv_permlane32_swap_b32 %0, %1" : "+v"(a), "+v"(b)); }
__device__ __forceinline__ float sum_halves(float v) { float a = v, b = v; swap_halves(a, b); return a + b; }
__device__ __forceinline__ float max_halves(float v) { float a = v, b = v; swap_halves(a, b); return fmaxf(a, b); }
typedef short bf16x8 __attribute__((ext_vector_type(8)));
typedef float f32x4 __attribute__((ext_vector_type(4)));
typedef unsigned u32x4 __attribute__((ext_vector_type(4)));
constexpr int BM = 256, BK = 64, HALF = 128, HTB = HALF * BK * 2  , STAGE_BYTES = 8 * HTB, NXCD = 8, WGM = 8;

__host__ __device__ __forceinline__ int lds_byte(int r, int c) { const int st = (r >> 4) * 2 + (c >> 5), rr = r & 15, cc = c & 31, ob = rr * 64 + cc * 2; return st * 1024 + (ob ^ (((ob >> 9) & 1) << 5)); }
__host__ __device__ __forceinline__ void stage_rc(int b, int& R, int& C) { const int st = b / 1024, sb = b % 1024, swz = sb ^ (((sb >> 9) & 1) << 5); R = (st >> 1) * 16 + swz / 64; C = (st & 1) * 32 + (swz % 64) / 2; }
__host__ __device__ __forceinline__ int perm32(int rho) { const int n = rho >> 4, i = rho & 15; return 8 * (i >> 2) + 4 * n + (i & 3); }

struct Unit { int pm, pn; };
struct Gemm { const bf16_t* A; const bf16_t* Bt; int M, N, K; };

struct StaticOrder {
    int nM, nN, nwg, G, c;
    __host__ __device__ void init(int M, int N, int G_, int c_) { nM = M / BM; nN = N / BM; nwg = nM * nN; G = G_; c = c_; }
    __host__ __device__ bool next(int i, Unit& u) const {
        const long L = (long)i * G + c; if (L >= nwg) return false;
        int wgid = (int)L; { const int q = nwg / NXCD, r = nwg % NXCD, xcd = wgid % NXCD, off = wgid / NXCD; wgid = (xcd < r ? xcd * (q + 1) : r * (q + 1) + (xcd - r) * q) + off; }
        const int nig = WGM * nN, gid = wgid / nig, fm = gid * WGM, gsz = (nM - fm) < WGM ? (nM - fm) : WGM;
        u.pm = fm + ((wgid % nig) % gsz); u.pn = (wgid % nig) / gsz; return true;
    }
    __device__ __forceinline__ void a_ready(const Unit&) const {}
    __device__ __forceinline__ void done(const Unit&) const {}
};
__device__ __forceinline__ unsigned cvt_pk_bf16(float lo, float hi) { unsigned r; asm volatile("v_cvt_pk_bf16_f32 %0, %1, %2" : "=v"(r) : "v"(lo), "v"(hi)); return r; }
typedef float f32x2 __attribute__((ext_vector_type(2)));
template <class Epi, class Sched, bool ALIGN_EPI = false, bool SP2 = false>
__device__ __forceinline__ void gemm_phase(PG8_LAS unsigned char* lds, const Gemm g, const Sched& S, const Epi& E, const int wid_in) {
    int tid_ = wid_in * 64 + lane_id(); asm volatile("" : "+v"(tid_));
    const int tid = tid_, wid = __builtin_amdgcn_readfirstlane(tid >> 6), lane = tid & 63, wr = wid >> 2, wc = wid & 3, fr = lane & 15, fq = lane >> 4;
    const int K = g.K, nt = K / BK;
    unsigned voffA[2], voffB[2];
#pragma unroll
    for (int i = 0; i < 2; ++i) { int R, C; stage_rc(tid * 16 + i * 8192, R, C); const int Rb = Epi::PERM ? ((R & ~31) + perm32(R & 31)) : R;
        voffA[i] = (unsigned)(R * K + C) * 2u; voffB[i] = (unsigned)(Rb * K + C) * 2u; }
    const size_t kstep = (size_t)(BK * 2);
    const size_t hstep = (size_t)HALF * K * 2;
    const size_t tstep = 2 * hstep;
    const unsigned ldsw = (unsigned)wid * 1024u;
    const int aoff = lds_byte(wr * 64 + fr, fq * 8), boff = lds_byte(wc * 32 + fr, fq * 8);
#define PG8_SA(b, h) (((b) * 2 + (h)) * HTB)
#define PG8_SB(b, h) ((4 + (b) * 2 + (h)) * HTB)
#define PG8_STAGE(bufoff, gbase, voff) do { _Pragma("unroll") for (int _i = 0; _i < 2; ++_i) \
        __builtin_amdgcn_global_load_lds((const unsigned*)((const char*)(gbase) + (voff)[_i]), (PG8_LAS unsigned*)(lds + (bufoff) + ldsw + _i * 8192), 16, 0, 0); } while (0)
#define PG8_LDA(dst, b, h) do { _Pragma("unroll") for (int m = 0; m < 4; ++m) _Pragma("unroll") for (int k = 0; k < 2; ++k) dst[m][k] = *(const PG8_LAS bf16x8*)(lds + PG8_SA(b, h) + aoff + m * 2048 + k * 1024); } while (0)
#define PG8_LDB(dst, b, h) do { _Pragma("unroll") for (int n = 0; n < 2; ++n) _Pragma("unroll") for (int k = 0; k < 2; ++k) dst[n][k] = *(const PG8_LAS bf16x8*)(lds + PG8_SB(b, h) + boff + n * 2048 + k * 1024); } while (0)
#define PG8_MMA(ai, bj, At, Bt) do { __builtin_amdgcn_s_setprio(1); _Pragma("unroll") for (int m = 0; m < 4; ++m) _Pragma("unroll") for (int n = 0; n < 2; ++n) _Pragma("unroll") for (int k = 0; k < 2; ++k) \
        acc[ai][bj][m][n] = __builtin_amdgcn_mfma_f32_16x16x32_bf16(Bt[n][k], At[m][k], acc[ai][bj][m][n], 0, 0, 0); __builtin_amdgcn_s_setprio(0); } while (0)
#define PG8_WAIT_V(n) asm volatile("s_waitcnt vmcnt(" #n ")" ::: "memory")
#define PG8_WAIT_L(n) asm volatile("s_waitcnt lgkmcnt(" #n ")" ::: "memory")
#define PG8_BAR __builtin_amdgcn_s_barrier()
#define PG8_SCHED __builtin_amdgcn_sched_barrier(0)
    Unit cur, nxt; int ui = 0;
    if (!S.next(0, cur)) return;
    f32x4 acc[2][2][4][2];
#pragma unroll
    for (int a = 0; a < 2; ++a)
#pragma unroll
        for (int b = 0; b < 2; ++b)
#pragma unroll
            for (int m = 0; m < 4; ++m)
#pragma unroll
                for (int n = 0; n < 2; ++n) acc[a][b][m][n] = (f32x4){0.f, 0.f, 0.f, 0.f};
    bf16x8 At[4][2], B0[2][2], B1[2][2];
    const char* cA = (const char*)g.A + (size_t)cur.pm * tstep; const char* cB = (const char*)g.Bt + (size_t)cur.pn * tstep;
    S.a_ready(cur);
    if constexpr (SP2) {
        PG8_STAGE(PG8_SB(0, 0), cB, voffB); PG8_STAGE(PG8_SB(0, 1), cB + hstep, voffB); PG8_STAGE(PG8_SA(0, 0), cA, voffA); PG8_STAGE(PG8_SA(0, 1), cA + hstep, voffA);
        if (wr == 1) PG8_BAR;
        PG8_WAIT_V(2); PG8_BAR;
        PG8_STAGE(PG8_SB(1, 0), cB + kstep, voffB); PG8_STAGE(PG8_SA(1, 0), cA + kstep, voffA); PG8_STAGE(PG8_SB(1, 1), cB + hstep + kstep, voffB);
        PG8_WAIT_V(6); PG8_BAR;
    } else {
        PG8_STAGE(PG8_SB(0, 0), cB, voffB); PG8_STAGE(PG8_SA(0, 0), cA, voffA); PG8_STAGE(PG8_SB(0, 1), cB + hstep, voffB); PG8_STAGE(PG8_SA(0, 1), cA + hstep, voffA);
        if (wr == 1) PG8_BAR;
        PG8_WAIT_V(4); PG8_BAR;
        PG8_STAGE(PG8_SB(1, 0), cB + kstep, voffB); PG8_STAGE(PG8_SA(1, 0), cA + kstep, voffA); PG8_STAGE(PG8_SB(1, 1), cB + hstep + kstep, voffB);
        PG8_WAIT_V(6); PG8_BAR;
    }
    for (;;) {
        const bool has_next = S.next(ui + 1, nxt);
        const char* nA = has_next ? (const char*)g.A + (size_t)nxt.pm * tstep : cA; const char* nB = has_next ? (const char*)g.Bt + (size_t)nxt.pn * tstep : cB;
        for (int t = 0; t < nt; t += 2) {
            const bool last = (t == nt - 2);
            const char* a1 = cA + (size_t)(t + 1) * kstep;
            const char* a2 = last ? nA : cA + (size_t)(t + 2) * kstep; const char* b2 = last ? nB : cB + (size_t)(t + 2) * kstep;
            const char* a3 = a2 + kstep; const char* b3 = b2 + kstep;
            if (last && has_next) S.a_ready(nxt);
            if constexpr (SP2) {
            PG8_LDB(B0, 0, 0); PG8_LDB(B1, 0, 1); PG8_SCHED; PG8_LDA(At, 0, 0); PG8_STAGE(PG8_SA(1, 1), a1 + hstep, voffA);
            PG8_WAIT_V(8); PG8_WAIT_L(0); PG8_BAR; PG8_MMA(0, 0, At, B0); PG8_MMA(0, 1, At, B1); PG8_BAR; PG8_SCHED;
            PG8_LDA(At, 0, 1); PG8_STAGE(PG8_SB(0, 0), b2, voffB); PG8_STAGE(PG8_SB(0, 1), b2 + hstep, voffB); PG8_STAGE(PG8_SA(0, 0), a2, voffA);
            PG8_WAIT_V(8); PG8_WAIT_L(0); PG8_BAR; PG8_MMA(1, 0, At, B0); PG8_MMA(1, 1, At, B1); PG8_BAR; PG8_SCHED;
            PG8_LDB(B0, 1, 0); PG8_LDB(B1, 1, 1); PG8_SCHED; PG8_LDA(At, 1, 0); PG8_STAGE(PG8_SA(0, 1), a2 + hstep, voffA);
            PG8_WAIT_V(8); PG8_WAIT_L(0); PG8_BAR; PG8_MMA(0, 0, At, B0); PG8_MMA(0, 1, At, B1); PG8_BAR; PG8_SCHED;
            PG8_LDA(At, 1, 1); PG8_STAGE(PG8_SB(1, 0), b3, voffB); PG8_STAGE(PG8_SB(1, 1), b3 + hstep, voffB); PG8_STAGE(PG8_SA(1, 0), a3, voffA);
            PG8_WAIT_V(8); PG8_WAIT_L(0); PG8_BAR; PG8_MMA(1, 0, At, B0); PG8_MMA(1, 1, At, B1); PG8_BAR; PG8_SCHED;
            } else {
            PG8_LDB(B0, 0, 0); PG8_SCHED; PG8_LDA(At, 0, 0); PG8_STAGE(PG8_SA(1, 1), a1 + hstep, voffA);
            PG8_WAIT_L(8); PG8_BAR; PG8_WAIT_L(0); PG8_MMA(0, 0, At, B0); PG8_BAR; PG8_SCHED;
            PG8_LDB(B1, 0, 1); PG8_STAGE(PG8_SB(0, 0), b2, voffB);
            PG8_BAR; PG8_WAIT_L(0); PG8_MMA(0, 1, At, B1); PG8_BAR;
            PG8_LDA(At, 0, 1); PG8_STAGE(PG8_SA(0, 0), a2, voffA);
            PG8_BAR; PG8_WAIT_L(0); PG8_MMA(1, 0, At, B0); PG8_BAR; PG8_SCHED;
            PG8_STAGE(PG8_SB(0, 1), b2 + hstep, voffB);
            PG8_WAIT_V(6); PG8_BAR; PG8_MMA(1, 1, At, B1); PG8_BAR;
            PG8_LDB(B0, 1, 0); PG8_SCHED; PG8_LDA(At, 1, 0); PG8_STAGE(PG8_SA(0, 1), a2 + hstep, voffA);
            PG8_WAIT_L(8); PG8_BAR; PG8_WAIT_L(0); PG8_MMA(0, 0, At, B0); PG8_BAR; PG8_SCHED;
            PG8_LDB(B1, 1, 1); PG8_STAGE(PG8_SB(1, 0), b3, voffB);
            PG8_BAR; PG8_WAIT_L(0); PG8_MMA(0, 1, At, B1); PG8_BAR;
            PG8_LDA(At, 1, 1); PG8_STAGE(PG8_SA(1, 0), a3, voffA);
            PG8_BAR; PG8_WAIT_L(0); PG8_MMA(1, 0, At, B0); PG8_BAR; PG8_SCHED;
            PG8_STAGE(PG8_SB(1, 1), b3 + hstep, voffB);
            PG8_WAIT_V(6); PG8_BAR; PG8_MMA(1, 1, At, B1); PG8_BAR;
            }
        }
        if constexpr (ALIGN_EPI) { if (wr == 0) PG8_BAR; }
        if constexpr (!Epi::AFTER_DRAIN) { E(acc, cur, wr, wc, fr, fq); S.done(cur); }
        if (!has_next) break;
#pragma unroll
        for (int a = 0; a < 2; ++a)
#pragma unroll
            for (int b = 0; b < 2; ++b)
#pragma unroll
                for (int m = 0; m < 4; ++m)
#pragma unroll
                    for (int n = 0; n < 2; ++n) acc[a][b][m][n] = (f32x4){0.f, 0.f, 0.f, 0.f};
        cur = nxt; cA = nA; cB = nB; ++ui;
        if constexpr (ALIGN_EPI) { if (wr == 1) PG8_BAR; }
    }
    PG8_WAIT_V(0);
    if constexpr (!ALIGN_EPI) { if (wr == 0) PG8_BAR; }
    PG8_BAR;
    if constexpr (Epi::AFTER_DRAIN) { E.fused(acc, cur, wr, wc, fr, fq, lds, wid, lane); S.done(cur); }
#undef PG8_SA
#undef PG8_SB
#undef PG8_STAGE
#undef PG8_LDA
#undef PG8_LDB
#undef PG8_MMA
#undef PG8_WAIT_V
#undef PG8_WAIT_L
#undef PG8_BAR
#undef PG8_SCHED
}
}

namespace pg8 {
typedef unsigned u32x2 __attribute__((ext_vector_type(2)));
template <int ACT> struct EpiStore {
    static constexpr bool PERM = true, AFTER_DRAIN = false;
    bf16_t* O; int ldc;
    __device__ __forceinline__ void operator()(const f32x4 (&acc)[2][2][4][2], const Unit& u, int wr, int wc, int fr, int fq) const {
        const int row0 = u.pm * BM + wr * 64 + fr, col0 = u.pn * BM + wc * 32 + 8 * fq;
#pragma unroll
        for (int ai = 0; ai < 2; ++ai)
#pragma unroll
            for (int m = 0; m < 4; ++m) { bf16_t* rowp = O + (size_t)(row0 + ai * HALF + m * 16) * ldc + col0;
#pragma unroll
                for (int bj = 0; bj < 2; ++bj) { f32x4 v0 = acc[ai][bj][m][0], v1 = acc[ai][bj][m][1];
                    if (ACT == 2) {
#pragma unroll
                        for (int e = 0; e < 4; ++e) { const float a = fmaxf(v0[e], 0.f), b = fmaxf(v1[e], 0.f); v0[e] = a * a; v1[e] = b * b; } }
                    u32x4 w; w.x = cvt_pk_bf16(v0[0], v0[1]); w.y = cvt_pk_bf16(v0[2], v0[3]); w.z = cvt_pk_bf16(v1[0], v1[1]); w.w = cvt_pk_bf16(v1[2], v1[3]);
                    *(u32x4*)(rowp + bj * HALF) = w; } }
    }
};


__device__ __forceinline__ void rows_rstd(const float* rs, int row0, int fq, float (&rstd)[2][4]) {
    f32x4 p[2][4];
#pragma unroll
    for (int ai = 0; ai < 2; ++ai)
#pragma unroll
        for (int m = 0; m < 4; ++m) p[ai][m] = *(const f32x4*)(rs + (size_t)(row0 + ai * HALF + m * 16) * 16 + 4 * fq);
#pragma unroll
    for (int ai = 0; ai < 2; ++ai)
#pragma unroll
        for (int m = 0; m < 4; ++m) { float s = (p[ai][m][0] + p[ai][m][1]) + (p[ai][m][2] + p[ai][m][3]); s += shx<16>(s); s = sum_halves(s); rstd[ai][m] = 1.0f / sqrtf(s * (1.0f / 1024.0f) + 1e-6f); }
}
struct EpiFc1 {
    static constexpr bool PERM = true, AFTER_DRAIN = false;
    bf16_t* O; int ldc; const float* rs; const float* bias;
    __device__ __forceinline__ void operator()(const f32x4 (&acc)[2][2][4][2], const Unit& u, int wr, int wc, int fr_in, int fq_in) const {
        (void)fr_in; (void)fq_in; int ln_e = lane_id(); asm volatile("" : "+v"(ln_e)); const int fr = ln_e & 15, fq = ln_e >> 4;
        const int row0 = u.pm * BM + wr * 64 + fr, col0 = u.pn * BM + wc * 32 + 8 * fq; const int b = (u.pm < 64) ? (u.pm >> 3) : 8;
        f32x4 bv[2][2];
#pragma unroll
        for (int bj = 0; bj < 2; ++bj)
#pragma unroll
            for (int n = 0; n < 2; ++n) bv[bj][n] = *(const f32x4*)(bias + (size_t)b * ldc + col0 + bj * HALF + 4 * n);
        float rsd[2][4]; rows_rstd(rs, row0, fq, rsd);
#pragma unroll
        for (int ai = 0; ai < 2; ++ai)
#pragma unroll
            for (int m = 0; m < 4; ++m) { const int row = row0 + ai * HALF + m * 16; const float rstd = rsd[ai][m]; bf16_t* rowp = O + (size_t)row * ldc + col0;
#pragma unroll
                for (int bj = 0; bj < 2; ++bj) { f32x4 v0 = acc[ai][bj][m][0] * rstd + bv[bj][0], v1 = acc[ai][bj][m][1] * rstd + bv[bj][1];
#pragma unroll
                    for (int e = 0; e < 4; ++e) { const float a = fmaxf(v0[e], 0.f), c = fmaxf(v1[e], 0.f); v0[e] = a * a; v1[e] = c * c; }
                    u32x4 w; w.x = cvt_pk_bf16(v0[0], v0[1]); w.y = cvt_pk_bf16(v0[2], v0[3]); w.z = cvt_pk_bf16(v1[0], v1[1]); w.w = cvt_pk_bf16(v1[2], v1[3]);
                    *(u32x4*)(rowp + bj * HALF) = w; }
                asm volatile("" ::: "memory"); }
    }
};

struct EpiResid {
    static constexpr bool PERM = true, AFTER_DRAIN = false;
    const float* base_lat; const float* base_ctx; float* out_lat; float* out_ctx; const float* gate;
    bf16_t* aout; const float* gn; const float* scn; float* rsout;
    __device__ __forceinline__ void operator()(const f32x4 (&acc)[2][2][4][2], const Unit& u, int wr, int wc, int fr_in, int fq_in) const {
        (void)fr_in; (void)fq_in; int ln_e = lane_id(); asm volatile("" : "+v"(ln_e)); const int fr = ln_e & 15, fq = ln_e >> 4;
        const bool lat = u.pm < 64;
        const int b = lat ? (u.pm >> 3) : 8;
        const size_t roff = (size_t)(lat ? u.pm : u.pm - 64) * BM * 1024;
        const float* base = (lat ? base_lat : base_ctx) + roff; float* out = (lat ? out_lat : out_ctx) + roff;
        const int col0 = u.pn * BM + wc * 32 + 8 * fq;
        f32x4 gv[2][2];
#pragma unroll
        for (int bj = 0; bj < 2; ++bj)
#pragma unroll
            for (int n = 0; n < 2; ++n) gv[bj][n] = *(const f32x4*)(gate + (size_t)b * 6144 + col0 + bj * HALF + n * 4);
        if (aout == nullptr) {
#pragma unroll
            for (int ai = 0; ai < 2; ++ai)
#pragma unroll
                for (int m = 0; m < 4; ++m) { const size_t off = (size_t)(ai * HALF + wr * 64 + m * 16 + fr) * 1024 + col0;
#pragma unroll
                    for (int bj = 0; bj < 2; ++bj)
#pragma unroll
                        for (int n = 0; n < 2; ++n) { const f32x4 bs = *(const f32x4*)(base + off + bj * HALF + n * 4);
                            *(f32x4*)(out + off + bj * HALF + n * 4) = bs + gv[bj][n] * acc[ai][bj][m][n]; }
                    if (m & 1) asm volatile("" ::: "memory"); }
            return;
        }
        f32x4 Gv[2][2];
#pragma unroll
        for (int bj = 0; bj < 2; ++bj)
#pragma unroll
            for (int n = 0; n < 2; ++n) Gv[bj][n] = *(const f32x4*)(gn + col0 + bj * HALF + n * 4) * (*(const f32x4*)(scn + (size_t)b * 6144 + col0 + bj * HALF + n * 4) + 1.0f);
        const size_t grow0 = (size_t)u.pm * BM;
#pragma unroll
        for (int ai = 0; ai < 2; ++ai)
#pragma unroll
            for (int m = 0; m < 4; ++m) { const int rl = ai * HALF + wr * 64 + m * 16 + fr; const size_t off = (size_t)rl * 1024 + col0; float ss = 0.f;
                bf16_t* ap = aout + (grow0 + rl) * 1024 + col0;
#pragma unroll
                for (int bj = 0; bj < 2; ++bj) {
                    const f32x4 b0 = *(const f32x4*)(base + off + bj * HALF), b1 = *(const f32x4*)(base + off + bj * HALF + 4);
                    const f32x4 x0 = b0 + gv[bj][0] * acc[ai][bj][m][0], x1 = b1 + gv[bj][1] * acc[ai][bj][m][1];
                    *(f32x4*)(out + off + bj * HALF) = x0; *(f32x4*)(out + off + bj * HALF + 4) = x1;
                    ss += ((x0[0] * x0[0] + x0[1] * x0[1]) + (x0[2] * x0[2] + x0[3] * x0[3])) + ((x1[0] * x1[0] + x1[1] * x1[1]) + (x1[2] * x1[2] + x1[3] * x1[3]));
                    const f32x4 y0 = x0 * Gv[bj][0], y1 = x1 * Gv[bj][1];
                    u32x4 w; w.x = cvt_pk_bf16(y0[0], y0[1]); w.y = cvt_pk_bf16(y0[2], y0[3]); w.z = cvt_pk_bf16(y1[0], y1[1]); w.w = cvt_pk_bf16(y1[2], y1[3]);
                    *(u32x4*)(ap + bj * HALF) = w; }
                ss += shx<16>(ss); ss = sum_halves(ss);
                if (fq == 0) rsout[(grow0 + rl) * 16 + u.pn * 4 + wc] = ss;
                if (m & 1) asm volatile("" ::: "memory"); }
    }
};

struct EpiProj {
    static constexpr bool PERM = true, AFTER_DRAIN = false;
    bf16_t* O; const float* gains;
    const float* rs; const float* bias;
    __device__ __forceinline__ void operator()(const f32x4 (&acc)[2][2][4][2], const Unit& u, int wr, int wc, int fr_in, int fq_in) const {
        (void)fr_in; (void)fq_in; int ln_e = lane_id(); asm volatile("" : "+v"(ln_e)); const int fr = ln_e & 15, fq = ln_e >> 4;
        const int pn = u.pn; const int row0 = u.pm * BM + wr * 64 + fr; const int b = (u.pm < 64) ? (u.pm >> 3) : 8;
        f32x4 bv[2][2];
#pragma unroll
        for (int bj = 0; bj < 2; ++bj)
#pragma unroll
            for (int n = 0; n < 2; ++n) bv[bj][n] = *(const f32x4*)(bias + (size_t)b * 2304 + pn * BM + bj * HALF + wc * 32 + 8 * fq + 4 * n);
        float rsd[2][4]; rows_rstd(rs, row0, fq, rsd);
        if (pn >= 2 && pn <= 5) {
            const int col0 = pn * BM + wc * 32 + 8 * fq;
#pragma unroll
            for (int ai = 0; ai < 2; ++ai)
#pragma unroll
                for (int m = 0; m < 4; ++m) { bf16_t* rowp = O + (size_t)(row0 + ai * HALF + m * 16) * 2304 + col0; const float rstd = rsd[ai][m];
#pragma unroll
                    for (int bj = 0; bj < 2; ++bj) { const f32x4 v0 = acc[ai][bj][m][0] * rstd + bv[bj][0], v1 = acc[ai][bj][m][1] * rstd + bv[bj][1];
                        u32x4 w; w.x = cvt_pk_bf16(v0[0], v0[1]); w.y = cvt_pk_bf16(v0[2], v0[3]); w.z = cvt_pk_bf16(v1[0], v1[1]); w.w = cvt_pk_bf16(v1[2], v1[3]);
                        *(u32x4*)(rowp + bj * HALF) = w; } }
            return;
        }
        const int colh = pn * BM + wc * 64 + 8 * fq;
        const bool vhead = (pn == 8) && (wc >= 2);
        if (vhead) {
#pragma unroll
            for (int ai = 0; ai < 2; ++ai)
#pragma unroll
                for (int m = 0; m < 4; ++m) { bf16_t* rowp = O + (size_t)(row0 + ai * HALF + m * 16) * 2304 + colh; const float rstd = rsd[ai][m];
#pragma unroll
                    for (int bj = 0; bj < 2; ++bj) { const f32x4 v0 = acc[ai][bj][m][0] * rstd + bv[bj][0], v1 = acc[ai][bj][m][1] * rstd + bv[bj][1];
                        u32x4 w; w.x = cvt_pk_bf16(v0[0], v0[1]); w.y = cvt_pk_bf16(v0[2], v0[3]); w.z = cvt_pk_bf16(v1[0], v1[1]); w.w = cvt_pk_bf16(v1[2], v1[3]);
                        *(u32x4*)(rowp + bj * 32) = w; } }
            return;
        }
        const float* gp = gains + 64 * ((pn == 0) ? 0 : (pn == 1) ? 1 : (pn == 8) ? 3 : 2);
        const float qs = (pn == 1 || pn == 8) ? 1.0f : 0.18033688011112042f;
        const bool rope = (pn >= 6) && (u.pm < 64);
        f32x4 gv[2][2];
#pragma unroll
        for (int bj = 0; bj < 2; ++bj)
#pragma unroll
            for (int n = 0; n < 2; ++n) gv[bj][n] = *(const f32x4*)(gp + 32 * bj + 16 * n + 4 * fq);
        float invrev[4];
#pragma unroll
        for (int e = 0; e < 4; ++e) invrev[e] = __builtin_amdgcn_exp2f(-(float)(4 * fq + e) * (13.287712379549449f / 16.0f)) * 0.15915494309189535f;
#pragma unroll
        for (int ai = 0; ai < 2; ++ai)
#pragma unroll
            for (int m = 0; m < 4; ++m) {
                const int row = row0 + ai * HALF + m * 16; const float rstd0 = rsd[ai][m];
                f32x4 v[2][2]; float ss = 0.f;
#pragma unroll
                for (int bj = 0; bj < 2; ++bj)
#pragma unroll
                    for (int n = 0; n < 2; ++n) v[bj][n] = acc[ai][bj][m][n] * rstd0 + bv[bj][n];
                asm volatile("" : "+v"(v[0][0]), "+v"(v[0][1]), "+v"(v[1][0]), "+v"(v[1][1]));
#pragma unroll
                for (int bj = 0; bj < 2; ++bj)
#pragma unroll
                    for (int n = 0; n < 2; ++n) { const f32x4 x = v[bj][n]; ss += (x[0] * x[0] + x[1] * x[1]) + (x[2] * x[2] + x[3] * x[3]); }
                ss += shx<16>(ss); ss = sum_halves(ss);
                const float rstd = 1.0f / sqrtf(ss * (1.0f / 64.0f) + 1e-6f);
#pragma unroll
                for (int bj = 0; bj < 2; ++bj)
#pragma unroll
                    for (int n = 0; n < 2; ++n) v[bj][n] = v[bj][n] * rstd * gv[bj][n];
                if (rope) {
                    const int t = row & 2047;
#pragma unroll
                    for (int bj = 0; bj < 2; ++bj) { const float pos = (float)(bj == 0 ? (t >> 6) : (t & 63));
#pragma unroll
                        for (int e = 0; e < 4; ++e) { float rev = pos * invrev[e]; rev = rev - floorf(rev);
                            const float cs = __builtin_amdgcn_cosf(rev), sn = __builtin_amdgcn_sinf(rev);
                            const float u1 = v[bj][0][e], u2 = v[bj][1][e];
                            v[bj][0][e] = u1 * cs - u2 * sn; v[bj][1][e] = u2 * cs + u1 * sn; } }
                }
                bf16_t* rowp = O + (size_t)row * 2304 + colh;
#pragma unroll
                for (int bj = 0; bj < 2; ++bj) { const f32x4 v0 = v[bj][0] * qs, v1 = v[bj][1] * qs;
                    u32x4 w; w.x = cvt_pk_bf16(v0[0], v0[1]); w.y = cvt_pk_bf16(v0[2], v0[3]); w.z = cvt_pk_bf16(v1[0], v1[1]); w.w = cvt_pk_bf16(v1[2], v1[3]);
                    *(u32x4*)(rowp + bj * 32) = w; }
                asm volatile("" ::: "memory");
            }
    }
};
}

#define LAS __attribute__((address_space(3)))
typedef unsigned short bf16_t;
typedef short bf16x8 __attribute__((ext_vector_type(8)));
typedef short s16x4 __attribute__((ext_vector_type(4)));
typedef float f32x16 __attribute__((ext_vector_type(16)));
typedef float f32x4 __attribute__((ext_vector_type(4)));
typedef unsigned u32x4 __attribute__((ext_vector_type(4)));
typedef unsigned u32x2 __attribute__((ext_vector_type(2)));

constexpr int DM = 1024, NB = 8, SEQ = 2048, CTXL = 256, FFN = 4096, INW = 2304;
constexpr int MLAT = NB * SEQ, MCTX = NB * CTXL, MALL = MLAT + MCTX;
constexpr float EPSN = 1e-6f, LOG2E = 1.4426950408889634f, NEGBIG = -1e30f;
constexpr int MODW = 6 * DM;
constexpr size_t MiB = (size_t)1 << 20;
constexpr size_t WS_MOD = 0;
constexpr size_t WS_GAIN = 512 * 1024;
constexpr size_t WS_BAR = 768 * 1024;
constexpr size_t WS_WIN = 1 * MiB;
constexpr size_t WS_WO = 10 * MiB;
constexpr size_t WS_W1 = 14 * MiB;
constexpr size_t WS_W2 = 30 * MiB;
constexpr size_t WS_CTX = 46 * MiB;
constexpr size_t WS_HN2 = 54 * MiB;
constexpr size_t WS_HN = 207 * MiB;
constexpr size_t WS_H1 = 90 * MiB;
constexpr size_t WS_PROJ = 90 * MiB;
constexpr size_t WS_OB = 171 * MiB;
constexpr size_t WS_RS1 = 243 * MiB;
constexpr size_t WS_RS2 = 245 * MiB;
constexpr size_t WS_BIN = 247 * MiB;
constexpr size_t WS_B1 = 248 * MiB;
constexpr size_t WS_END = 249 * MiB;

__device__ __forceinline__ float half_sum(float v) { v += pg8::shx<1>(v); v += pg8::shx<2>(v); v += pg8::shx<4>(v); v += pg8::shx<8>(v); v += pg8::shx<16>(v); return v; }
__device__ __forceinline__ float wave_sum(float v) { return pg8::sum_halves(half_sum(v)); }
__device__ __forceinline__ unsigned f2bf(float f) { unsigned u = __builtin_bit_cast(unsigned, f); return (u + 0x7fffu + ((u >> 16) & 1u)) >> 16; }
__device__ __forceinline__ unsigned pk2(float lo, float hi) { return f2bf(lo) | (f2bf(hi) << 16); }
__device__ __forceinline__ float bf_lo(unsigned u) { return __builtin_bit_cast(float, u << 16); }
__device__ __forceinline__ float bf_hi(unsigned u) { return __builtin_bit_cast(float, u & 0xffff0000u); }

namespace att {
constexpr int KROWB = 144, VROWB = 128, WL_V = 64 * KROWB, WL_A = WL_V + 64 * VROWB, WL_TAB = WL_A + 128 + 192, WAVE_LDS = WL_TAB + 15 * 32 * 4;
typedef float f32x2_t __attribute__((ext_vector_type(2))); typedef __bf16 bf16x2_t __attribute__((ext_vector_type(2)));
typedef short v4i16_t __attribute__((ext_vector_type(4)));
__device__ __forceinline__ unsigned cvtpk(float lo, float hi) { f32x2_t v = {lo, hi}; bf16x2_t b = __builtin_convertvector(v, bf16x2_t); return __builtin_bit_cast(unsigned, b); }
__device__ __forceinline__ s16x4 vtr(LAS const unsigned char* p) { return __builtin_bit_cast(s16x4, __builtin_amdgcn_ds_read_tr16_b64_v4i16((LAS v4i16_t*)p)); }
struct AU { int qrow0, qcol, kcol, vcol, ocol, ctxrow0, nloc, locrow0, a0, a1; float m0, l0; const float* rpb; };
template <int KIND> __device__ __forceinline__ void attn_unit(LAS unsigned char* wl, const bf16_t* __restrict__ proj, bf16_t* __restrict__ obuf, const AU u, const int lane) {
    const int r32 = lane & 31, hi = lane >> 5;
    LAS float* sc = (LAS float*)(wl + WL_A);
    LAS float* tab = (LAS float*)(wl + WL_TAB);
    bf16x8 qr[4];
    { const bf16_t* qp = proj + (size_t)(u.qrow0 + r32) * INW + u.qcol + hi * 8;
#pragma unroll
      for (int d0 = 0; d0 < 4; ++d0) qr[d0] = *(const bf16x8*)(qp + d0 * 16); }
    if (KIND == 0) { for (int i = lane; i < 15 * 31; i += 64) { const int a = i / 31, b = i - a * 31; tab[a * 32 + b] = u.rpb[i] * LOG2E; } }
    f32x16 o0, o1;
#pragma unroll
    for (int r = 0; r < 16; ++r) { o0[r] = 0.f; o1[r] = 0.f; }
    float m = u.m0, l = (hi == 0) ? u.l0 : 0.f;
    const int nt = 4 + u.nloc;
    const int lrow = lane >> 3, lch = lane & 7;
    u32x4 kreg[8], vreg[8];
#define ATT_LOAD_TILE(t) do { const int row0_ = ((t) < 4) ? u.ctxrow0 + 64 * (t) : u.locrow0 + 64 * ((t) - 4); const bf16_t* bp_ = proj + (size_t)(row0_ + lrow) * INW + lch * 8; \
        _Pragma("unroll") for (int i_ = 0; i_ < 8; ++i_) { kreg[i_] = *(const u32x4*)(bp_ + (size_t)i_ * 8 * INW + u.kcol); vreg[i_] = *(const u32x4*)(bp_ + (size_t)i_ * 8 * INW + u.vcol); } } while (0)
    ATT_LOAD_TILE(0);
    LAS unsigned char* kw = wl + lrow * KROWB + lch * 16;
    LAS unsigned char* vw = wl + WL_V + lrow * VROWB + lch * 16;
    LAS const unsigned char* kf = wl + r32 * KROWB + hi * 16;
    LAS const unsigned char* vf = wl + WL_V + (4 * hi + ((lane & 15) >> 2)) * VROWB + ((lane >> 4) & 1) * 32 + (lane & 3) * 8;
    for (int t = 0; t < nt; ++t) {
#pragma unroll
        for (int i = 0; i < 8; ++i) { *(LAS u32x4*)(kw + i * 8 * KROWB) = kreg[i]; *(LAS u32x4*)(vw + i * 8 * VROWB) = vreg[i]; }
        if (t + 1 < nt) ATT_LOAD_TILE(t + 1);
        f32x16 p0, p1;
#pragma unroll
        for (int r = 0; r < 16; ++r) { p0[r] = 0.f; p1[r] = 0.f; }
#pragma unroll
        for (int d0 = 0; d0 < 4; ++d0) {
            const bf16x8 a0 = *(LAS const bf16x8*)(kf + d0 * 32), a1 = *(LAS const bf16x8*)(kf + 32 * KROWB + d0 * 32);
            p0 = __builtin_amdgcn_mfma_f32_32x32x16_bf16(a0, qr[d0], p0, 0, 0, 0);
            p1 = __builtin_amdgcn_mfma_f32_32x32x16_bf16(a1, qr[d0], p1, 0, 0, 0);
        }
        if (KIND == 0) { if (t >= 4) {
            const int dr = u.a0 + (t - 4), qc = u.a1 + r32; const int cs = min(max(qc - 8, 0), 48);
            const int kb = 4 * hi - cs; LAS const float* tb = tab + dr * 32 + 15 - qc + 4 * hi;
#pragma unroll
            for (int r = 0; r < 16; ++r) { const int kc = (r & 3) + 8 * (r >> 2);
                p0[r] = ((unsigned)(kb + kc) < 16u) ? p0[r] + tb[kc] : NEGBIG;
                p1[r] = ((unsigned)(kb + kc + 32) < 16u) ? p1[r] + tb[kc + 32] : NEGBIG; } } }
        if (KIND == 1) { if (t >= 4) {
            const int d0_ = u.a0 + 64 * (t - 4) + 4 * hi - r32 + 128;
#pragma unroll
            for (int r = 0; r < 16; ++r) { const int kc = (r & 3) + 8 * (r >> 2);
                p0[r] = ((unsigned)(d0_ + kc) <= 256u) ? p0[r] : NEGBIG;
                p1[r] = ((unsigned)(d0_ + kc + 32) <= 256u) ? p1[r] : NEGBIG; } } }
        float mx = fmaxf(p0[0], p1[0]);
#pragma unroll
        for (int r = 1; r < 16; ++r) mx = fmaxf(mx, fmaxf(p0[r], p1[r]));
        mx = pg8::max_halves(mx);
        const float mnew = fmaxf(m, mx); const float alpha = __builtin_amdgcn_exp2f(m - mnew); m = mnew;
        float rs = 0.f;
#pragma unroll
        for (int r = 0; r < 16; ++r) { p0[r] = __builtin_amdgcn_exp2f(p0[r] - mnew); p1[r] = __builtin_amdgcn_exp2f(p1[r] - mnew); rs += p0[r] + p1[r]; }
        l = l * alpha + rs;
        if (hi == 0) sc[r32] = alpha;
#pragma unroll
        for (int g = 0; g < 4; ++g) { const f32x4 a = *(LAS const f32x4*)(sc + 8 * g + 4 * hi);
#pragma unroll
            for (int i = 0; i < 4; ++i) { o0[4 * g + i] *= a[i]; o1[4 * g + i] *= a[i]; } }
        u32x4 pa[4];
#pragma unroll
        for (int j = 0; j < 4; ++j) { pa[0][j] = cvtpk(p0[2 * j], p0[2 * j + 1]); pa[1][j] = cvtpk(p0[8 + 2 * j], p0[8 + 2 * j + 1]); pa[2][j] = cvtpk(p1[2 * j], p1[2 * j + 1]); pa[3][j] = cvtpk(p1[8 + 2 * j], p1[8 + 2 * j + 1]); }
#pragma unroll
        for (int ks = 0; ks < 4; ++ks) {
            const s16x4 l0 = vtr(vf + ks * 16 * VROWB), h0 = vtr(vf + ks * 16 * VROWB + 8 * VROWB);
            const s16x4 l1 = vtr(vf + ks * 16 * VROWB + 64), h1 = vtr(vf + ks * 16 * VROWB + 8 * VROWB + 64);
            const bf16x8 b0 = (bf16x8){l0[0], l0[1], l0[2], l0[3], h0[0], h0[1], h0[2], h0[3]}, b1 = (bf16x8){l1[0], l1[1], l1[2], l1[3], h1[0], h1[1], h1[2], h1[3]};
            o0 = __builtin_amdgcn_mfma_f32_32x32x16_bf16(__builtin_bit_cast(bf16x8, pa[ks]), b0, o0, 0, 0, 0);
            o1 = __builtin_amdgcn_mfma_f32_32x32x16_bf16(__builtin_bit_cast(bf16x8, pa[ks]), b1, o1, 0, 0, 0);
        }
    }
#undef ATT_LOAD_TILE
    const float lt = pg8::sum_halves(l);
    if (hi == 0) sc[r32] = 1.0f / lt;
    bf16_t* ob = obuf + (size_t)u.qrow0 * DM + u.ocol + r32;
#pragma unroll
    for (int g = 0; g < 4; ++g) { const f32x4 a = *(LAS const f32x4*)(sc + 8 * g + 4 * hi);
#pragma unroll
        for (int i = 0; i < 4; ++i) { const int q = i + 8 * g + 4 * hi; bf16_t* op = ob + (size_t)q * DM;
            op[0] = (bf16_t)f2bf(o0[4 * g + i] * a[i]); op[32] = (bf16_t)f2bf(o1[4 * g + i] * a[i]); } }
}

__device__ __forceinline__ void attn_phase(LAS unsigned char* wl, const bf16_t* proj, bf16_t* obuf, const float* rpb_l, const float* sink_l, bool with_ctx, int gw, int ngw, int lane) {
    const int total = 2048 + 4096 + (with_ctx ? 768 : 0);
    for (int i0 = gw; i0 < total; i0 += ngw) {
        int i = i0; AU u;
        if (i < 2048) {
            const int half = i & 1, h = (i >> 1) & 3, r = (i >> 3) & 31, b = i >> 8; const int rs = min(max(r - 4, 0), 24);
            u.qrow0 = b * SEQ + r * 64 + 32 * half; u.qcol = 64 * h; u.kcol = 256 + 64 * h; u.vcol = 512 + 64 * h; u.ocol = 64 * h; u.ctxrow0 = MLAT + b * CTXL;
            u.nloc = 8; u.locrow0 = b * SEQ + rs * 64; u.a0 = rs - r + 7; u.a1 = 32 * half; u.m0 = NEGBIG; u.l0 = 0.f; u.rpb = rpb_l + h * (15 * 31);
            attn_unit<0>(wl, proj, obuf, u, lane);
            continue;
        }
        i -= 2048;
        if (i < 4096) {
            const int ch = i & 63, h = (i >> 6) & 7, b = i >> 9; const int qpos0 = 32 * ch;
            const int kt0 = max(0, (qpos0 - 128) >> 6), kt1 = min(31, (qpos0 + 159) >> 6);
            u.qrow0 = b * SEQ + qpos0; u.qcol = 1536 + 64 * h; u.kcol = 2048 + 64 * (h >> 2); u.vcol = 2176 + 64 * (h >> 2); u.ocol = 512 + 64 * h; u.ctxrow0 = MLAT + b * CTXL;
            u.nloc = kt1 - kt0 + 1; u.locrow0 = b * SEQ + 64 * kt0; u.a0 = 64 * kt0 - qpos0; u.a1 = 0; u.m0 = sink_l[h] * LOG2E; u.l0 = 1.f; u.rpb = nullptr;
            attn_unit<1>(wl, proj, obuf, u, lane);
            continue;
        }
        i -= 4096;
        if (i < 256) {
            const int ch = i & 7, h = (i >> 3) & 3, b = i >> 5;
            u.qrow0 = MLAT + b * CTXL + 32 * ch; u.qcol = 64 * h; u.kcol = 256 + 64 * h; u.vcol = 512 + 64 * h; u.ocol = 64 * h; u.m0 = NEGBIG; u.l0 = 0.f; u.ctxrow0 = MLAT + b * CTXL;
        } else {
            i -= 256; const int ch = i & 7, h = (i >> 3) & 7, b = i >> 6;
            u.qrow0 = MLAT + b * CTXL + 32 * ch; u.qcol = 1536 + 64 * h; u.kcol = 2048 + 64 * (h >> 2); u.vcol = 2176 + 64 * (h >> 2); u.ocol = 512 + 64 * h; u.m0 = sink_l[h] * LOG2E; u.l0 = 1.f; u.ctxrow0 = MLAT + b * CTXL;
        }
        u.nloc = 0; u.locrow0 = 0; u.a0 = 0; u.a1 = 0; u.rpb = nullptr;
        attn_unit<2>(wl, proj, obuf, u, lane);
    }
}
}

__device__ __forceinline__ void prep_pass(const float* xlat, const float* xctx, const float* g, const float* modl, int scoff, bf16_t* hn, float* rs, int gw, int ngw, int lane) {
    for (int m = gw; m < MALL; m += ngw) {
        const bool lat = m < MLAT; const float* xr = lat ? xlat + (size_t)m * DM : xctx + (size_t)(m - MLAT) * DM; const int b = lat ? (m >> 11) : 8;
        f32x4 v[4]; float ss = 0.f;
#pragma unroll
        for (int j = 0; j < 4; ++j) { v[j] = *(const f32x4*)(xr + 4 * lane + 256 * j); ss += (v[j][0] * v[j][0] + v[j][1] * v[j][1]) + (v[j][2] * v[j][2] + v[j][3] * v[j][3]); }
        ss = wave_sum(ss);
        if (lane < 16) rs[(size_t)m * 16 + lane] = (lane == 0) ? ss : 0.f;
        const float* mb = modl + (size_t)b * MODW;
#pragma unroll
        for (int j = 0; j < 4; ++j) { const int c = 4 * lane + 256 * j;
            const f32x4 gg = *(const f32x4*)(g + c), scv = *(const f32x4*)(mb + scoff + c);
            const f32x4 y = v[j] * gg * (scv + 1.0f);
            u32x2 w; w.x = pk2(y[0], y[1]); w.y = pk2(y[2], y[3]);
            *(u32x2*)(hn + (size_t)m * DM + c) = w; }
    }
}
__device__ __forceinline__ void mix_pass(const bf16_t* proj, const bf16_t* obuf, const float* convw, const float* convb, const float* gout, bf16_t* abuf, int nrows, int gw, int ngw, int lane) {
    for (int m = gw; m < nrows; m += ngw) {
        float va[8];
        if (lane < 32) {
            const u32x4 raw = *(const u32x4*)(obuf + (size_t)m * DM + 8 * lane);
#pragma unroll
            for (int j = 0; j < 4; ++j) { va[2 * j] = bf_lo(raw[j]); va[2 * j + 1] = bf_hi(raw[j]); }
        } else {
            const int c = 8 * (lane - 32); const bool lat = m < MLAT; const int t = lat ? (m & (SEQ - 1)) : ((m - MLAT) & (CTXL - 1)); const int L = lat ? SEQ : CTXL;
            const bf16_t* pr = proj + (size_t)m * INW;
            const u32x4 cx = *(const u32x4*)(pr + 768 + c), cb = *(const u32x4*)(pr + 1024 + c), cc = *(const u32x4*)(pr + 1280 + c);
            u32x4 pxm = {0u, 0u, 0u, 0u}, pcm = {0u, 0u, 0u, 0u}, pxp = {0u, 0u, 0u, 0u}, pcp = {0u, 0u, 0u, 0u};
            if (t > 0) { pxm = *(const u32x4*)(pr - INW + 768 + c); pcm = *(const u32x4*)(pr - INW + 1280 + c); }
            if (t < L - 1) { pxp = *(const u32x4*)(pr + INW + 768 + c); pcp = *(const u32x4*)(pr + INW + 1280 + c); }
            const f32x4 w0a = *(const f32x4*)(convw + c), w0b = *(const f32x4*)(convw + c + 4), w1a = *(const f32x4*)(convw + 256 + c), w1b = *(const f32x4*)(convw + 256 + c + 4),
                        w2a = *(const f32x4*)(convw + 512 + c), w2b = *(const f32x4*)(convw + 512 + c + 4), bba = *(const f32x4*)(convb + c), bbb = *(const f32x4*)(convb + c + 4);
#pragma unroll
            for (int j = 0; j < 4; ++j) {
                const float w0l = j < 2 ? w0a[2 * j] : w0b[2 * j - 4], w0h = j < 2 ? w0a[2 * j + 1] : w0b[2 * j - 3];
                const float w1l = j < 2 ? w1a[2 * j] : w1b[2 * j - 4], w1h = j < 2 ? w1a[2 * j + 1] : w1b[2 * j - 3];
                const float w2l = j < 2 ? w2a[2 * j] : w2b[2 * j - 4], w2h = j < 2 ? w2a[2 * j + 1] : w2b[2 * j - 3];
                const float bl = j < 2 ? bba[2 * j] : bbb[2 * j - 4], bh = j < 2 ? bba[2 * j + 1] : bbb[2 * j - 3];
                const float ul = bf_lo(cc[j]) * bf_lo(cx[j]), uh = bf_hi(cc[j]) * bf_hi(cx[j]);
                const float uml = bf_lo(pcm[j]) * bf_lo(pxm[j]), umh = bf_hi(pcm[j]) * bf_hi(pxm[j]);
                const float upl = bf_lo(pcp[j]) * bf_lo(pxp[j]), uph = bf_hi(pcp[j]) * bf_hi(pxp[j]);
                va[2 * j] = bf_lo(cb[j]) * (bl + w0l * uml + w1l * ul + w2l * upl);
                va[2 * j + 1] = bf_hi(cb[j]) * (bh + w0h * umh + w1h * uh + w2h * uph);
            }
        }
        float ssa = 0.f;
#pragma unroll
        for (int j = 0; j < 8; ++j) ssa += va[j] * va[j];
        ssa = half_sum(ssa); const float rsa = 1.0f / sqrtf(ssa * (1.0f / 256.0f) + EPSN);
        { const f32x4 g0 = *(const f32x4*)(gout + 8 * lane), g1 = *(const f32x4*)(gout + 8 * lane + 4);
          u32x4 w; w.x = pk2(va[0] * rsa * g0[0], va[1] * rsa * g0[1]); w.y = pk2(va[2] * rsa * g0[2], va[3] * rsa * g0[3]); w.z = pk2(va[4] * rsa * g1[0], va[5] * rsa * g1[1]); w.w = pk2(va[6] * rsa * g1[2], va[7] * rsa * g1[3]);
          *(u32x4*)(abuf + (size_t)m * DM + 8 * lane) = w; }
        float vb[8];
        { const u32x4 raw = *(const u32x4*)(obuf + (size_t)m * DM + 512 + 8 * lane);
#pragma unroll
          for (int j = 0; j < 4; ++j) { vb[2 * j] = bf_lo(raw[j]); vb[2 * j + 1] = bf_hi(raw[j]); } }
        float ssb = 0.f;
#pragma unroll
        for (int j = 0; j < 8; ++j) ssb += vb[j] * vb[j];
        ssb = wave_sum(ssb); const float rsb = 1.0f / sqrtf(ssb * (1.0f / 512.0f) + EPSN);
        { const f32x4 g0 = *(const f32x4*)(gout + 512 + 8 * lane), g1 = *(const f32x4*)(gout + 512 + 8 * lane + 4);
          u32x4 w; w.x = pk2(vb[0] * rsb * g0[0], vb[1] * rsb * g0[1]); w.y = pk2(vb[2] * rsb * g0[2], vb[3] * rsb * g0[3]); w.z = pk2(vb[4] * rsb * g1[0], vb[5] * rsb * g1[1]); w.w = pk2(vb[6] * rsb * g1[2], vb[7] * rsb * g1[3]);
          *(u32x4*)(abuf + (size_t)m * DM + 512 + 8 * lane) = w; }
    }
}

__device__ __forceinline__ void mod_item(int item, const float* c, const float* cctx, const float* wmod, const float* bmod, float* mod, LAS unsigned char* lds, int tid, int wave, int lane) {
    LAS float* sl = (LAS float*)lds;
    LAS float* red = (LAS float*)(lds + 9 * 1024 * 4);
    const int l = item / 96, n0 = (item % 96) * 64;
    for (int i = tid; i < 9 * 1024; i += 512) { const int r = i >> 10, k = i & 1023; const float v = r < 8 ? c[r * 1024 + k] : cctx[k]; sl[i] = v / (1.0f + __expf(-v)); }
    __syncthreads();
    float acc[9];
#pragma unroll
    for (int r = 0; r < 9; ++r) acc[r] = 0.f;
    const float* wp = wmod + ((size_t)l * 1024 + wave * 128) * MODW + n0 + lane;
#pragma unroll 8
    for (int k = 0; k < 128; ++k) { const float wv = wp[(size_t)k * MODW];
#pragma unroll
        for (int r = 0; r < 9; ++r) acc[r] += sl[r * 1024 + wave * 128 + k] * wv; }
#pragma unroll
    for (int r = 0; r < 9; ++r) red[(wave * 9 + r) * 64 + lane] = acc[r];
    __syncthreads();
    for (int i = tid; i < 9 * 64; i += 512) { const int r = i >> 6, ln = i & 63; float s = bmod[l * MODW + n0 + ln];
#pragma unroll
        for (int w = 0; w < 8; ++w) s += red[(w * 9 + r) * 64 + ln];
        mod[((size_t)l * 9 + r) * MODW + n0 + ln] = s; }
    __syncthreads();
}
__device__ __forceinline__ int rowmap_in(int c) {
    const int pn = c >> 8; if (pn >= 2 && pn <= 5) return c;
    const int wc = (c >> 6) & 3, d = c & 63, bj = d >> 5; const bool vhead = (pn == 8) && (wc >= 2);
    int n, fq; const int e = d & 3;
    if (!vhead) { n = (d >> 4) & 1; fq = (d >> 2) & 3; } else { fq = (d >> 3) & 3; n = (d >> 2) & 1; }
    return pn * 256 + bj * 128 + wc * 32 + fq * 8 + n * 4 + e;
}
template <bool MAPIN> __device__ __forceinline__ void bias_item(const float* W, int ldw, int n0, const float* shrows  , float* out  , LAS unsigned char* lds, int tid, int wave, int lane) {
    LAS float* sl = (LAS float*)lds;
    LAS float* red = (LAS float*)(lds + 9 * 1024 * 4);
    for (int i = tid; i < 9 * 1024; i += 512) { const int r = i >> 10, k = i & 1023; sl[i] = shrows[(size_t)r * MODW + k]; }
    __syncthreads();
    float acc[9];
#pragma unroll
    for (int r = 0; r < 9; ++r) acc[r] = 0.f;
    const float* wp = W + (size_t)(wave * 128) * ldw + n0 + lane;
#pragma unroll 8
    for (int k = 0; k < 128; ++k) { const float wv = wp[(size_t)k * ldw];
#pragma unroll
        for (int r = 0; r < 9; ++r) acc[r] += sl[r * 1024 + wave * 128 + k] * wv; }
#pragma unroll
    for (int r = 0; r < 9; ++r) red[(wave * 9 + r) * 64 + lane] = acc[r];
    __syncthreads();
    for (int i = tid; i < 9 * 64; i += 512) { const int r = i >> 6, ln = i & 63; float s = 0.f;
#pragma unroll
        for (int w = 0; w < 8; ++w) s += red[(w * 9 + r) * 64 + ln];
        const int n = n0 + ln; out[(size_t)r * ldw + (MAPIN ? rowmap_in(n) : n)] = s; }
    __syncthreads();
}
template <bool MAPIN> __device__ __forceinline__ void transpose_item(const float* W, int K, int N, bf16_t* WT, LAS float* scr, int item, int lane) {
    const int nblk = N / 32, kb = item / nblk, nb = item % nblk, k0 = 64 * kb, n0 = 32 * nb;
#pragma unroll 8
    for (int i = 0; i < 32; ++i) { const int kk = 2 * i + (lane >> 5); scr[kk * 33 + (lane & 31)] = W[(size_t)(k0 + kk) * N + n0 + (lane & 31)]; }
    asm volatile("s_waitcnt lgkmcnt(0)" ::: "memory");
    const int c = lane & 7;
#pragma unroll
    for (int j = 0; j < 4; ++j) { const int n = (lane >> 3) + 8 * j; const LAS float* s = scr + (8 * c) * 33 + n;
        u32x4 o; o.x = pk2(s[0 * 33], s[1 * 33]); o.y = pk2(s[2 * 33], s[3 * 33]); o.z = pk2(s[4 * 33], s[5 * 33]); o.w = pk2(s[6 * 33], s[7 * 33]);
        const int orow = MAPIN ? rowmap_in(n0 + n) : (n0 + n);
        *(u32x4*)(WT + (size_t)orow * K + k0 + 8 * c) = o; }
    asm volatile("s_waitcnt lgkmcnt(0)" ::: "memory");
}

#define XB_TMO      128
#define XB_XCNT(j)  (256  + 64 * (j))
#define XB_XSUB(j)  (1280 + 64 * (j))
#define XB_XGEN(j)  (2304 + 64 * (j))
#define XB_TOP      3328
#define XB_TOPGEN   3392
#define XCD_BAR_WORDS 3456
#define XB_SPIN_CAP (1u << 18)

__device__ __forceinline__ unsigned xb_ld(unsigned* p)              { return __hip_atomic_load(p, __ATOMIC_RELAXED, __HIP_MEMORY_SCOPE_AGENT); }
__device__ __forceinline__ unsigned xb_add(unsigned* p, unsigned v) { return __hip_atomic_fetch_add(p, v, __ATOMIC_RELAXED, __HIP_MEMORY_SCOPE_AGENT); }
__device__ __forceinline__ unsigned xb_xcc_id() { return (unsigned)__builtin_amdgcn_s_getreg((3 << 11) | 20) & 0xFu; }
#define XB_SPIN(cond, bar) do { unsigned _sp = 0; while (cond) { __builtin_amdgcn_s_sleep(1); \
    if ((++_sp & 255u) == 0u) { if (xb_ld(&(bar)[XB_TMO])) break; if (_sp > XB_SPIN_CAP) { atomicAdd(&(bar)[XB_TMO], 1u); break; } } } } while (0)

struct XcdBarrier {
    unsigned* bar; unsigned x;
    volatile LAS unsigned* st;
};

__device__ __forceinline__ XcdBarrier xcd_barrier_post(unsigned* bar, volatile LAS unsigned* st) {
    XcdBarrier b; b.bar = bar; b.x = xb_xcc_id(); b.st = st;
    if (threadIdx.x == 0) (void)xb_add(&bar[XB_XCNT(b.x)], 1u);
    return b;
}
__device__ __forceinline__ void xcd_barrier_complete(unsigned* bar, unsigned x, unsigned& nloc, unsigned& nx) {
    const unsigned G = gridDim.x * gridDim.y * gridDim.z;
    unsigned sum, cnt, mine, sp = 0u;
    for (;;) {
        sum = 0u; cnt = 0u; mine = 0u;
#pragma unroll
        for (unsigned j = 0; j < 16; ++j) { const unsigned c = xb_ld(&bar[XB_XCNT(j)]); sum += c; cnt += (c > 0u) ? 1u : 0u; mine = (j == x) ? c : mine; }
        if (sum == G) break;
        __builtin_amdgcn_s_sleep(1);
        if ((++sp & 255u) == 0u) { if (xb_ld(&bar[XB_TMO])) break; if (sp > XB_SPIN_CAP) { atomicAdd(&bar[XB_TMO], 1u); break; } }
    }
    nloc = mine > 0u ? mine : 1u; nx = cnt > 0u ? cnt : 1u;
}

__device__ __forceinline__ void xcd_barrier(const XcdBarrier& b) {
    asm volatile("s_waitcnt vmcnt(0)" ::: "memory");
    __syncthreads();
    if (threadIdx.x == 0) {
        unsigned* bar = b.bar;
        __builtin_amdgcn_s_waitcnt(0);
        unsigned nloc = b.st[0], nx = b.st[1];
        if (nloc == 0u) { xcd_barrier_complete(bar, b.x, nloc, nx); b.st[0] = nloc; b.st[1] = nx; }
        const unsigned old = xb_add(&bar[XB_XSUB(b.x)], 1u);
        const unsigned gen = old / nloc;
        if (old + 1u == (gen + 1u) * nloc) {
            __builtin_amdgcn_fence(__ATOMIC_RELEASE, "agent");
            asm volatile("s_waitcnt vmcnt(0)" ::: "memory");
            const unsigned og = xb_add(&bar[XB_TOP], 1u);
            const unsigned tg = og / nx;
            if (og + 1u == (tg + 1u) * nx) xb_add(&bar[XB_TOPGEN], 1u);
            else XB_SPIN(xb_ld(&bar[XB_TOPGEN]) == tg, bar);
            __builtin_amdgcn_fence(__ATOMIC_ACQUIRE, "agent");
            xb_add(&bar[XB_XGEN(b.x)], 1u);
            asm volatile("s_waitcnt vmcnt(0)" ::: "memory");
        } else {
            XB_SPIN(xb_ld(&bar[XB_XGEN(b.x)]) == gen, bar);
            __builtin_amdgcn_fence(__ATOMIC_ACQUIRE, "agent");
            asm volatile("s_waitcnt vmcnt(0)" ::: "memory");
        }
    }
    __syncthreads();
}

constexpr int LDS_ST_OFF = 8 * att::WAVE_LDS + 512;
constexpr int LDS_BYTES = LDS_ST_OFF + 64;
static_assert(LDS_BYTES <= 160 * 1024 && LDS_BYTES >= pg8::STAGE_BYTES, "LDS budget");
constexpr int N_PHASES = 14;
struct Params { const float* in[21]; float* out; unsigned char* ws; int ph_lo, ph_hi; };

#ifndef REPMASK
#define REPMASK 0
#endif
#ifndef EXTRA_SYNC
#define EXTRA_SYNC 0
#endif
__global__ void __launch_bounds__(512, 2) fwd_kernel(Params P) {
    extern __shared__ __attribute__((aligned(16))) unsigned char lds_raw[];
    LAS unsigned char* lds = (LAS unsigned char*)lds_raw;
    {   volatile LAS unsigned* bst0 = (volatile LAS unsigned*)(lds + LDS_ST_OFF);
        if (threadIdx.x < 16) bst0[threadIdx.x] = 0u;
        __syncthreads();
        (void)xcd_barrier_post((unsigned*)(P.ws + WS_BAR), bst0); }
#define GRID_SYNC() do { unsigned* bp_ = (unsigned*)(P.ws + WS_BAR); asm volatile("" : "+s"(bp_)); XcdBarrier b_; b_.bar = bp_; b_.x = xb_xcc_id(); b_.st = (volatile LAS unsigned*)(lds + LDS_ST_OFF); xcd_barrier(b_); } while (0)
#define LANE_OPAQUE int ln_ = pg8::lane_id(); asm volatile("" : "+v"(ln_)); const int tid_ = wave * 64 + ln_; (void)tid_
#define WSP(T, off) ((T*)(ws + (off)))
#define MODL (WSP(const float, WS_MOD) + (size_t)ly * 9 * MODW)
#define XL ((ly == 0) ? P.in[0] : (const float*)P.out)
#define CL ((ly == 0) ? P.in[2] : WSP(const float, WS_CTX))
#define MROWS ((ly == 0) ? MALL : MLAT)
    const int ph_hi = P.ph_hi;
    const int wave = __builtin_amdgcn_readfirstlane(threadIdx.x >> 6);
#pragma unroll 1
    for (int ph = P.ph_lo; ph < ph_hi; ++ph) {
        int phv = ph; asm volatile("" : "+s"(phv));
        int kind = 0, ly = 0;
        if (phv >= 1) { const int idx = phv - 1; if (idx < 7) { kind = idx + 1 + (idx >= 5 ? 1 : 0); } else { const int j = idx - 7; ly = 1; kind = j + 2 + (j >= 4 ? 1 : 0); } }
        const int G = gridDim.x, bx = blockIdx.x; const int vcu = (G % 8 == 0) ? (bx % 8) * (G / 8) + bx / 8 : bx; const int gw = vcu * 8 + wave, ngw = G * 8;
        unsigned char* ws = P.ws;
#pragma unroll 1
        for (int rep_ = 0; rep_ <= ((REPMASK >> kind) & 1); ++rep_) {
        if (rep_) GRID_SYNC();
        switch (kind) {
        case 0: { LANE_OPAQUE;
            if (bx == G - 1) { for (int i = tid_; i < 512; i += 512) { const int l2 = i >> 8, k = (i >> 6) & 3, d = i & 63; const float* src = P.in[k == 0 ? 9 : k == 1 ? 10 : k == 2 ? 14 : 15]; WSP(float, WS_GAIN)[i] = src[l2 * 64 + d]; } }
            if (bx < 192) mod_item(bx, P.in[1], P.in[3], P.in[4], P.in[5], WSP(float, WS_MOD), lds, tid_, wave, ln_);
            LAS float* scr = (LAS float*)(lds + wave * 16384);
            constexpr int I_IN = 16 * (INW / 32), I_O = 16 * (DM / 32), I_1 = 16 * (FFN / 32), I_2 = 64 * (DM / 32), I_L = I_IN + I_O + I_1 + I_2;
            for (int it = gw; it < 2 * I_L; it += ngw) {
                const int l2 = it / I_L; int r = it - l2 * I_L;
                if (r < I_IN) { transpose_item<true>(P.in[8] + (size_t)l2 * DM * INW, DM, INW, WSP(bf16_t, WS_WIN) + (size_t)l2 * INW * DM, scr, r, ln_); continue; } r -= I_IN;
                if (r < I_O) { transpose_item<false>(P.in[18] + (size_t)l2 * DM * DM, DM, DM, WSP(bf16_t, WS_WO) + (size_t)l2 * DM * DM, scr, r, ln_); continue; } r -= I_O;
                if (r < I_1) { transpose_item<false>(P.in[19] + (size_t)l2 * DM * FFN, DM, FFN, WSP(bf16_t, WS_W1) + (size_t)l2 * FFN * DM, scr, r, ln_); continue; } r -= I_1;
                transpose_item<false>(P.in[20] + (size_t)l2 * FFN * DM, FFN, DM, WSP(bf16_t, WS_W2) + (size_t)l2 * DM * FFN, scr, r, ln_);
            }
        } break;
        case 1: { LANE_OPAQUE;
            prep_pass(P.in[0], P.in[2], P.in[6], WSP(const float, WS_MOD), DM, WSP(bf16_t, WS_HN2), WSP(float, WS_RS1), gw, ngw, ln_);
            for (int it = bx; it < 200; it += G) { const int l2 = it / 100, c = it % 100; const float* m2 = WSP(const float, WS_MOD) + (size_t)l2 * 9 * MODW;
                if (c < 36) bias_item<true>(P.in[8] + (size_t)l2 * DM * INW, INW, c * 64, m2, WSP(float, WS_BIN) + (size_t)l2 * 9 * INW, lds, tid_, wave, ln_);
                else bias_item<false>(P.in[19] + (size_t)l2 * DM * FFN, FFN, (c - 36) * 64, m2 + 3 * DM, WSP(float, WS_B1) + (size_t)l2 * 9 * FFN, lds, tid_, wave, ln_); }
        } break;
        case 2: { LANE_OPAQUE;
            pg8::Gemm g{WSP(bf16_t, WS_HN2), WSP(bf16_t, WS_WIN) + (size_t)ly * INW * DM, MALL, INW, DM}; pg8::StaticOrder S; S.init(MALL, INW, G, bx);
            pg8::EpiProj E{WSP(bf16_t, WS_PROJ), WSP(const float, WS_GAIN) + ly * 256, WSP(const float, WS_RS1), WSP(const float, WS_BIN) + (size_t)ly * 9 * INW};
            pg8::gemm_phase<pg8::EpiProj, pg8::StaticOrder, true, true>(lds, g, S, E, wave);
        } break;
        case 3: { LANE_OPAQUE;
            att::attn_phase(lds + wave * att::WAVE_LDS + 256, WSP(bf16_t, WS_PROJ), WSP(bf16_t, WS_OB), P.in[11] + (size_t)ly * 4 * 15 * 31, P.in[16] + ly * 8, ly == 0, gw, ngw, ln_);
        } break;
        case 4: { LANE_OPAQUE;
            mix_pass(WSP(bf16_t, WS_PROJ), WSP(bf16_t, WS_OB), P.in[12] + (size_t)ly * 3 * 256, P.in[13] + ly * 256, P.in[17] + ly * DM, WSP(bf16_t, WS_HN), MROWS, gw, ngw, ln_);
        } break;
        case 5: { LANE_OPAQUE;
            pg8::Gemm g{WSP(bf16_t, WS_HN), WSP(bf16_t, WS_WO) + (size_t)ly * DM * DM, MROWS, DM, DM}; pg8::StaticOrder S; S.init(MROWS, DM, G, bx);
            pg8::EpiResid E{XL, CL, P.out, WSP(float, WS_CTX), MODL + 2 * DM, WSP(bf16_t, WS_HN2), P.in[7] + ly * DM, MODL + 4 * DM, WSP(float, WS_RS2)};
            pg8::gemm_phase<pg8::EpiResid, pg8::StaticOrder, true, true>(lds, g, S, E, wave);
        } break;
        case 7: { LANE_OPAQUE;
            pg8::Gemm g{WSP(bf16_t, WS_HN2), WSP(bf16_t, WS_W1) + (size_t)ly * FFN * DM, MROWS, FFN, DM}; pg8::StaticOrder S; S.init(MROWS, FFN, G, bx);
            pg8::EpiFc1 E{WSP(bf16_t, WS_H1), FFN, WSP(const float, WS_RS2), WSP(const float, WS_B1) + (size_t)ly * 9 * FFN};
            pg8::gemm_phase<pg8::EpiFc1, pg8::StaticOrder, true, true>(lds, g, S, E, wave);
        } break;
        default: { LANE_OPAQUE;
            pg8::Gemm g{WSP(bf16_t, WS_H1), WSP(bf16_t, WS_W2) + (size_t)ly * DM * FFN, MROWS, DM, FFN}; pg8::StaticOrder S; S.init(MROWS, DM, G, bx);
            pg8::EpiResid E{P.out, WSP(float, WS_CTX), P.out, WSP(float, WS_CTX), MODL + 5 * DM, (ly == 0) ? WSP(bf16_t, WS_HN2) : (bf16_t*)nullptr, P.in[6] + DM, WSP(const float, WS_MOD) + (size_t)9 * MODW + DM, WSP(float, WS_RS1)};
            pg8::gemm_phase<pg8::EpiResid, pg8::StaticOrder, true, true>(lds, g, S, E, wave);
        } break;
        }
        }
        for (int es_ = 0; es_ < EXTRA_SYNC; ++es_) GRID_SYNC();
        if (ph + 1 < ph_hi) GRID_SYNC();
    }
}

#ifndef MK_MULTI_LAUNCH
#define MK_MULTI_LAUNCH 0
#endif
extern "C" void kernel_launch(void* const* d_in, const int* in_sizes, int n_in, void* d_out, int out_size, void* d_ws, size_t ws_size, hipStream_t stream) {
    static int grid = 0;
    if (grid == 0) {
        if (n_in != 21 || out_size != MLAT * DM || ws_size < WS_END) { fprintf(stderr, "kernel_launch: unexpected shapes (n_in %d out %d ws %zu)\n", n_in, out_size, ws_size); grid = -1; return; }
        int dev = 0, cus = 0, per_cu = 0;
        if (hipGetDevice(&dev) != hipSuccess || hipDeviceGetAttribute(&cus, hipDeviceAttributeMultiprocessorCount, dev) != hipSuccess) { grid = -1; return; }
        if (hipFuncSetAttribute((const void*)fwd_kernel, hipFuncAttributeMaxDynamicSharedMemorySize, LDS_BYTES) != hipSuccess) { fprintf(stderr, "kernel_launch: hipFuncSetAttribute failed\n"); grid = -1; return; }
        if (hipOccupancyMaxActiveBlocksPerMultiprocessor(&per_cu, (const void*)fwd_kernel, 512, LDS_BYTES) != hipSuccess || per_cu < 1) { fprintf(stderr, "kernel_launch: occupancy query gave %d\n", per_cu); (void)hipGetLastError(); grid = -1; return; }
        grid = cus * per_cu;
    }
    if (grid < 0) return;
    Params p{};
    for (int i = 0; i < 21; ++i) p.in[i] = (const float*)d_in[i];
    p.out = (float*)d_out; p.ws = (unsigned char*)d_ws;
    if (hipMemsetAsync((char*)d_ws + WS_BAR, 0, XCD_BAR_WORDS * 4, stream) != hipSuccess) { fprintf(stderr, "kernel_launch: memset of the barrier words failed\n"); return; }
    void* args[] = {&p};
#if MK_MULTI_LAUNCH
    for (int ph = 0; ph < N_PHASES; ++ph) { p.ph_lo = ph; p.ph_hi = ph + 1;
        hipError_t e = hipLaunchCooperativeKernel((const void*)fwd_kernel, dim3(grid), dim3(512), args, LDS_BYTES, stream);
        if (e != hipSuccess) { fprintf(stderr, "launch %d failed: %s\n", ph, hipGetErrorString(e)); break; } }
#else
    p.ph_lo = 0; p.ph_hi = N_PHASES;
    hipError_t e = hipLaunchCooperativeKernel((const void*)fwd_kernel, dim3(grid), dim3(512), args, LDS_BYTES, stream);
    if (e != hipSuccess) fprintf(stderr, "cooperative launch failed: %s (grid %d)\n", hipGetErrorString(e), grid);
#endif
}
```

```cpp
#include <hip/hip_runtime.h>
#include <cstdio>
#include <cstdint>
namespace pg8 {
#define PG8_LAS __attribute__((address_space(3)))
typedef unsigned short bf16_t;
__device__ __forceinline__ int lane_id() { int r; asm volatile("v_mbcnt_lo_u32_b32 %0, -1, 0\n\tv_mbcnt_hi_u32_b32 %0, -1, %0" : "=v"(r)); return r; }
template <int K> __device__ __forceinline__ float shx(float v) { static_assert(K == 1 || K == 2 || K == 4 || K == 8 || K == 16, "xor mask"); return __builtin_bit_cast(float, __builtin_amdgcn_ds_swizzle(__builtin_bit_cast(int, v), 0x1f | (K << 10))); }
__device__ __forceinline__ void swap_halves(float& a, float& b) { asm("s_nop 1\n\tv_permlane32_swap_b32 %0, %1" : "+v"(a), "+v"(b)); }
__device__ __forceinline__ float sum_halves(float v) { float a = v, b = v; swap_halves(a, b); return a + b; }
__device__ __forceinline__ float max_halves(float v) { float a = v, b = v; swap_halves(a, b); return fmaxf(a, b); }
typedef short bf16x8 __attribute__((ext_vector_type(8)));
typedef float f32x4 __attribute__((ext_vector_type(4)));
typedef unsigned u32x4 __attribute__((ext_vector_type(4)));
constexpr int BM = 256, BK = 64, HALF = 128, HTB = HALF * BK * 2  , STAGE_BYTES = 8 * HTB, NXCD = 8, WGM = 8;

__host__ __device__ __forceinline__ int lds_byte(int r, int c) { const int st = (r >> 4) * 2 + (c >> 5), rr = r & 15, cc = c & 31, ob = rr * 64 + cc * 2; return st * 1024 + (ob ^ (((ob >> 9) & 1) << 5)); }
__host__ __device__ __forceinline__ void stage_rc(int b, int& R, int& C) { const int st = b / 1024, sb = b % 1024, swz = sb ^ (((sb >> 9) & 1) << 5); R = (st >> 1) * 16 + swz / 64; C = (st & 1) * 32 + (swz % 64) / 2; }
__host__ __device__ __forceinline__ int perm32(int rho) { const int n = rho >> 4, i = rho & 15; return 8 * (i >> 2) + 4 * n + (i & 3); }

struct Unit { int pm, pn, k0t, nt, ks; };
struct Gemm { const bf16_t* A; const bf16_t* Bt; int M, N, K; };

struct StaticOrder {
    int nM, nN, nwg, G, c;
    __host__ __device__ void init(int M, int N, int G_, int c_) { nM = M / BM; nN = N / BM; nwg = nM * nN; G = G_; c = c_; }
    __host__ __device__ __forceinline__ bool next(int i, Unit& u) const {
        const long L = (long)i * G + c; if (L >= nwg) { u.pm = 0; u.pn = 0; u.k0t = 0; u.nt = 0; u.ks = 0; return false; }
        int wgid = (int)L; { const int q = nwg / NXCD, r = nwg % NXCD, xcd = wgid % NXCD, off = wgid / NXCD; wgid = (xcd < r ? xcd * (q + 1) : r * (q + 1) + (xcd - r) * q) + off; }
        const int nig = WGM * nN, gid = wgid / nig, fm = gid * WGM, gsz = (nM - fm) < WGM ? (nM - fm) : WGM;
        u.pm = fm + ((wgid % nig) % gsz); u.pn = (wgid % nig) / gsz; u.k0t = 0; u.nt = 0; u.ks = 0; return true;
    }
    __device__ __forceinline__ void a_ready(const Unit&) const {}
    __device__ __forceinline__ void done(const Unit&) const {}
};
__device__ __forceinline__ unsigned cvt_pk_bf16(float lo, float hi) { unsigned r; asm volatile("v_cvt_pk_bf16_f32 %0, %1, %2" : "=v"(r) : "v"(lo), "v"(hi)); return r; }
typedef float f32x2 __attribute__((ext_vector_type(2)));
template <class Epi, class Sched, bool ALIGN_EPI = false, bool SP2 = false>
__device__ __forceinline__ void gemm_phase(PG8_LAS unsigned char* lds, const Gemm g, const Sched& S, const Epi& E, const int wid_in) {
    int tid_ = wid_in * 64 + lane_id(); asm volatile("" : "+v"(tid_));
    const int tid = tid_, wid = __builtin_amdgcn_readfirstlane(tid >> 6), lane = tid & 63, wr = wid >> 2, wc = wid & 3, fr = lane & 15, fq = lane >> 4;
    const int K = g.K, nt_all = K / BK;
    unsigned voffA[2], voffB[2];
#pragma unroll
    for (int i = 0; i < 2; ++i) { int R, C; stage_rc(tid * 16 + i * 8192, R, C); const int Rb = Epi::PERM ? ((R & ~31) + perm32(R & 31)) : R;
        voffA[i] = (unsigned)(R * K + C) * 2u; voffB[i] = (unsigned)(Rb * K + C) * 2u; }
    const size_t kstep = (size_t)(BK * 2);
    const size_t hstep = (size_t)HALF * K * 2;
    const size_t tstep = 2 * hstep;
    const unsigned ldsw = (unsigned)wid * 1024u;
    const int aoff = lds_byte(wr * 64 + fr, fq * 8), boff = lds_byte(wc * 32 + fr, fq * 8);
#define PG8_SA(b, h) (((b) * 2 + (h)) * HTB)
#define PG8_SB(b, h) ((4 + (b) * 2 + (h)) * HTB)
#define PG8_STAGE(bufoff, gbase, voff) do { _Pragma("unroll") for (int _i = 0; _i < 2; ++_i) \
        __builtin_amdgcn_global_load_lds((const unsigned*)((const char*)(gbase) + (voff)[_i]), (PG8_LAS unsigned*)(lds + (bufoff) + ldsw + _i * 8192), 16, 0, 0); } while (0)
#define PG8_LDA(dst, b, h) do { _Pragma("unroll") for (int m = 0; m < 4; ++m) _Pragma("unroll") for (int k = 0; k < 2; ++k) dst[m][k] = *(const PG8_LAS bf16x8*)(lds + PG8_SA(b, h) + aoff + m * 2048 + k * 1024); } while (0)
#define PG8_LDB(dst, b, h) do { _Pragma("unroll") for (int n = 0; n < 2; ++n) _Pragma("unroll") for (int k = 0; k < 2; ++k) dst[n][k] = *(const PG8_LAS bf16x8*)(lds + PG8_SB(b, h) + boff + n * 2048 + k * 1024); } while (0)
#define PG8_MMA(ai, bj, At, Bt) do { __builtin_amdgcn_s_setprio(1); _Pragma("unroll") for (int m = 0; m < 4; ++m) _Pragma("unroll") for (int n = 0; n < 2; ++n) _Pragma("unroll") for (int k = 0; k < 2; ++k) \
        acc[ai][bj][m][n] = __builtin_amdgcn_mfma_f32_16x16x32_bf16(Bt[n][k], At[m][k], acc[ai][bj][m][n], 0, 0, 0); __builtin_amdgcn_s_setprio(0); } while (0)
#define PG8_WAIT_V(n) asm volatile("s_waitcnt vmcnt(" #n ")" ::: "memory")
#define PG8_WAIT_L(n) asm volatile("s_waitcnt lgkmcnt(" #n ")" ::: "memory")
#define PG8_BAR __builtin_amdgcn_s_barrier()
#define PG8_SCHED __builtin_amdgcn_sched_barrier(0)
    Unit cur, nxt; int ui = 0;
    if (!S.next(0, cur)) return;
    f32x4 acc[2][2][4][2];
#pragma unroll
    for (int a = 0; a < 2; ++a)
#pragma unroll
        for (int b = 0; b < 2; ++b)
#pragma unroll
            for (int m = 0; m < 4; ++m)
#pragma unroll
                for (int n = 0; n < 2; ++n) acc[a][b][m][n] = (f32x4){0.f, 0.f, 0.f, 0.f};
    bf16x8 At[4][2], B0[2][2], B1[2][2];
    const char* cA = (const char*)g.A + (size_t)cur.pm * tstep + (size_t)cur.k0t * kstep; const char* cB = (const char*)g.Bt + (size_t)cur.pn * tstep + (size_t)cur.k0t * kstep;
    int nt = cur.nt ? cur.nt : nt_all;
    S.a_ready(cur);
    if constexpr (SP2) {
        PG8_STAGE(PG8_SB(0, 0), cB, voffB); PG8_STAGE(PG8_SB(0, 1), cB + hstep, voffB); PG8_STAGE(PG8_SA(0, 0), cA, voffA); PG8_STAGE(PG8_SA(0, 1), cA + hstep, voffA);
        if (wr == 1) PG8_BAR;
        PG8_WAIT_V(2); PG8_BAR;
        PG8_STAGE(PG8_SB(1, 0), cB + kstep, voffB); PG8_STAGE(PG8_SA(1, 0), cA + kstep, voffA); PG8_STAGE(PG8_SB(1, 1), cB + hstep + kstep, voffB);
        PG8_WAIT_V(6); PG8_BAR;
    } else {
        PG8_STAGE(PG8_SB(0, 0), cB, voffB); PG8_STAGE(PG8_SA(0, 0), cA, voffA); PG8_STAGE(PG8_SB(0, 1), cB + hstep, voffB); PG8_STAGE(PG8_SA(0, 1), cA + hstep, voffA);
        if (wr == 1) PG8_BAR;
        PG8_WAIT_V(4); PG8_BAR;
        PG8_STAGE(PG8_SB(1, 0), cB + kstep, voffB); PG8_STAGE(PG8_SA(1, 0), cA + kstep, voffA); PG8_STAGE(PG8_SB(1, 1), cB + hstep + kstep, voffB);
        PG8_WAIT_V(6); PG8_BAR;
    }
    for (;;) {
        const bool has_next = S.next(ui + 1, nxt);
        const char* nA = has_next ? (const char*)g.A + (size_t)nxt.pm * tstep + (size_t)nxt.k0t * kstep : cA; const char* nB = has_next ? (const char*)g.Bt + (size_t)nxt.pn * tstep + (size_t)nxt.k0t * kstep : cB;
        for (int t = 0; t < nt; t += 2) {
            const bool last = (t == nt - 2);
            const char* a1 = cA + (size_t)(t + 1) * kstep;
            const char* a2 = last ? nA : cA + (size_t)(t + 2) * kstep; const char* b2 = last ? nB : cB + (size_t)(t + 2) * kstep;
            const char* a3 = a2 + kstep; const char* b3 = b2 + kstep;
            if (last && has_next) S.a_ready(nxt);
            if constexpr (SP2) {
            PG8_LDB(B0, 0, 0); PG8_LDB(B1, 0, 1); PG8_SCHED; PG8_LDA(At, 0, 0); PG8_STAGE(PG8_SA(1, 1), a1 + hstep, voffA);
            PG8_WAIT_V(8); PG8_WAIT_L(0); PG8_BAR; PG8_MMA(0, 0, At, B0); PG8_MMA(0, 1, At, B1); PG8_BAR; PG8_SCHED;
            PG8_LDA(At, 0, 1); PG8_STAGE(PG8_SB(0, 0), b2, voffB); PG8_STAGE(PG8_SB(0, 1), b2 + hstep, voffB); PG8_STAGE(PG8_SA(0, 0), a2, voffA);
            PG8_WAIT_V(8); PG8_WAIT_L(0); PG8_BAR; PG8_MMA(1, 0, At, B0); PG8_MMA(1, 1, At, B1); PG8_BAR; PG8_SCHED;
            PG8_LDB(B0, 1, 0); PG8_LDB(B1, 1, 1); PG8_SCHED; PG8_LDA(At, 1, 0); PG8_STAGE(PG8_SA(0, 1), a2 + hstep, voffA);
            PG8_WAIT_V(8); PG8_WAIT_L(0); PG8_BAR; PG8_MMA(0, 0, At, B0); PG8_MMA(0, 1, At, B1); PG8_BAR; PG8_SCHED;
            PG8_LDA(At, 1, 1); PG8_STAGE(PG8_SB(1, 0), b3, voffB); PG8_STAGE(PG8_SB(1, 1), b3 + hstep, voffB); PG8_STAGE(PG8_SA(1, 0), a3, voffA);
            PG8_WAIT_V(8); PG8_WAIT_L(0); PG8_BAR; PG8_MMA(1, 0, At, B0); PG8_MMA(1, 1, At, B1); PG8_BAR; PG8_SCHED;
            } else {
            PG8_LDB(B0, 0, 0); PG8_SCHED; PG8_LDA(At, 0, 0); PG8_STAGE(PG8_SA(1, 1), a1 + hstep, voffA);
            PG8_WAIT_L(8); PG8_BAR; PG8_WAIT_L(0); PG8_MMA(0, 0, At, B0); PG8_BAR; PG8_SCHED;
            PG8_LDB(B1, 0, 1); PG8_STAGE(PG8_SB(0, 0), b2, voffB);
            PG8_BAR; PG8_WAIT_L(0); PG8_MMA(0, 1, At, B1); PG8_BAR;
            PG8_LDA(At, 0, 1); PG8_STAGE(PG8_SA(0, 0), a2, voffA);
            PG8_BAR; PG8_WAIT_L(0); PG8_MMA(1, 0, At, B0); PG8_BAR; PG8_SCHED;
            PG8_STAGE(PG8_SB(0, 1), b2 + hstep, voffB);
            PG8_WAIT_V(6); PG8_BAR; PG8_MMA(1, 1, At, B1); PG8_BAR;
            PG8_LDB(B0, 1, 0); PG8_SCHED; PG8_LDA(At, 1, 0); PG8_STAGE(PG8_SA(0, 1), a2 + hstep, voffA);
            PG8_WAIT_L(8); PG8_BAR; PG8_WAIT_L(0); PG8_MMA(0, 0, At, B0); PG8_BAR; PG8_SCHED;
            PG8_LDB(B1, 1, 1); PG8_STAGE(PG8_SB(1, 0), b3, voffB);
            PG8_BAR; PG8_WAIT_L(0); PG8_MMA(0, 1, At, B1); PG8_BAR;
            PG8_LDA(At, 1, 1); PG8_STAGE(PG8_SA(1, 0), a3, voffA);
            PG8_BAR; PG8_WAIT_L(0); PG8_MMA(1, 0, At, B0); PG8_BAR; PG8_SCHED;
            PG8_STAGE(PG8_SB(1, 1), b3 + hstep, voffB);
            PG8_WAIT_V(6); PG8_BAR; PG8_MMA(1, 1, At, B1); PG8_BAR;
            }
        }
        if constexpr (ALIGN_EPI) { if (wr == 0) PG8_BAR; }
        if constexpr (!Epi::AFTER_DRAIN) { E(acc, cur, wr, wc, fr, fq); S.done(cur); }
        if (!has_next) break;
#pragma unroll
        for (int a = 0; a < 2; ++a)
#pragma unroll
            for (int b = 0; b < 2; ++b)
#pragma unroll
                for (int m = 0; m < 4; ++m)
#pragma unroll
                    for (int n = 0; n < 2; ++n) acc[a][b][m][n] = (f32x4){0.f, 0.f, 0.f, 0.f};
        cur = nxt; cA = nA; cB = nB; ++ui; nt = cur.nt ? cur.nt : nt_all;
        if constexpr (ALIGN_EPI) { if (wr == 1) PG8_BAR; }
    }
    PG8_WAIT_V(0);
    if constexpr (!ALIGN_EPI) { if (wr == 0) PG8_BAR; }
    PG8_BAR;
    if constexpr (Epi::AFTER_DRAIN) { E.fused(acc, cur, wr, wc, fr, fq, lds, wid, lane); S.done(cur); }
#undef PG8_SA
#undef PG8_SB
#undef PG8_STAGE
#undef PG8_LDA
#undef PG8_LDB
#undef PG8_MMA
#undef PG8_WAIT_V
#undef PG8_WAIT_L
#undef PG8_BAR
#undef PG8_SCHED
}
}

namespace pg8 {
typedef unsigned u32x2 __attribute__((ext_vector_type(2)));
template <int ACT> struct EpiStore {
    static constexpr bool PERM = true, AFTER_DRAIN = false;
    bf16_t* O; int ldc;
    __device__ __forceinline__ void operator()(const f32x4 (&acc)[2][2][4][2], const Unit& u, int wr, int wc, int fr, int fq) const {
        const int row0 = u.pm * BM + wr * 64 + fr, col0 = u.pn * BM + wc * 32 + 8 * fq;
#pragma unroll
        for (int ai = 0; ai < 2; ++ai)
#pragma unroll
            for (int m = 0; m < 4; ++m) { bf16_t* rowp = O + (size_t)(row0 + ai * HALF + m * 16) * ldc + col0;
#pragma unroll
                for (int bj = 0; bj < 2; ++bj) { f32x4 v0 = acc[ai][bj][m][0], v1 = acc[ai][bj][m][1];
                    if (ACT == 2) {
#pragma unroll
                        for (int e = 0; e < 4; ++e) { const float a = fmaxf(v0[e], 0.f), b = fmaxf(v1[e], 0.f); v0[e] = a * a; v1[e] = b * b; } }
                    u32x4 w; w.x = cvt_pk_bf16(v0[0], v0[1]); w.y = cvt_pk_bf16(v0[2], v0[3]); w.z = cvt_pk_bf16(v1[0], v1[1]); w.w = cvt_pk_bf16(v1[2], v1[3]);
                    *(u32x4*)(rowp + bj * HALF) = w; } }
    }
};


__device__ __forceinline__ void rows_rstd(const float* rs, int row0, int fq, float (&rstd)[2][4]) {
    f32x4 p[2][4];
#pragma unroll
    for (int ai = 0; ai < 2; ++ai)
#pragma unroll
        for (int m = 0; m < 4; ++m) p[ai][m] = *(const f32x4*)(rs + (size_t)(row0 + ai * HALF + m * 16) * 16 + 4 * fq);
#pragma unroll
    for (int ai = 0; ai < 2; ++ai)
#pragma unroll
        for (int m = 0; m < 4; ++m) { float s = (p[ai][m][0] + p[ai][m][1]) + (p[ai][m][2] + p[ai][m][3]); s += shx<16>(s); s = sum_halves(s); rstd[ai][m] = 1.0f / sqrtf(s * (1.0f / 1024.0f) + 1e-6f); }
}
struct EpiFc1 {
    static constexpr bool PERM = true, AFTER_DRAIN = false;
    bf16_t* O; int ldc; const float* rs; const float* bias;
    __device__ __forceinline__ void operator()(const f32x4 (&acc)[2][2][4][2], const Unit& u, int wr, int wc, int fr_in, int fq_in) const {
        (void)fr_in; (void)fq_in; int ln_e = lane_id(); asm volatile("" : "+v"(ln_e)); const int fr = ln_e & 15, fq = ln_e >> 4;
        const int row0 = u.pm * BM + wr * 64 + fr, col0 = u.pn * BM + wc * 32 + 8 * fq; const int b = (u.pm < 64) ? (u.pm >> 3) : 8;
        f32x4 bv[2][2];
#pragma unroll
        for (int bj = 0; bj < 2; ++bj)
#pragma unroll
            for (int n = 0; n < 2; ++n) bv[bj][n] = *(const f32x4*)(bias + (size_t)b * ldc + col0 + bj * HALF + 4 * n);
        float rsd[2][4]; rows_rstd(rs, row0, fq, rsd);
#pragma unroll
        for (int ai = 0; ai < 2; ++ai)
#pragma unroll
            for (int m = 0; m < 4; ++m) { const int row = row0 + ai * HALF + m * 16; const float rstd = rsd[ai][m]; bf16_t* rowp = O + (size_t)row * ldc + col0;
#pragma unroll
                for (int bj = 0; bj < 2; ++bj) { f32x4 v0 = acc[ai][bj][m][0] * rstd + bv[bj][0], v1 = acc[ai][bj][m][1] * rstd + bv[bj][1];
#pragma unroll
                    for (int e = 0; e < 4; ++e) { const float a = fmaxf(v0[e], 0.f), c = fmaxf(v1[e], 0.f); v0[e] = a * a; v1[e] = c * c; }
                    u32x4 w; w.x = cvt_pk_bf16(v0[0], v0[1]); w.y = cvt_pk_bf16(v0[2], v0[3]); w.z = cvt_pk_bf16(v1[0], v1[1]); w.w = cvt_pk_bf16(v1[2], v1[3]);
                    *(u32x4*)(rowp + bj * HALF) = w; }
                asm volatile("" ::: "memory"); }
    }
};


__host__ __device__ __forceinline__ size_t slab_off(int i) { const size_t MiB_ = (size_t)1 << 20; return i < 36 ? 234 * MiB_ + (size_t)i * 262144 : i < 64 ? 249 * MiB_ + (size_t)(i - 36) * 262144 : 14 * MiB_ + (size_t)(i - 64) * 262144; }
struct SplitOrder {
    StaticOrder lat; int G, c;
    __host__ __device__ void init(int G_, int c_) { lat.init(64 * BM, 4 * BM, G_, c_); G = G_; c = c_; }
    __host__ __device__ __forceinline__ bool next(int i, Unit& u) const {
        const long L = (long)i * G + c;
        Unit t; const bool okl = lat.next(i, t);
        const int s = (int)(L - 256), unit = s >> 2; const bool isl = L < 256;
        u.pm = isl ? t.pm : 64 + (unit >> 2); u.pn = isl ? t.pn : (unit & 3); u.ks = isl ? 0 : (s & 3); u.k0t = isl ? 0 : (s & 3) * 16; u.nt = isl ? 0 : 16;
        return isl ? okl : (s < 128);
    }
    __device__ __forceinline__ void a_ready(const Unit&) const {}
    __device__ __forceinline__ void done(const Unit&) const {}
};

struct EpiResid {
    static constexpr bool PERM = true, AFTER_DRAIN = false;
    const float* base_lat; const float* base_ctx; float* out_lat; float* out_ctx; const float* gate;
    bf16_t* aout; const float* gn; const float* scn; float* rsout;
    float* slab; bool split_ctx;
    __device__ __forceinline__ void operator()(const f32x4 (&acc)[2][2][4][2], const Unit& u, int wr, int wc, int fr_in, int fq_in) const {
        (void)fr_in; (void)fq_in; int ln_e = lane_id(); asm volatile("" : "+v"(ln_e)); const int fr = ln_e & 15, fq = ln_e >> 4;
        const bool lat = u.pm < 64;
        const int b = lat ? (u.pm >> 3) : 8;
        const size_t roff = (size_t)(lat ? u.pm : u.pm - 64) * BM * 1024;
        const float* base = (lat ? base_lat : base_ctx) + roff; float* out = (lat ? out_lat : out_ctx) + roff;
        const int col0 = u.pn * BM + wc * 32 + 8 * fq;
        f32x4 gv[2][2];
#pragma unroll
        for (int bj = 0; bj < 2; ++bj)
#pragma unroll
            for (int n = 0; n < 2; ++n) gv[bj][n] = *(const f32x4*)(gate + (size_t)b * 6144 + col0 + bj * HALF + n * 4);
        if (u.ks != 0) {
            float* sp = (float*)((unsigned char*)slab + slab_off(((u.pm - 64) * 4 + u.pn) * 3 + (u.ks - 1))) + wc * 32 + 8 * fq;
#pragma unroll
            for (int ai = 0; ai < 2; ++ai)
#pragma unroll
                for (int m = 0; m < 4; ++m) { float* rp = sp + (size_t)(ai * HALF + wr * 64 + m * 16 + fr) * 256;
#pragma unroll
                    for (int bj = 0; bj < 2; ++bj) { *(f32x4*)(rp + bj * HALF) = acc[ai][bj][m][0]; *(f32x4*)(rp + bj * HALF + 4) = acc[ai][bj][m][1]; } }
            return;
        }
        if (aout == nullptr || (split_ctx && !lat)) {
#pragma unroll
            for (int ai = 0; ai < 2; ++ai)
#pragma unroll
                for (int m = 0; m < 4; ++m) { const size_t off = (size_t)(ai * HALF + wr * 64 + m * 16 + fr) * 1024 + col0;
#pragma unroll
                    for (int bj = 0; bj < 2; ++bj)
#pragma unroll
                        for (int n = 0; n < 2; ++n) { const f32x4 bs = *(const f32x4*)(base + off + bj * HALF + n * 4);
                            *(f32x4*)(out + off + bj * HALF + n * 4) = bs + gv[bj][n] * acc[ai][bj][m][n]; }
                    if (m & 1) asm volatile("" ::: "memory"); }
            return;
        }
        f32x4 Gv[2][2];
#pragma unroll
        for (int bj = 0; bj < 2; ++bj)
#pragma unroll
            for (int n = 0; n < 2; ++n) Gv[bj][n] = *(const f32x4*)(gn + col0 + bj * HALF + n * 4) * (*(const f32x4*)(scn + (size_t)b * 6144 + col0 + bj * HALF + n * 4) + 1.0f);
        const size_t grow0 = (size_t)u.pm * BM;
#pragma unroll
        for (int ai = 0; ai < 2; ++ai)
#pragma unroll
            for (int m = 0; m < 4; ++m) { const int rl = ai * HALF + wr * 64 + m * 16 + fr; const size_t off = (size_t)rl * 1024 + col0; float ss = 0.f;
                bf16_t* ap = aout + (grow0 + rl) * 1024 + col0;
#pragma unroll
                for (int bj = 0; bj < 2; ++bj) {
                    const f32x4 b0 = *(const f32x4*)(base + off + bj * HALF), b1 = *(const f32x4*)(base + off + bj * HALF + 4);
                    const f32x4 x0 = b0 + gv[bj][0] * acc[ai][bj][m][0], x1 = b1 + gv[bj][1] * acc[ai][bj][m][1];
                    *(f32x4*)(out + off + bj * HALF) = x0; *(f32x4*)(out + off + bj * HALF + 4) = x1;
                    ss += ((x0[0] * x0[0] + x0[1] * x0[1]) + (x0[2] * x0[2] + x0[3] * x0[3])) + ((x1[0] * x1[0] + x1[1] * x1[1]) + (x1[2] * x1[2] + x1[3] * x1[3]));
                    const f32x4 y0 = x0 * Gv[bj][0], y1 = x1 * Gv[bj][1];
                    u32x4 w; w.x = cvt_pk_bf16(y0[0], y0[1]); w.y = cvt_pk_bf16(y0[2], y0[3]); w.z = cvt_pk_bf16(y1[0], y1[1]); w.w = cvt_pk_bf16(y1[2], y1[3]);
                    *(u32x4*)(ap + bj * HALF) = w; }
                ss += shx<16>(ss); ss = sum_halves(ss);
                if (fq == 0) rsout[(grow0 + rl) * 16 + u.pn * 4 + wc] = ss;
                if (m & 1) asm volatile("" ::: "memory"); }
    }
};

struct EpiProj {
    static constexpr bool PERM = true, AFTER_DRAIN = false;
    bf16_t* O; const float* gains;
    const float* rs; const float* bias;
    __device__ __forceinline__ void operator()(const f32x4 (&acc)[2][2][4][2], const Unit& u, int wr, int wc, int fr_in, int fq_in) const {
        (void)fr_in; (void)fq_in; int ln_e = lane_id(); asm volatile("" : "+v"(ln_e)); const int fr = ln_e & 15, fq = ln_e >> 4;
        const int pn = u.pn; const int row0 = u.pm * BM + wr * 64 + fr; const int b = (u.pm < 64) ? (u.pm >> 3) : 8;
        f32x4 bv[2][2];
#pragma unroll
        for (int bj = 0; bj < 2; ++bj)
#pragma unroll
            for (int n = 0; n < 2; ++n) bv[bj][n] = *(const f32x4*)(bias + (size_t)b * 2304 + pn * BM + bj * HALF + wc * 32 + 8 * fq + 4 * n);
        float rsd[2][4]; rows_rstd(rs, row0, fq, rsd);
        if (pn >= 2 && pn <= 5) {
            const int col0 = pn * BM + wc * 32 + 8 * fq;
#pragma unroll
            for (int ai = 0; ai < 2; ++ai)
#pragma unroll
                for (int m = 0; m < 4; ++m) { bf16_t* rowp = O + (size_t)(row0 + ai * HALF + m * 16) * 2304 + col0; const float rstd = rsd[ai][m];
#pragma unroll
                    for (int bj = 0; bj < 2; ++bj) { const f32x4 v0 = acc[ai][bj][m][0] * rstd + bv[bj][0], v1 = acc[ai][bj][m][1] * rstd + bv[bj][1];
                        u32x4 w; w.x = cvt_pk_bf16(v0[0], v0[1]); w.y = cvt_pk_bf16(v0[2], v0[3]); w.z = cvt_pk_bf16(v1[0], v1[1]); w.w = cvt_pk_bf16(v1[2], v1[3]);
                        *(u32x4*)(rowp + bj * HALF) = w; } }
            return;
        }
        const int colh = pn * BM + wc * 64 + 8 * fq;
        const bool vhead = (pn == 8) && (wc >= 2);
        if (vhead) {
#pragma unroll
            for (int ai = 0; ai < 2; ++ai)
#pragma unroll
                for (int m = 0; m < 4; ++m) { bf16_t* rowp = O + (size_t)(row0 + ai * HALF + m * 16) * 2304 + colh; const float rstd = rsd[ai][m];
#pragma unroll
                    for (int bj = 0; bj < 2; ++bj) { const f32x4 v0 = acc[ai][bj][m][0] * rstd + bv[bj][0], v1 = acc[ai][bj][m][1] * rstd + bv[bj][1];
                        u32x4 w; w.x = cvt_pk_bf16(v0[0], v0[1]); w.y = cvt_pk_bf16(v0[2], v0[3]); w.z = cvt_pk_bf16(v1[0], v1[1]); w.w = cvt_pk_bf16(v1[2], v1[3]);
                        *(u32x4*)(rowp + bj * 32) = w; } }
            return;
        }
        const float* gp = gains + 64 * ((pn == 0) ? 0 : (pn == 1) ? 1 : (pn == 8) ? 3 : 2);
        const float qs = (pn == 1 || pn == 8) ? 1.0f : 0.18033688011112042f;
        const bool rope = (pn >= 6) && (u.pm < 64);
        f32x4 gv[2][2];
#pragma unroll
        for (int bj = 0; bj < 2; ++bj)
#pragma unroll
            for (int n = 0; n < 2; ++n) gv[bj][n] = *(const f32x4*)(gp + 32 * bj + 16 * n + 4 * fq);
        float invrev[4];
#pragma unroll
        for (int e = 0; e < 4; ++e) invrev[e] = __builtin_amdgcn_exp2f(-(float)(4 * fq + e) * (13.287712379549449f / 16.0f)) * 0.15915494309189535f;
#pragma unroll
        for (int ai = 0; ai < 2; ++ai)
#pragma unroll
            for (int m = 0; m < 4; ++m) {
                const int row = row0 + ai * HALF + m * 16; const float rstd0 = rsd[ai][m];
                f32x4 v[2][2]; float ss = 0.f;
#pragma unroll
                for (int bj = 0; bj < 2; ++bj)
#pragma unroll
                    for (int n = 0; n < 2; ++n) v[bj][n] = acc[ai][bj][m][n] * rstd0 + bv[bj][n];
                asm volatile("" : "+v"(v[0][0]), "+v"(v[0][1]), "+v"(v[1][0]), "+v"(v[1][1]));
#pragma unroll
                for (int bj = 0; bj < 2; ++bj)
#pragma unroll
                    for (int n = 0; n < 2; ++n) { const f32x4 x = v[bj][n]; ss += (x[0] * x[0] + x[1] * x[1]) + (x[2] * x[2] + x[3] * x[3]); }
                ss += shx<16>(ss); ss = sum_halves(ss);
                const float rstd = 1.0f / sqrtf(ss * (1.0f / 64.0f) + 1e-6f);
#pragma unroll
                for (int bj = 0; bj < 2; ++bj)
#pragma unroll
                    for (int n = 0; n < 2; ++n) v[bj][n] = v[bj][n] * rstd * gv[bj][n];
                if (rope) {
                    const int t = row & 2047;
#pragma unroll
                    for (int bj = 0; bj < 2; ++bj) { const float pos = (float)(bj == 0 ? (t >> 6) : (t & 63));
#pragma unroll
                        for (int e = 0; e < 4; ++e) { float rev = pos * invrev[e]; rev = rev - floorf(rev);
                            const float cs = __builtin_amdgcn_cosf(rev), sn = __builtin_amdgcn_sinf(rev);
                            const float u1 = v[bj][0][e], u2 = v[bj][1][e];
                            v[bj][0][e] = u1 * cs - u2 * sn; v[bj][1][e] = u2 * cs + u1 * sn; } }
                }
                bf16_t* rowp = O + (size_t)row * 2304 + colh;
#pragma unroll
                for (int bj = 0; bj < 2; ++bj) { const f32x4 v0 = v[bj][0] * qs, v1 = v[bj][1] * qs;
                    u32x4 w; w.x = cvt_pk_bf16(v0[0], v0[1]); w.y = cvt_pk_bf16(v0[2], v0[3]); w.z = cvt_pk_bf16(v1[0], v1[1]); w.w = cvt_pk_bf16(v1[2], v1[3]);
                    *(u32x4*)(rowp + bj * 32) = w; }
                asm volatile("" ::: "memory");
            }
    }
};
}

#define LAS __attribute__((address_space(3)))
typedef unsigned short bf16_t;
typedef short bf16x8 __attribute__((ext_vector_type(8)));
typedef short s16x4 __attribute__((ext_vector_type(4)));
typedef float f32x16 __attribute__((ext_vector_type(16)));
typedef float f32x4 __attribute__((ext_vector_type(4)));
typedef unsigned u32x4 __attribute__((ext_vector_type(4)));
typedef unsigned u32x2 __attribute__((ext_vector_type(2)));

constexpr int DM = 1024, NB = 8, SEQ = 2048, CTXL = 256, FFN = 4096, INW = 2304;
constexpr int MLAT = NB * SEQ, MCTX = NB * CTXL, MALL = MLAT + MCTX;
constexpr float EPSN = 1e-6f, LOG2E = 1.4426950408889634f, NEGBIG = -1e30f;
constexpr int MODW = 6 * DM;
constexpr size_t MiB = (size_t)1 << 20;
constexpr size_t WS_MOD = 0;
constexpr size_t WS_GAIN = 512 * 1024;
constexpr size_t WS_BAR = 768 * 1024;
constexpr size_t WS_WIN = 1 * MiB;
constexpr size_t WS_WO = 10 * MiB;
constexpr size_t WS_W1 = 14 * MiB;
constexpr size_t WS_W2 = 30 * MiB;
constexpr size_t WS_CTX = 46 * MiB;
constexpr size_t WS_HN2 = 54 * MiB;
constexpr size_t WS_HN = 207 * MiB;
constexpr size_t WS_H1 = 90 * MiB;
constexpr size_t WS_PROJ = 90 * MiB;
constexpr size_t WS_OB = 171 * MiB;
constexpr size_t WS_RS1 = 243 * MiB;
constexpr size_t WS_RS2 = 245 * MiB;
constexpr size_t WS_BIN = 247 * MiB;
constexpr size_t WS_B1 = 248 * MiB;
constexpr size_t WS_END = 256 * MiB;
static_assert(WS_W1 == 14 * MiB, "pg8::slab_off places 32 slabs in the first layer's fc1 weight copy");

__device__ __forceinline__ float half_sum(float v) { v += pg8::shx<1>(v); v += pg8::shx<2>(v); v += pg8::shx<4>(v); v += pg8::shx<8>(v); v += pg8::shx<16>(v); return v; }
__device__ __forceinline__ float wave_sum(float v) { return pg8::sum_halves(half_sum(v)); }
__device__ __forceinline__ unsigned f2bf(float f) { unsigned u = __builtin_bit_cast(unsigned, f); return (u + 0x7fffu + ((u >> 16) & 1u)) >> 16; }
__device__ __forceinline__ unsigned pk2(float lo, float hi) { return f2bf(lo) | (f2bf(hi) << 16); }
__device__ __forceinline__ float bf_lo(unsigned u) { return __builtin_bit_cast(float, u << 16); }
__device__ __forceinline__ float bf_hi(unsigned u) { return __builtin_bit_cast(float, u & 0xffff0000u); }

namespace att {
constexpr int KROWB = 144, VROWB = 128, WL_V = 64 * KROWB, WL_A = WL_V + 64 * VROWB, WL_TAB = WL_A + 128 + 192, WAVE_LDS = WL_TAB + 15 * 32 * 4;
typedef float f32x2_t __attribute__((ext_vector_type(2))); typedef __bf16 bf16x2_t __attribute__((ext_vector_type(2)));
typedef short v4i16_t __attribute__((ext_vector_type(4)));
__device__ __forceinline__ unsigned cvtpk(float lo, float hi) { f32x2_t v = {lo, hi}; bf16x2_t b = __builtin_convertvector(v, bf16x2_t); return __builtin_bit_cast(unsigned, b); }
__device__ __forceinline__ s16x4 vtr(LAS const unsigned char* p) { return __builtin_bit_cast(s16x4, __builtin_amdgcn_ds_read_tr16_b64_v4i16((LAS v4i16_t*)p)); }
struct AU { int qrow0, qcol, kcol, vcol, ocol, ctxrow0, nloc, locrow0, a0, a1; float m0, l0; const float* rpb; };
template <int KIND> __device__ __forceinline__ void attn_unit(LAS unsigned char* wl, const bf16_t* __restrict__ proj, bf16_t* __restrict__ obuf, const AU u, const int lane) {
    const int r32 = lane & 31, hi = lane >> 5;
    LAS float* sc = (LAS float*)(wl + WL_A);
    LAS float* tab = (LAS float*)(wl + WL_TAB);
    bf16x8 qr[4];
    { const bf16_t* qp = proj + (size_t)(u.qrow0 + r32) * INW + u.qcol + hi * 8;
#pragma unroll
      for (int d0 = 0; d0 < 4; ++d0) qr[d0] = *(const bf16x8*)(qp + d0 * 16); }
    if (KIND == 0) { for (int i = lane; i < 15 * 31; i += 64) { const int a = i / 31, b = i - a * 31; tab[a * 32 + b] = u.rpb[i] * LOG2E; } }
    f32x16 o0, o1;
#pragma unroll
    for (int r = 0; r < 16; ++r) { o0[r] = 0.f; o1[r] = 0.f; }
    float m = u.m0, l = (hi == 0) ? u.l0 : 0.f;
    const int nt = 4 + u.nloc;
    const int lrow = lane >> 3, lch = lane & 7;
    u32x4 kreg[8], vreg[8];
#define ATT_LOAD_TILE(t) do { const int row0_ = ((t) < 4) ? u.ctxrow0 + 64 * (t) : u.locrow0 + 64 * ((t) - 4); const bf16_t* bp_ = proj + (size_t)(row0_ + lrow) * INW + lch * 8; \
        _Pragma("unroll") for (int i_ = 0; i_ < 8; ++i_) { kreg[i_] = *(const u32x4*)(bp_ + (size_t)i_ * 8 * INW + u.kcol); vreg[i_] = *(const u32x4*)(bp_ + (size_t)i_ * 8 * INW + u.vcol); } } while (0)
    ATT_LOAD_TILE(0);
    LAS unsigned char* kw = wl + lrow * KROWB + lch * 16;
    LAS unsigned char* vw = wl + WL_V + lrow * VROWB + lch * 16;
    LAS const unsigned char* kf = wl + r32 * KROWB + hi * 16;
    LAS const unsigned char* vf = wl + WL_V + (4 * hi + ((lane & 15) >> 2)) * VROWB + ((lane >> 4) & 1) * 32 + (lane & 3) * 8;
    for (int t = 0; t < nt; ++t) {
#pragma unroll
        for (int i = 0; i < 8; ++i) { *(LAS u32x4*)(kw + i * 8 * KROWB) = kreg[i]; *(LAS u32x4*)(vw + i * 8 * VROWB) = vreg[i]; }
        if (t + 1 < nt) ATT_LOAD_TILE(t + 1);
        f32x16 p0, p1;
#pragma unroll
        for (int r = 0; r < 16; ++r) { p0[r] = 0.f; p1[r] = 0.f; }
#pragma unroll
        for (int d0 = 0; d0 < 4; ++d0) {
            const bf16x8 a0 = *(LAS const bf16x8*)(kf + d0 * 32), a1 = *(LAS const bf16x8*)(kf + 32 * KROWB + d0 * 32);
            p0 = __builtin_amdgcn_mfma_f32_32x32x16_bf16(a0, qr[d0], p0, 0, 0, 0);
            p1 = __builtin_amdgcn_mfma_f32_32x32x16_bf16(a1, qr[d0], p1, 0, 0, 0);
        }
        if (KIND == 0) { if (t >= 4) {
            const int dr = u.a0 + (t - 4), qc = u.a1 + r32; const int cs = min(max(qc - 8, 0), 48);
            const int kb = 4 * hi - cs; LAS const float* tb = tab + dr * 32 + 15 - qc + 4 * hi;
#pragma unroll
            for (int r = 0; r < 16; ++r) { const int kc = (r & 3) + 8 * (r >> 2);
                p0[r] = ((unsigned)(kb + kc) < 16u) ? p0[r] + tb[kc] : NEGBIG;
                p1[r] = ((unsigned)(kb + kc + 32) < 16u) ? p1[r] + tb[kc + 32] : NEGBIG; } } }
        if (KIND == 1) { if (t >= 4) {
            const int d0_ = u.a0 + 64 * (t - 4) + 4 * hi - r32 + 128;
#pragma unroll
            for (int r = 0; r < 16; ++r) { const int kc = (r & 3) + 8 * (r >> 2);
                p0[r] = ((unsigned)(d0_ + kc) <= 256u) ? p0[r] : NEGBIG;
                p1[r] = ((unsigned)(d0_ + kc + 32) <= 256u) ? p1[r] : NEGBIG; } } }
        float mx = fmaxf(p0[0], p1[0]);
#pragma unroll
        for (int r = 1; r < 16; ++r) mx = fmaxf(mx, fmaxf(p0[r], p1[r]));
        mx = pg8::max_halves(mx);
        const float mnew = fmaxf(m, mx); const float alpha = __builtin_amdgcn_exp2f(m - mnew); m = mnew;
        float rs = 0.f;
#pragma unroll
        for (int r = 0; r < 16; ++r) { p0[r] = __builtin_amdgcn_exp2f(p0[r] - mnew); p1[r] = __builtin_amdgcn_exp2f(p1[r] - mnew); rs += p0[r] + p1[r]; }
        l = l * alpha + rs;
        if (hi == 0) sc[r32] = alpha;
#pragma unroll
        for (int g = 0; g < 4; ++g) { const f32x4 a = *(LAS const f32x4*)(sc + 8 * g + 4 * hi);
#pragma unroll
            for (int i = 0; i < 4; ++i) { o0[4 * g + i] *= a[i]; o1[4 * g + i] *= a[i]; } }
        u32x4 pa[4];
#pragma unroll
        for (int j = 0; j < 4; ++j) { pa[0][j] = cvtpk(p0[2 * j], p0[2 * j + 1]); pa[1][j] = cvtpk(p0[8 + 2 * j], p0[8 + 2 * j + 1]); pa[2][j] = cvtpk(p1[2 * j], p1[2 * j + 1]); pa[3][j] = cvtpk(p1[8 + 2 * j], p1[8 + 2 * j + 1]); }
#pragma unroll
        for (int ks = 0; ks < 4; ++ks) {
            const s16x4 l0 = vtr(vf + ks * 16 * VROWB), h0 = vtr(vf + ks * 16 * VROWB + 8 * VROWB);
            const s16x4 l1 = vtr(vf + ks * 16 * VROWB + 64), h1 = vtr(vf + ks * 16 * VROWB + 8 * VROWB + 64);
            const bf16x8 b0 = (bf16x8){l0[0], l0[1], l0[2], l0[3], h0[0], h0[1], h0[2], h0[3]}, b1 = (bf16x8){l1[0], l1[1], l1[2], l1[3], h1[0], h1[1], h1[2], h1[3]};
            o0 = __builtin_amdgcn_mfma_f32_32x32x16_bf16(__builtin_bit_cast(bf16x8, pa[ks]), b0, o0, 0, 0, 0);
            o1 = __builtin_amdgcn_mfma_f32_32x32x16_bf16(__builtin_bit_cast(bf16x8, pa[ks]), b1, o1, 0, 0, 0);
        }
    }
#undef ATT_LOAD_TILE
    const float lt = pg8::sum_halves(l);
    if (hi == 0) sc[r32] = 1.0f / lt;
    bf16_t* ob = obuf + (size_t)u.qrow0 * DM + u.ocol + r32;
#pragma unroll
    for (int g = 0; g < 4; ++g) { const f32x4 a = *(LAS const f32x4*)(sc + 8 * g + 4 * hi);
#pragma unroll
        for (int i = 0; i < 4; ++i) { const int q = i + 8 * g + 4 * hi; bf16_t* op = ob + (size_t)q * DM;
            op[0] = (bf16_t)f2bf(o0[4 * g + i] * a[i]); op[32] = (bf16_t)f2bf(o1[4 * g + i] * a[i]); } }
}

__device__ __forceinline__ void attn_phase(LAS unsigned char* wl, const bf16_t* proj, bf16_t* obuf, const float* rpb_l, const float* sink_l, bool with_ctx, int gw, int ngw, int lane) {
    const int total = 2048 + 4096 + (with_ctx ? 768 : 0);
    for (int i0 = gw; i0 < total; i0 += ngw) {
        int i = i0; AU u;
        if (i < 2048) {
            const int half = i & 1, h = (i >> 1) & 3, r = (i >> 3) & 31, b = i >> 8; const int rs = min(max(r - 4, 0), 24);
            u.qrow0 = b * SEQ + r * 64 + 32 * half; u.qcol = 64 * h; u.kcol = 256 + 64 * h; u.vcol = 512 + 64 * h; u.ocol = 64 * h; u.ctxrow0 = MLAT + b * CTXL;
            u.nloc = 8; u.locrow0 = b * SEQ + rs * 64; u.a0 = rs - r + 7; u.a1 = 32 * half; u.m0 = NEGBIG; u.l0 = 0.f; u.rpb = rpb_l + h * (15 * 31);
            attn_unit<0>(wl, proj, obuf, u, lane);
            continue;
        }
        i -= 2048;
        if (i < 4096) {
            const int ch = i & 63, h = (i >> 6) & 7, b = i >> 9; const int qpos0 = 32 * ch;
            const int kt0 = max(0, (qpos0 - 128) >> 6), kt1 = min(31, (qpos0 + 159) >> 6);
            u.qrow0 = b * SEQ + qpos0; u.qcol = 1536 + 64 * h; u.kcol = 2048 + 64 * (h >> 2); u.vcol = 2176 + 64 * (h >> 2); u.ocol = 512 + 64 * h; u.ctxrow0 = MLAT + b * CTXL;
            u.nloc = kt1 - kt0 + 1; u.locrow0 = b * SEQ + 64 * kt0; u.a0 = 64 * kt0 - qpos0; u.a1 = 0; u.m0 = sink_l[h] * LOG2E; u.l0 = 1.f; u.rpb = nullptr;
            attn_unit<1>(wl, proj, obuf, u, lane);
            continue;
        }
        i -= 4096;
        if (i < 256) {
            const int ch = i & 7, h = (i >> 3) & 3, b = i >> 5;
            u.qrow0 = MLAT + b * CTXL + 32 * ch; u.qcol = 64 * h; u.kcol = 256 + 64 * h; u.vcol = 512 + 64 * h; u.ocol = 64 * h; u.m0 = NEGBIG; u.l0 = 0.f; u.ctxrow0 = MLAT + b * CTXL;
        } else {
            i -= 256; const int ch = i & 7, h = (i >> 3) & 7, b = i >> 6;
            u.qrow0 = MLAT + b * CTXL + 32 * ch; u.qcol = 1536 + 64 * h; u.kcol = 2048 + 64 * (h >> 2); u.vcol = 2176 + 64 * (h >> 2); u.ocol = 512 + 64 * h; u.m0 = sink_l[h] * LOG2E; u.l0 = 1.f; u.ctxrow0 = MLAT + b * CTXL;
        }
        u.nloc = 0; u.locrow0 = 0; u.a0 = 0; u.a1 = 0; u.rpb = nullptr;
        attn_unit<2>(wl, proj, obuf, u, lane);
    }
}
}

__device__ __forceinline__ void prep_pass(const float* xlat, const float* xctx, const float* g, const float* modl, int scoff, bf16_t* hn, float* rs, int gw, int ngw, int lane) {
    for (int m = gw; m < MALL; m += ngw) {
        const bool lat = m < MLAT; const float* xr = lat ? xlat + (size_t)m * DM : xctx + (size_t)(m - MLAT) * DM; const int b = lat ? (m >> 11) : 8;
        f32x4 v[4]; float ss = 0.f;
#pragma unroll
        for (int j = 0; j < 4; ++j) { v[j] = *(const f32x4*)(xr + 4 * lane + 256 * j); ss += (v[j][0] * v[j][0] + v[j][1] * v[j][1]) + (v[j][2] * v[j][2] + v[j][3] * v[j][3]); }
        ss = wave_sum(ss);
        if (lane < 16) rs[(size_t)m * 16 + lane] = (lane == 0) ? ss : 0.f;
        const float* mb = modl + (size_t)b * MODW;
#pragma unroll
        for (int j = 0; j < 4; ++j) { const int c = 4 * lane + 256 * j;
            const f32x4 gg = *(const f32x4*)(g + c), scv = *(const f32x4*)(mb + scoff + c);
            const f32x4 y = v[j] * gg * (scv + 1.0f);
            u32x2 w; w.x = pk2(y[0], y[1]); w.y = pk2(y[2], y[3]);
            *(u32x2*)(hn + (size_t)m * DM + c) = w; }
    }
}
__device__ __forceinline__ void ctx_rows_pass(const unsigned char* ws, const float* ctxbuf, const float* gate, const float* gn, const float* scn, bf16_t* hn2, float* rs, int gw, int ngw, int lane) {
    for (int r = gw; r < MCTX; r += ngw) {
        const int pmc = r >> 8, rl = r & 255; f32x4 x[4]; float ss = 0.f;
#pragma unroll
        for (int j = 0; j < 4; ++j) { const int c = 4 * lane + 256 * j; f32x4 p = {0.f, 0.f, 0.f, 0.f};
#pragma unroll
            for (int ks = 0; ks < 3; ++ks) p += *(const f32x4*)((const float*)(ws + pg8::slab_off((pmc * 4 + j) * 3 + ks)) + (size_t)rl * 256 + 4 * lane);
            x[j] = *(const f32x4*)(ctxbuf + (size_t)r * DM + c) + *(const f32x4*)(gate + c) * p;
            ss += (x[j][0] * x[j][0] + x[j][1] * x[j][1]) + (x[j][2] * x[j][2] + x[j][3] * x[j][3]); }
        ss = wave_sum(ss);
        const int m = MLAT + r;
        if (lane < 16) rs[(size_t)m * 16 + lane] = (lane == 0) ? ss : 0.f;
#pragma unroll
        for (int j = 0; j < 4; ++j) { const int c = 4 * lane + 256 * j;
            const f32x4 y = x[j] * (*(const f32x4*)(gn + c)) * (*(const f32x4*)(scn + c) + 1.0f);
            u32x2 w; w.x = pk2(y[0], y[1]); w.y = pk2(y[2], y[3]);
            *(u32x2*)(hn2 + (size_t)m * DM + c) = w; }
    }
}

__device__ __forceinline__ void mix_pass(const bf16_t* proj, const bf16_t* obuf, const float* convw, const float* convb, const float* gout, bf16_t* abuf, int nrows, int gw, int ngw, int lane) {
    for (int m = gw; m < nrows; m += ngw) {
        float va[8];
        if (lane < 32) {
            const u32x4 raw = *(const u32x4*)(obuf + (size_t)m * DM + 8 * lane);
#pragma unroll
            for (int j = 0; j < 4; ++j) { va[2 * j] = bf_lo(raw[j]); va[2 * j + 1] = bf_hi(raw[j]); }
        } else {
            const int c = 8 * (lane - 32); const bool lat = m < MLAT; const int t = lat ? (m & (SEQ - 1)) : ((m - MLAT) & (CTXL - 1)); const int L = lat ? SEQ : CTXL;
            const bf16_t* pr = proj + (size_t)m * INW;
            const u32x4 cx = *(const u32x4*)(pr + 768 + c), cb = *(const u32x4*)(pr + 1024 + c), cc = *(const u32x4*)(pr + 1280 + c);
            u32x4 pxm = {0u, 0u, 0u, 0u}, pcm = {0u, 0u, 0u, 0u}, pxp = {0u, 0u, 0u, 0u}, pcp = {0u, 0u, 0u, 0u};
            if (t > 0) { pxm = *(const u32x4*)(pr - INW + 768 + c); pcm = *(const u32x4*)(pr - INW + 1280 + c); }
            if (t < L - 1) { pxp = *(const u32x4*)(pr + INW + 768 + c); pcp = *(const u32x4*)(pr + INW + 1280 + c); }
            const f32x4 w0a = *(const f32x4*)(convw + c), w0b = *(const f32x4*)(convw + c + 4), w1a = *(const f32x4*)(convw + 256 + c), w1b = *(const f32x4*)(convw + 256 + c + 4),
                        w2a = *(const f32x4*)(convw + 512 + c), w2b = *(const f32x4*)(convw + 512 + c + 4), bba = *(const f32x4*)(convb + c), bbb = *(const f32x4*)(convb + c + 4);
#pragma unroll
            for (int j = 0; j < 4; ++j) {
                const float w0l = j < 2 ? w0a[2 * j] : w0b[2 * j - 4], w0h = j < 2 ? w0a[2 * j + 1] : w0b[2 * j - 3];
                const float w1l = j < 2 ? w1a[2 * j] : w1b[2 * j - 4], w1h = j < 2 ? w1a[2 * j + 1] : w1b[2 * j - 3];
                const float w2l = j < 2 ? w2a[2 * j] : w2b[2 * j - 4], w2h = j < 2 ? w2a[2 * j + 1] : w2b[2 * j - 3];
                const float bl = j < 2 ? bba[2 * j] : bbb[2 * j - 4], bh = j < 2 ? bba[2 * j + 1] : bbb[2 * j - 3];
                const float ul = bf_lo(cc[j]) * bf_lo(cx[j]), uh = bf_hi(cc[j]) * bf_hi(cx[j]);
                const float uml = bf_lo(pcm[j]) * bf_lo(pxm[j]), umh = bf_hi(pcm[j]) * bf_hi(pxm[j]);
                const float upl = bf_lo(pcp[j]) * bf_lo(pxp[j]), uph = bf_hi(pcp[j]) * bf_hi(pxp[j]);
                va[2 * j] = bf_lo(cb[j]) * (bl + w0l * uml + w1l * ul + w2l * upl);
                va[2 * j + 1] = bf_hi(cb[j]) * (bh + w0h * umh + w1h * uh + w2h * uph);
            }
        }
        float ssa = 0.f;
#pragma unroll
        for (int j = 0; j < 8; ++j) ssa += va[j] * va[j];
        ssa = half_sum(ssa); const float rsa = 1.0f / sqrtf(ssa * (1.0f / 256.0f) + EPSN);
        { const f32x4 g0 = *(const f32x4*)(gout + 8 * lane), g1 = *(const f32x4*)(gout + 8 * lane + 4);
          u32x4 w; w.x = pk2(va[0] * rsa * g0[0], va[1] * rsa * g0[1]); w.y = pk2(va[2] * rsa * g0[2], va[3] * rsa * g0[3]); w.z = pk2(va[4] * rsa * g1[0], va[5] * rsa * g1[1]); w.w = pk2(va[6] * rsa * g1[2], va[7] * rsa * g1[3]);
          *(u32x4*)(abuf + (size_t)m * DM + 8 * lane) = w; }
        float vb[8];
        { const u32x4 raw = *(const u32x4*)(obuf + (size_t)m * DM + 512 + 8 * lane);
#pragma unroll
          for (int j = 0; j < 4; ++j) { vb[2 * j] = bf_lo(raw[j]); vb[2 * j + 1] = bf_hi(raw[j]); } }
        float ssb = 0.f;
#pragma unroll
        for (int j = 0; j < 8; ++j) ssb += vb[j] * vb[j];
        ssb = wave_sum(ssb); const float rsb = 1.0f / sqrtf(ssb * (1.0f / 512.0f) + EPSN);
        { const f32x4 g0 = *(const f32x4*)(gout + 512 + 8 * lane), g1 = *(const f32x4*)(gout + 512 + 8 * lane + 4);
          u32x4 w; w.x = pk2(vb[0] * rsb * g0[0], vb[1] * rsb * g0[1]); w.y = pk2(vb[2] * rsb * g0[2], vb[3] * rsb * g0[3]); w.z = pk2(vb[4] * rsb * g1[0], vb[5] * rsb * g1[1]); w.w = pk2(vb[6] * rsb * g1[2], vb[7] * rsb * g1[3]);
          *(u32x4*)(abuf + (size_t)m * DM + 512 + 8 * lane) = w; }
    }
}

__device__ __forceinline__ void mod_item(int item, const float* c, const float* cctx, const float* wmod, const float* bmod, float* mod, LAS unsigned char* lds, int tid, int wave, int lane) {
    LAS float* sl = (LAS float*)lds;
    LAS float* red = (LAS float*)(lds + 9 * 1024 * 4);
    const int l = item / 96, n0 = (item % 96) * 64;
    for (int i = tid; i < 9 * 1024; i += 512) { const int r = i >> 10, k = i & 1023; const float v = r < 8 ? c[r * 1024 + k] : cctx[k]; sl[i] = v / (1.0f + __expf(-v)); }
    __syncthreads();
    float acc[9];
#pragma unroll
    for (int r = 0; r < 9; ++r) acc[r] = 0.f;
    const float* wp = wmod + ((size_t)l * 1024 + wave * 128) * MODW + n0 + lane;
#pragma unroll 8
    for (int k = 0; k < 128; ++k) { const float wv = wp[(size_t)k * MODW];
#pragma unroll
        for (int r = 0; r < 9; ++r) acc[r] += sl[r * 1024 + wave * 128 + k] * wv; }
#pragma unroll
    for (int r = 0; r < 9; ++r) red[(wave * 9 + r) * 64 + lane] = acc[r];
    __syncthreads();
    for (int i = tid; i < 9 * 64; i += 512) { const int r = i >> 6, ln = i & 63; float s = bmod[l * MODW + n0 + ln];
#pragma unroll
        for (int w = 0; w < 8; ++w) s += red[(w * 9 + r) * 64 + ln];
        mod[((size_t)l * 9 + r) * MODW + n0 + ln] = s; }
    __syncthreads();
}
__device__ __forceinline__ int rowmap_in(int c) {
    const int pn = c >> 8; if (pn >= 2 && pn <= 5) return c;
    const int wc = (c >> 6) & 3, d = c & 63, bj = d >> 5; const bool vhead = (pn == 8) && (wc >= 2);
    int n, fq; const int e = d & 3;
    if (!vhead) { n = (d >> 4) & 1; fq = (d >> 2) & 3; } else { fq = (d >> 3) & 3; n = (d >> 2) & 1; }
    return pn * 256 + bj * 128 + wc * 32 + fq * 8 + n * 4 + e;
}
template <bool MAPIN> __device__ __forceinline__ void bias_item(const float* W, int ldw, int n0, const float* shrows  , float* out  , LAS unsigned char* lds, int tid, int wave, int lane) {
    LAS float* sl = (LAS float*)lds;
    LAS float* red = (LAS float*)(lds + 9 * 1024 * 4);
    for (int i = tid; i < 9 * 1024; i += 512) { const int r = i >> 10, k = i & 1023; sl[i] = shrows[(size_t)r * MODW + k]; }
    __syncthreads();
    float acc[9];
#pragma unroll
    for (int r = 0; r < 9; ++r) acc[r] = 0.f;
    const float* wp = W + (size_t)(wave * 128) * ldw + n0 + lane;
#pragma unroll 8
    for (int k = 0; k < 128; ++k) { const float wv = wp[(size_t)k * ldw];
#pragma unroll
        for (int r = 0; r < 9; ++r) acc[r] += sl[r * 1024 + wave * 128 + k] * wv; }
#pragma unroll
    for (int r = 0; r < 9; ++r) red[(wave * 9 + r) * 64 + lane] = acc[r];
    __syncthreads();
    for (int i = tid; i < 9 * 64; i += 512) { const int r = i >> 6, ln = i & 63; float s = 0.f;
#pragma unroll
        for (int w = 0; w < 8; ++w) s += red[(w * 9 + r) * 64 + ln];
        const int n = n0 + ln; out[(size_t)r * ldw + (MAPIN ? rowmap_in(n) : n)] = s; }
    __syncthreads();
}
template <bool MAPIN> __device__ __forceinline__ void transpose_item(const float* W, int K, int N, bf16_t* WT, LAS float* scr, int item, int lane) {
    const int nblk = N / 32, kb = item / nblk, nb = item % nblk, k0 = 64 * kb, n0 = 32 * nb;
#pragma unroll 8
    for (int i = 0; i < 32; ++i) { const int kk = 2 * i + (lane >> 5); scr[kk * 33 + (lane & 31)] = W[(size_t)(k0 + kk) * N + n0 + (lane & 31)]; }
    asm volatile("s_waitcnt lgkmcnt(0)" ::: "memory");
    const int c = lane & 7;
#pragma unroll
    for (int j = 0; j < 4; ++j) { const int n = (lane >> 3) + 8 * j; const LAS float* s = scr + (8 * c) * 33 + n;
        u32x4 o; o.x = pk2(s[0 * 33], s[1 * 33]); o.y = pk2(s[2 * 33], s[3 * 33]); o.z = pk2(s[4 * 33], s[5 * 33]); o.w = pk2(s[6 * 33], s[7 * 33]);
        const int orow = MAPIN ? rowmap_in(n0 + n) : (n0 + n);
        *(u32x4*)(WT + (size_t)orow * K + k0 + 8 * c) = o; }
    asm volatile("s_waitcnt lgkmcnt(0)" ::: "memory");
}

#define XB_TMO      128
#define XB_XCNT(j)  (256  + 64 * (j))
#define XB_XSUB(j)  (1280 + 64 * (j))
#define XB_XGEN(j)  (2304 + 64 * (j))
#define XB_TOP      3328
#define XB_TOPGEN   3392
#define XCD_BAR_WORDS 3456
#define XB_SPIN_CAP (1u << 18)

__device__ __forceinline__ unsigned xb_ld(unsigned* p)              { return __hip_atomic_load(p, __ATOMIC_RELAXED, __HIP_MEMORY_SCOPE_AGENT); }
__device__ __forceinline__ unsigned xb_add(unsigned* p, unsigned v) { return __hip_atomic_fetch_add(p, v, __ATOMIC_RELAXED, __HIP_MEMORY_SCOPE_AGENT); }
__device__ __forceinline__ unsigned xb_xcc_id() { return (unsigned)__builtin_amdgcn_s_getreg((3 << 11) | 20) & 0xFu; }
#define XB_SPIN(cond, bar) do { unsigned _sp = 0; while (cond) { __builtin_amdgcn_s_sleep(1); \
    if ((++_sp & 255u) == 0u) { if (xb_ld(&(bar)[XB_TMO])) break; if (_sp > XB_SPIN_CAP) { atomicAdd(&(bar)[XB_TMO], 1u); break; } } } } while (0)

struct XcdBarrier {
    unsigned* bar; unsigned x; bool t0;
    volatile LAS unsigned* st;
};

__device__ __forceinline__ XcdBarrier xcd_barrier_post(unsigned* bar, volatile LAS unsigned* st) {
    XcdBarrier b; b.bar = bar; b.x = xb_xcc_id(); b.st = st; b.t0 = (threadIdx.x == 0);
    if (threadIdx.x == 0) (void)xb_add(&bar[XB_XCNT(b.x)], 1u);
    return b;
}
__device__ __forceinline__ void xcd_barrier_complete(unsigned* bar, unsigned x, unsigned& nloc, unsigned& nx) {
    const unsigned G = gridDim.x * gridDim.y * gridDim.z;
    unsigned sum, cnt, mine, sp = 0u;
    for (;;) {
        sum = 0u; cnt = 0u; mine = 0u;
#pragma unroll
        for (unsigned j = 0; j < 16; ++j) { const unsigned c = xb_ld(&bar[XB_XCNT(j)]); sum += c; cnt += (c > 0u) ? 1u : 0u; mine = (j == x) ? c : mine; }
        if (sum == G) break;
        __builtin_amdgcn_s_sleep(1);
        if ((++sp & 255u) == 0u) { if (xb_ld(&bar[XB_TMO])) break; if (sp > XB_SPIN_CAP) { atomicAdd(&bar[XB_TMO], 1u); break; } }
    }
    nloc = mine > 0u ? mine : 1u; nx = cnt > 0u ? cnt : 1u;
}

__device__ __forceinline__ void xcd_barrier(const XcdBarrier& b) {
    asm volatile("s_waitcnt vmcnt(0)" ::: "memory");
    __syncthreads();
    if (b.t0) {
        unsigned* bar = b.bar;
        __builtin_amdgcn_s_waitcnt(0);
        unsigned nloc = b.st[0], nx = b.st[1];
        if (nloc == 0u) { xcd_barrier_complete(bar, b.x, nloc, nx); b.st[0] = nloc; b.st[1] = nx; }
        const unsigned old = xb_add(&bar[XB_XSUB(b.x)], 1u);
        const unsigned gen = old / nloc;
        if (old + 1u == (gen + 1u) * nloc) {
            __builtin_amdgcn_fence(__ATOMIC_RELEASE, "agent");
            asm volatile("s_waitcnt vmcnt(0)" ::: "memory");
            const unsigned og = xb_add(&bar[XB_TOP], 1u);
            const unsigned tg = og / nx;
            if (og + 1u == (tg + 1u) * nx) xb_add(&bar[XB_TOPGEN], 1u);
            else XB_SPIN(xb_ld(&bar[XB_TOPGEN]) == tg, bar);
            __builtin_amdgcn_fence(__ATOMIC_ACQUIRE, "agent");
            xb_add(&bar[XB_XGEN(b.x)], 1u);
            asm volatile("s_waitcnt vmcnt(0)" ::: "memory");
        } else {
            XB_SPIN(xb_ld(&bar[XB_XGEN(b.x)]) == gen, bar);
            __builtin_amdgcn_fence(__ATOMIC_ACQUIRE, "agent");
            asm volatile("s_waitcnt vmcnt(0)" ::: "memory");
        }
    }
    __syncthreads();
}

constexpr int LDS_ST_OFF = 8 * att::WAVE_LDS + 512;
constexpr int LDS_BYTES = LDS_ST_OFF + 64;
static_assert(LDS_BYTES <= 160 * 1024 && LDS_BYTES >= pg8::STAGE_BYTES, "LDS budget");
constexpr int N_PHASES = 15;
struct Params { const float* in[21]; float* out; unsigned char* ws; int ph_lo, ph_hi; };

#ifndef REPMASK
#define REPMASK 0
#endif
#ifndef EXTRA_SYNC
#define EXTRA_SYNC 0
#endif
__global__ void __launch_bounds__(512, 2) fwd_kernel(Params P) {
    extern __shared__ __attribute__((aligned(16))) unsigned char lds_raw[];
    LAS unsigned char* lds = (LAS unsigned char*)lds_raw;
    {   volatile LAS unsigned* bst0 = (volatile LAS unsigned*)(lds + LDS_ST_OFF);
        if (threadIdx.x < 16) bst0[threadIdx.x] = 0u;
        __syncthreads();
        (void)xcd_barrier_post((unsigned*)(P.ws + WS_BAR), bst0); }
#define GRID_SYNC() do { unsigned* bp_ = (unsigned*)(P.ws + WS_BAR); asm volatile("" : "+s"(bp_)); XcdBarrier b_; b_.bar = bp_; b_.x = xb_xcc_id(); b_.st = (volatile LAS unsigned*)(lds + LDS_ST_OFF); b_.t0 = (wave == 0) && (pg8::lane_id() == 0); xcd_barrier(b_); } while (0)
#define LANE_OPAQUE int ln_ = pg8::lane_id(); asm volatile("" : "+v"(ln_)); const int tid_ = wave * 64 + ln_; (void)tid_
#define WSP(T, off) ((T*)(ws + (off)))
#define MODL (WSP(const float, WS_MOD) + (size_t)ly * 9 * MODW)
#define XL ((ly == 0) ? P.in[0] : (const float*)P.out)
#define CL ((ly == 0) ? P.in[2] : WSP(const float, WS_CTX))
#define MROWS ((ly == 0) ? MALL : MLAT)
    const int ph_hi = P.ph_hi;
    const int wave = __builtin_amdgcn_readfirstlane(threadIdx.x >> 6);
#pragma unroll 1
    for (int ph = P.ph_lo; ph < ph_hi; ++ph) {
        int phv = ph; asm volatile("" : "+s"(phv));
        int kind = 0, ly = 0;
        if (phv >= 1) { const int idx = phv - 1; if (idx < 8) { kind = idx + 1 + (idx >= 5 ? 1 : 0); } else { const int j = idx - 8; ly = 1; kind = j + 2 + (j >= 4 ? 1 : 0); } }
        int G_ = gridDim.x, bx_ = blockIdx.x; asm volatile("" : "+s"(G_), "+s"(bx_));
        const int G = G_, bx = bx_; const int vcu = (G % 8 == 0) ? (bx % 8) * (G / 8) + bx / 8 : bx; const int gw = vcu * 8 + wave, ngw = G * 8;
        unsigned char* ws = P.ws;
#pragma unroll 1
        for (int rep_ = 0; rep_ <= ((REPMASK >> kind) & 1); ++rep_) {
        if (rep_) GRID_SYNC();
        switch (kind) {
        case 0: { LANE_OPAQUE;
            if (bx == G - 1) { for (int i = tid_; i < 512; i += 512) { const int l2 = i >> 8, k = (i >> 6) & 3, d = i & 63; const float* src = P.in[k == 0 ? 9 : k == 1 ? 10 : k == 2 ? 14 : 15]; WSP(float, WS_GAIN)[i] = src[l2 * 64 + d]; } }
            if (bx < 192) mod_item(bx, P.in[1], P.in[3], P.in[4], P.in[5], WSP(float, WS_MOD), lds, tid_, wave, ln_);
            LAS float* scr = (LAS float*)(lds + wave * 16384);
            constexpr int I_IN = 16 * (INW / 32), I_O = 16 * (DM / 32), I_1 = 16 * (FFN / 32), I_2 = 64 * (DM / 32), I_L = I_IN + I_O + I_1 + I_2;
            for (int it = gw; it < 2 * I_L; it += ngw) {
                const int l2 = it / I_L; int r = it - l2 * I_L;
                if (r < I_IN) { transpose_item<true>(P.in[8] + (size_t)l2 * DM * INW, DM, INW, WSP(bf16_t, WS_WIN) + (size_t)l2 * INW * DM, scr, r, ln_); continue; } r -= I_IN;
                if (r < I_O) { transpose_item<false>(P.in[18] + (size_t)l2 * DM * DM, DM, DM, WSP(bf16_t, WS_WO) + (size_t)l2 * DM * DM, scr, r, ln_); continue; } r -= I_O;
                if (r < I_1) { transpose_item<false>(P.in[19] + (size_t)l2 * DM * FFN, DM, FFN, WSP(bf16_t, WS_W1) + (size_t)l2 * FFN * DM, scr, r, ln_); continue; } r -= I_1;
                transpose_item<false>(P.in[20] + (size_t)l2 * FFN * DM, FFN, DM, WSP(bf16_t, WS_W2) + (size_t)l2 * DM * FFN, scr, r, ln_);
            }
        } break;
        case 1: { LANE_OPAQUE;
            prep_pass(P.in[0], P.in[2], P.in[6], WSP(const float, WS_MOD), DM, WSP(bf16_t, WS_HN2), WSP(float, WS_RS1), gw, ngw, ln_);
            for (int it = bx; it < 200; it += G) { const int l2 = it / 100, c = it % 100; const float* m2 = WSP(const float, WS_MOD) + (size_t)l2 * 9 * MODW;
                if (c < 36) bias_item<true>(P.in[8] + (size_t)l2 * DM * INW, INW, c * 64, m2, WSP(float, WS_BIN) + (size_t)l2 * 9 * INW, lds, tid_, wave, ln_);
                else bias_item<false>(P.in[19] + (size_t)l2 * DM * FFN, FFN, (c - 36) * 64, m2 + 3 * DM, WSP(float, WS_B1) + (size_t)l2 * 9 * FFN, lds, tid_, wave, ln_); }
        } break;
        case 2: { LANE_OPAQUE;
            pg8::Gemm g{WSP(bf16_t, WS_HN2), WSP(bf16_t, WS_WIN) + (size_t)ly * INW * DM, MALL, INW, DM}; pg8::StaticOrder S; S.init(MALL, INW, G, bx);
            pg8::EpiProj E{WSP(bf16_t, WS_PROJ), WSP(const float, WS_GAIN) + ly * 256, WSP(const float, WS_RS1), WSP(const float, WS_BIN) + (size_t)ly * 9 * INW};
            pg8::gemm_phase<pg8::EpiProj, pg8::StaticOrder, true, true>(lds, g, S, E, wave);
        } break;
        case 3: { LANE_OPAQUE;
            att::attn_phase(lds + wave * att::WAVE_LDS + 256, WSP(bf16_t, WS_PROJ), WSP(bf16_t, WS_OB), P.in[11] + (size_t)ly * 4 * 15 * 31, P.in[16] + ly * 8, ly == 0, gw, ngw, ln_);
        } break;
        case 4: { LANE_OPAQUE;
            mix_pass(WSP(bf16_t, WS_PROJ), WSP(bf16_t, WS_OB), P.in[12] + (size_t)ly * 3 * 256, P.in[13] + ly * 256, P.in[17] + ly * DM, WSP(bf16_t, WS_HN), MROWS, gw, ngw, ln_);
        } break;
        case 5: { LANE_OPAQUE;
            pg8::Gemm g{WSP(bf16_t, WS_HN), WSP(bf16_t, WS_WO) + (size_t)ly * DM * DM, MROWS, DM, DM}; pg8::StaticOrder S; S.init(MROWS, DM, G, bx);
            pg8::EpiResid E{XL, CL, P.out, WSP(float, WS_CTX), MODL + 2 * DM, WSP(bf16_t, WS_HN2), P.in[7] + ly * DM, MODL + 4 * DM, WSP(float, WS_RS2), nullptr, false};
            pg8::gemm_phase<pg8::EpiResid, pg8::StaticOrder, true, true>(lds, g, S, E, wave);
        } break;
        case 7: { LANE_OPAQUE;
            pg8::Gemm g{WSP(bf16_t, WS_HN2), WSP(bf16_t, WS_W1) + (size_t)ly * FFN * DM, MROWS, FFN, DM}; pg8::StaticOrder S; S.init(MROWS, FFN, G, bx);
            pg8::EpiFc1 E{WSP(bf16_t, WS_H1), FFN, WSP(const float, WS_RS2), WSP(const float, WS_B1) + (size_t)ly * 9 * FFN};
            pg8::gemm_phase<pg8::EpiFc1, pg8::StaticOrder, true, true>(lds, g, S, E, wave);
        } break;
        case 8: { LANE_OPAQUE;
            pg8::Gemm g{WSP(bf16_t, WS_H1), WSP(bf16_t, WS_W2) + (size_t)ly * DM * FFN, MROWS, DM, FFN};
            if (ly == 0) {
                pg8::SplitOrder S; S.init(G, bx);
                pg8::EpiResid E{P.out, WSP(float, WS_CTX), P.out, WSP(float, WS_CTX), MODL + 5 * DM, WSP(bf16_t, WS_HN2), P.in[6] + DM, WSP(const float, WS_MOD) + (size_t)9 * MODW + DM, WSP(float, WS_RS1), (float*)ws, true};
                pg8::gemm_phase<pg8::EpiResid, pg8::SplitOrder, true, true>(lds, g, S, E, wave);
            } else {
                pg8::StaticOrder S; S.init(MROWS, DM, G, bx);
                pg8::EpiResid E{P.out, WSP(float, WS_CTX), P.out, WSP(float, WS_CTX), MODL + 5 * DM, (bf16_t*)nullptr, nullptr, nullptr, nullptr, nullptr, false};
                pg8::gemm_phase<pg8::EpiResid, pg8::StaticOrder, true, true>(lds, g, S, E, wave);
            }
        } break;
        default: { LANE_OPAQUE;
            ctx_rows_pass(ws, WSP(const float, WS_CTX), WSP(const float, WS_MOD) + (size_t)8 * MODW + 5 * DM, P.in[6] + DM, WSP(const float, WS_MOD) + (size_t)(9 + 8) * MODW + DM, WSP(bf16_t, WS_HN2), WSP(float, WS_RS1), gw, ngw, ln_);
        } break;
        }
        }
        for (int es_ = 0; es_ < EXTRA_SYNC; ++es_) GRID_SYNC();
        if (ph + 1 < ph_hi) GRID_SYNC();
    }
}

#ifndef MK_MULTI_LAUNCH
#define MK_MULTI_LAUNCH 0
#endif
extern "C" void kernel_launch(void* const* d_in, const int* in_sizes, int n_in, void* d_out, int out_size, void* d_ws, size_t ws_size, hipStream_t stream) {
    static int grid = 0;
    if (grid == 0) {
        if (n_in != 21 || out_size != MLAT * DM || ws_size < WS_END) { fprintf(stderr, "kernel_launch: unexpected shapes (n_in %d out %d ws %zu)\n", n_in, out_size, ws_size); grid = -1; return; }
        int dev = 0, cus = 0, per_cu = 0;
        if (hipGetDevice(&dev) != hipSuccess || hipDeviceGetAttribute(&cus, hipDeviceAttributeMultiprocessorCount, dev) != hipSuccess) { grid = -1; return; }
        if (hipFuncSetAttribute((const void*)fwd_kernel, hipFuncAttributeMaxDynamicSharedMemorySize, LDS_BYTES) != hipSuccess) { fprintf(stderr, "kernel_launch: hipFuncSetAttribute failed\n"); grid = -1; return; }
        if (hipOccupancyMaxActiveBlocksPerMultiprocessor(&per_cu, (const void*)fwd_kernel, 512, LDS_BYTES) != hipSuccess || per_cu < 1) { fprintf(stderr, "kernel_launch: occupancy query gave %d\n", per_cu); (void)hipGetLastError(); grid = -1; return; }
        grid = cus * per_cu;
    }
    if (grid < 0) return;
    Params p{};
    for (int i = 0; i < 21; ++i) p.in[i] = (const float*)d_in[i];
    p.out = (float*)d_out; p.ws = (unsigned char*)d_ws;
    if (hipMemsetAsync((char*)d_ws + WS_BAR, 0, XCD_BAR_WORDS * 4, stream) != hipSuccess) { fprintf(stderr, "kernel_launch: memset of the barrier words failed\n"); return; }
    void* args[] = {&p};
#if MK_MULTI_LAUNCH
    for (int ph = 0; ph < N_PHASES; ++ph) { p.ph_lo = ph; p.ph_hi = ph + 1;
        hipError_t e = hipLaunchCooperativeKernel((const void*)fwd_kernel, dim3(grid), dim3(512), args, LDS_BYTES, stream);
        if (e != hipSuccess) { fprintf(stderr, "launch %d failed: %s\n", ph, hipGetErrorString(e)); break; } }
#else
    p.ph_lo = 0; p.ph_hi = N_PHASES;
    hipError_t e = hipLaunchCooperativeKernel((const void*)fwd_kernel, dim3(grid), dim3(512), args, LDS_BYTES, stream);
    if (e != hipSuccess) fprintf(stderr, "cooperative launch failed: %s (grid %d)\n", hipGetErrorString(e), grid);
#endif
}
```

```cpp
#include <hip/hip_runtime.h>
#include <cstdio>
#include <cstdint>
namespace pg8 {
#define PG8_LAS __attribute__((address_space(3)))
typedef unsigned short bf16_t;
__device__ __forceinline__ int lane_id() { int r; asm volatile("v_mbcnt_lo_u32_b32 %0, -1, 0\n\tv_mbcnt_hi_u32_b32 %0, -1, %0" : "=v"(r)); return r; }
template <int K> __device__ __forceinline__ float shx(float v) { static_assert(K == 1 || K == 2 || K == 4 || K == 8 || K == 16, "xor mask"); return __builtin_bit_cast(float, __builtin_amdgcn_ds_swizzle(__builtin_bit_cast(int, v), 0x1f | (K << 10))); }
__device__ __forceinline__ void swap_halves(float& a, float& b) { asm("s_nop 1\n\tv_permlane32_swap_b32 %0, %1" : "+v"(a), "+v"(b)); }
__device__ __forceinline__ float sum_halves(float v) { float a = v, b = v; swap_halves(a, b); return a + b; }
__device__ __forceinline__ float max_halves(float v) { float a = v, b = v; swap_halves(a, b); return fmaxf(a, b); }
typedef short bf16x8 __attribute__((ext_vector_type(8)));
typedef float f32x4 __attribute__((ext_vector_type(4)));
typedef unsigned u32x4 __attribute__((ext_vector_type(4)));
constexpr int BM = 256, BK = 64, HALF = 128, HTB = HALF * BK * 2  , STAGE_BYTES = 8 * HTB, NXCD = 8, WGM = 8;

__host__ __device__ __forceinline__ int lds_byte(int r, int c) { const int st = (r >> 4) * 2 + (c >> 5), rr = r & 15, cc = c & 31, ob = rr * 64 + cc * 2; return st * 1024 + (ob ^ (((ob >> 9) & 1) << 5)); }
__host__ __device__ __forceinline__ void stage_rc(int b, int& R, int& C) { const int st = b / 1024, sb = b % 1024, swz = sb ^ (((sb >> 9) & 1) << 5); R = (st >> 1) * 16 + swz / 64; C = (st & 1) * 32 + (swz % 64) / 2; }
__host__ __device__ __forceinline__ int perm32(int rho) { const int n = rho >> 4, i = rho & 15; return 8 * (i >> 2) + 4 * n + (i & 3); }

struct Unit { int pm, pn, k0t, nt, ks; };
struct Gemm { const bf16_t* A; const bf16_t* Bt; int M, N, K; };

struct StaticOrder {
    int nM, nN, nwg, G, c;
    __host__ __device__ void init(int M, int N, int G_, int c_) { nM = M / BM; nN = N / BM; nwg = nM * nN; G = G_; c = c_; }
    __host__ __device__ __forceinline__ bool next(int i, Unit& u) const {
        const long L = (long)i * G + c; if (L >= nwg) { u.pm = 0; u.pn = 0; u.k0t = 0; u.nt = 0; u.ks = 0; return false; }
        int wgid = (int)L; { const int q = nwg / NXCD, r = nwg % NXCD, xcd = wgid % NXCD, off = wgid / NXCD; wgid = (xcd < r ? xcd * (q + 1) : r * (q + 1) + (xcd - r) * q) + off; }
        const int nig = WGM * nN, gid = wgid / nig, fm = gid * WGM, gsz = (nM - fm) < WGM ? (nM - fm) : WGM;
        u.pm = fm + ((wgid % nig) % gsz); u.pn = (wgid % nig) / gsz; u.k0t = 0; u.nt = 0; u.ks = 0; return true;
    }
    __device__ __forceinline__ void a_ready(const Unit&) const {}
    __device__ __forceinline__ void done(const Unit&) const {}
};
__device__ __forceinline__ unsigned cvt_pk_bf16(float lo, float hi) { unsigned r; asm volatile("v_cvt_pk_bf16_f32 %0, %1, %2" : "=v"(r) : "v"(lo), "v"(hi)); return r; }
typedef float f32x2 __attribute__((ext_vector_type(2)));
template <class Epi, class Sched, bool ALIGN_EPI = false, bool SP2 = false>
__device__ __forceinline__ void gemm_phase(PG8_LAS unsigned char* lds, const Gemm g, const Sched& S, const Epi& E, const int wid_in) {
    int tid_ = wid_in * 64 + lane_id(); asm volatile("" : "+v"(tid_));
    const int tid = tid_, wid = __builtin_amdgcn_readfirstlane(tid >> 6), lane = tid & 63, wr = wid >> 2, wc = wid & 3, fr = lane & 15, fq = lane >> 4;
    const int K = g.K, nt_all = K / BK;
    unsigned voffA[2], voffB[2];
#pragma unroll
    for (int i = 0; i < 2; ++i) { int R, C; stage_rc(tid * 16 + i * 8192, R, C); const int Rb = Epi::PERM ? ((R & ~31) + perm32(R & 31)) : R;
        voffA[i] = (unsigned)(R * K + C) * 2u; voffB[i] = (unsigned)(Rb * K + C) * 2u; }
    const size_t kstep = (size_t)(BK * 2);
    const size_t hstep = (size_t)HALF * K * 2;
    const size_t tstep = 2 * hstep;
    const unsigned ldsw = (unsigned)wid * 1024u;
    const int aoff = lds_byte(wr * 64 + fr, fq * 8), boff = lds_byte(wc * 32 + fr, fq * 8);
#define PG8_SA(b, h) (((b) * 2 + (h)) * HTB)
#define PG8_SB(b, h) ((4 + (b) * 2 + (h)) * HTB)
#define PG8_STAGE(bufoff, gbase, voff) do { _Pragma("unroll") for (int _i = 0; _i < 2; ++_i) \
        __builtin_amdgcn_global_load_lds((const unsigned*)((const char*)(gbase) + (voff)[_i]), (PG8_LAS unsigned*)(lds + (bufoff) + ldsw + _i * 8192), 16, 0, 0); } while (0)
#define PG8_LDA(dst, b, h) do { _Pragma("unroll") for (int m = 0; m < 4; ++m) _Pragma("unroll") for (int k = 0; k < 2; ++k) dst[m][k] = *(const PG8_LAS bf16x8*)(lds + PG8_SA(b, h) + aoff + m * 2048 + k * 1024); } while (0)
#define PG8_LDB(dst, b, h) do { _Pragma("unroll") for (int n = 0; n < 2; ++n) _Pragma("unroll") for (int k = 0; k < 2; ++k) dst[n][k] = *(const PG8_LAS bf16x8*)(lds + PG8_SB(b, h) + boff + n * 2048 + k * 1024); } while (0)
#define PG8_MMA(ai, bj, At, Bt) do { __builtin_amdgcn_s_setprio(1); _Pragma("unroll") for (int m = 0; m < 4; ++m) _Pragma("unroll") for (int n = 0; n < 2; ++n) _Pragma("unroll") for (int k = 0; k < 2; ++k) \
        acc[ai][bj][m][n] = __builtin_amdgcn_mfma_f32_16x16x32_bf16(Bt[n][k], At[m][k], acc[ai][bj][m][n], 0, 0, 0); __builtin_amdgcn_s_setprio(0); } while (0)
#define PG8_WAIT_V(n) asm volatile("s_waitcnt vmcnt(" #n ")" ::: "memory")
#define PG8_WAIT_L(n) asm volatile("s_waitcnt lgkmcnt(" #n ")" ::: "memory")
#define PG8_BAR __builtin_amdgcn_s_barrier()
#define PG8_SCHED __builtin_amdgcn_sched_barrier(0)
    Unit cur, nxt; int ui = 0;
    if (!S.next(0, cur)) return;
    f32x4 acc[2][2][4][2];
#pragma unroll
    for (int a = 0; a < 2; ++a)
#pragma unroll
        for (int b = 0; b < 2; ++b)
#pragma unroll
            for (int m = 0; m < 4; ++m)
#pragma unroll
                for (int n = 0; n < 2; ++n) acc[a][b][m][n] = (f32x4){0.f, 0.f, 0.f, 0.f};
    bf16x8 At[4][2], B0[2][2], B1[2][2];
    const char* cA = (const char*)g.A + (size_t)cur.pm * tstep + (size_t)cur.k0t * kstep; const char* cB = (const char*)g.Bt + (size_t)cur.pn * tstep + (size_t)cur.k0t * kstep;
    int nt = cur.nt ? cur.nt : nt_all;
    S.a_ready(cur);
    if constexpr (SP2) {
        PG8_STAGE(PG8_SB(0, 0), cB, voffB); PG8_STAGE(PG8_SB(0, 1), cB + hstep, voffB); PG8_STAGE(PG8_SA(0, 0), cA, voffA); PG8_STAGE(PG8_SA(0, 1), cA + hstep, voffA);
        if (wr == 1) PG8_BAR;
        PG8_WAIT_V(2); PG8_BAR;
        PG8_STAGE(PG8_SB(1, 0), cB + kstep, voffB); PG8_STAGE(PG8_SA(1, 0), cA + kstep, voffA); PG8_STAGE(PG8_SB(1, 1), cB + hstep + kstep, voffB);
        PG8_WAIT_V(6); PG8_BAR;
    } else {
        PG8_STAGE(PG8_SB(0, 0), cB, voffB); PG8_STAGE(PG8_SA(0, 0), cA, voffA); PG8_STAGE(PG8_SB(0, 1), cB + hstep, voffB); PG8_STAGE(PG8_SA(0, 1), cA + hstep, voffA);
        if (wr == 1) PG8_BAR;
        PG8_WAIT_V(4); PG8_BAR;
        PG8_STAGE(PG8_SB(1, 0), cB + kstep, voffB); PG8_STAGE(PG8_SA(1, 0), cA + kstep, voffA); PG8_STAGE(PG8_SB(1, 1), cB + hstep + kstep, voffB);
        PG8_WAIT_V(6); PG8_BAR;
    }
    for (;;) {
        const bool has_next = S.next(ui + 1, nxt);
        const char* nA = has_next ? (const char*)g.A + (size_t)nxt.pm * tstep + (size_t)nxt.k0t * kstep : cA; const char* nB = has_next ? (const char*)g.Bt + (size_t)nxt.pn * tstep + (size_t)nxt.k0t * kstep : cB;
        for (int t = 0; t < nt; t += 2) {
            const bool last = (t == nt - 2);
            const char* a1 = cA + (size_t)(t + 1) * kstep;
            const char* a2 = last ? nA : cA + (size_t)(t + 2) * kstep; const char* b2 = last ? nB : cB + (size_t)(t + 2) * kstep;
            const char* a3 = a2 + kstep; const char* b3 = b2 + kstep;
            if (last && has_next) S.a_ready(nxt);
            if constexpr (SP2) {
            PG8_LDB(B0, 0, 0); PG8_LDB(B1, 0, 1); PG8_SCHED; PG8_LDA(At, 0, 0); PG8_STAGE(PG8_SA(1, 1), a1 + hstep, voffA);
            PG8_WAIT_V(8); PG8_WAIT_L(0); PG8_BAR; PG8_MMA(0, 0, At, B0); PG8_MMA(0, 1, At, B1); PG8_BAR; PG8_SCHED;
            PG8_LDA(At, 0, 1); PG8_STAGE(PG8_SB(0, 0), b2, voffB); PG8_STAGE(PG8_SB(0, 1), b2 + hstep, voffB); PG8_STAGE(PG8_SA(0, 0), a2, voffA);
            PG8_WAIT_V(8); PG8_WAIT_L(0); PG8_BAR; PG8_MMA(1, 0, At, B0); PG8_MMA(1, 1, At, B1); PG8_BAR; PG8_SCHED;
            PG8_LDB(B0, 1, 0); PG8_LDB(B1, 1, 1); PG8_SCHED; PG8_LDA(At, 1, 0); PG8_STAGE(PG8_SA(0, 1), a2 + hstep, voffA);
            PG8_WAIT_V(8); PG8_WAIT_L(0); PG8_BAR; PG8_MMA(0, 0, At, B0); PG8_MMA(0, 1, At, B1); PG8_BAR; PG8_SCHED;
            PG8_LDA(At, 1, 1); PG8_STAGE(PG8_SB(1, 0), b3, voffB); PG8_STAGE(PG8_SB(1, 1), b3 + hstep, voffB); PG8_STAGE(PG8_SA(1, 0), a3, voffA);
            PG8_WAIT_V(8); PG8_WAIT_L(0); PG8_BAR; PG8_MMA(1, 0, At, B0); PG8_MMA(1, 1, At, B1); PG8_BAR; PG8_SCHED;
            } else {
            PG8_LDB(B0, 0, 0); PG8_SCHED; PG8_LDA(At, 0, 0); PG8_STAGE(PG8_SA(1, 1), a1 + hstep, voffA);
            PG8_WAIT_L(8); PG8_BAR; PG8_WAIT_L(0); PG8_MMA(0, 0, At, B0); PG8_BAR; PG8_SCHED;
            PG8_LDB(B1, 0, 1); PG8_STAGE(PG8_SB(0, 0), b2, voffB);
            PG8_BAR; PG8_WAIT_L(0); PG8_MMA(0, 1, At, B1); PG8_BAR;
            PG8_LDA(At, 0, 1); PG8_STAGE(PG8_SA(0, 0), a2, voffA);
            PG8_BAR; PG8_WAIT_L(0); PG8_MMA(1, 0, At, B0); PG8_BAR; PG8_SCHED;
            PG8_STAGE(PG8_SB(0, 1), b2 + hstep, voffB);
            PG8_WAIT_V(6); PG8_BAR; PG8_MMA(1, 1, At, B1); PG8_BAR;
            PG8_LDB(B0, 1, 0); PG8_SCHED; PG8_LDA(At, 1, 0); PG8_STAGE(PG8_SA(0, 1), a2 + hstep, voffA);
            PG8_WAIT_L(8); PG8_BAR; PG8_WAIT_L(0); PG8_MMA(0, 0, At, B0); PG8_BAR; PG8_SCHED;
            PG8_LDB(B1, 1, 1); PG8_STAGE(PG8_SB(1, 0), b3, voffB);
            PG8_BAR; PG8_WAIT_L(0); PG8_MMA(0, 1, At, B1); PG8_BAR;
            PG8_LDA(At, 1, 1); PG8_STAGE(PG8_SA(1, 0), a3, voffA);
            PG8_BAR; PG8_WAIT_L(0); PG8_MMA(1, 0, At, B0); PG8_BAR; PG8_SCHED;
            PG8_STAGE(PG8_SB(1, 1), b3 + hstep, voffB);
            PG8_WAIT_V(6); PG8_BAR; PG8_MMA(1, 1, At, B1); PG8_BAR;
            }
        }
        if constexpr (ALIGN_EPI) { if (wr == 0) PG8_BAR; }
        if constexpr (!Epi::AFTER_DRAIN) { E(acc, cur, wr, wc, fr, fq); S.done(cur); }
        if (!has_next) break;
#pragma unroll
        for (int a = 0; a < 2; ++a)
#pragma unroll
            for (int b = 0; b < 2; ++b)
#pragma unroll
                for (int m = 0; m < 4; ++m)
#pragma unroll
                    for (int n = 0; n < 2; ++n) acc[a][b][m][n] = (f32x4){0.f, 0.f, 0.f, 0.f};
        cur = nxt; cA = nA; cB = nB; ++ui; nt = cur.nt ? cur.nt : nt_all;
        if constexpr (ALIGN_EPI) { if (wr == 1) PG8_BAR; }
    }
    PG8_WAIT_V(0);
    if constexpr (!ALIGN_EPI) { if (wr == 0) PG8_BAR; }
    PG8_BAR;
    if constexpr (Epi::AFTER_DRAIN) { E.fused(acc, cur, wr, wc, fr, fq, lds, wid, lane); S.done(cur); }
#undef PG8_SA
#undef PG8_SB
#undef PG8_STAGE
#undef PG8_LDA
#undef PG8_LDB
#undef PG8_MMA
#undef PG8_WAIT_V
#undef PG8_WAIT_L
#undef PG8_BAR
#undef PG8_SCHED
}
}

namespace pg8 {
typedef unsigned u32x2 __attribute__((ext_vector_type(2)));
template <int ACT> struct EpiStore {
    static constexpr bool PERM = true, AFTER_DRAIN = false;
    bf16_t* O; int ldc;
    __device__ __forceinline__ void operator()(const f32x4 (&acc)[2][2][4][2], const Unit& u, int wr, int wc, int fr, int fq) const {
        const int row0 = u.pm * BM + wr * 64 + fr, col0 = u.pn * BM + wc * 32 + 8 * fq;
#pragma unroll
        for (int ai = 0; ai < 2; ++ai)
#pragma unroll
            for (int m = 0; m < 4; ++m) { bf16_t* rowp = O + (size_t)(row0 + ai * HALF + m * 16) * ldc + col0;
#pragma unroll
                for (int bj = 0; bj < 2; ++bj) { f32x4 v0 = acc[ai][bj][m][0], v1 = acc[ai][bj][m][1];
                    if (ACT == 2) {
#pragma unroll
                        for (int e = 0; e < 4; ++e) { const float a = fmaxf(v0[e], 0.f), b = fmaxf(v1[e], 0.f); v0[e] = a * a; v1[e] = b * b; } }
                    u32x4 w; w.x = cvt_pk_bf16(v0[0], v0[1]); w.y = cvt_pk_bf16(v0[2], v0[3]); w.z = cvt_pk_bf16(v1[0], v1[1]); w.w = cvt_pk_bf16(v1[2], v1[3]);
                    *(u32x4*)(rowp + bj * HALF) = w; } }
    }
};


__device__ __forceinline__ void rows_rstd(const float* rs, int row0, int fq, float (&rstd)[2][4]) {
    f32x4 p[2][4];
#pragma unroll
    for (int ai = 0; ai < 2; ++ai)
#pragma unroll
        for (int m = 0; m < 4; ++m) p[ai][m] = *(const f32x4*)(rs + (size_t)(row0 + ai * HALF + m * 16) * 16 + 4 * fq);
#pragma unroll
    for (int ai = 0; ai < 2; ++ai)
#pragma unroll
        for (int m = 0; m < 4; ++m) { float s = (p[ai][m][0] + p[ai][m][1]) + (p[ai][m][2] + p[ai][m][3]); s += shx<16>(s); s = sum_halves(s); rstd[ai][m] = 1.0f / sqrtf(s * (1.0f / 1024.0f) + 1e-6f); }
}
struct EpiFc1 {
    static constexpr bool PERM = true, AFTER_DRAIN = false;
    bf16_t* O; int ldc; const float* rs; const float* bias;
    __device__ __forceinline__ void operator()(const f32x4 (&acc)[2][2][4][2], const Unit& u, int wr, int wc, int fr_in, int fq_in) const {
        (void)fr_in; (void)fq_in; int ln_e = lane_id(); asm volatile("" : "+v"(ln_e)); const int fr = ln_e & 15, fq = ln_e >> 4;
        const int row0 = u.pm * BM + wr * 64 + fr, col0 = u.pn * BM + wc * 32 + 8 * fq; const int b = (u.pm < 64) ? (u.pm >> 3) : 8;
        f32x4 bv[2][2];
#pragma unroll
        for (int bj = 0; bj < 2; ++bj)
#pragma unroll
            for (int n = 0; n < 2; ++n) bv[bj][n] = *(const f32x4*)(bias + (size_t)b * ldc + col0 + bj * HALF + 4 * n);
        float rsd[2][4]; rows_rstd(rs, row0, fq, rsd);
#pragma unroll
        for (int ai = 0; ai < 2; ++ai)
#pragma unroll
            for (int m = 0; m < 4; ++m) { const int row = row0 + ai * HALF + m * 16; const float rstd = rsd[ai][m]; bf16_t* rowp = O + (size_t)row * ldc + col0;
#pragma unroll
                for (int bj = 0; bj < 2; ++bj) { f32x4 v0 = acc[ai][bj][m][0] * rstd + bv[bj][0], v1 = acc[ai][bj][m][1] * rstd + bv[bj][1];
#pragma unroll
                    for (int e = 0; e < 4; ++e) { const float a = fmaxf(v0[e], 0.f), c = fmaxf(v1[e], 0.f); v0[e] = a * a; v1[e] = c * c; }
                    u32x4 w; w.x = cvt_pk_bf16(v0[0], v0[1]); w.y = cvt_pk_bf16(v0[2], v0[3]); w.z = cvt_pk_bf16(v1[0], v1[1]); w.w = cvt_pk_bf16(v1[2], v1[3]);
                    *(u32x4*)(rowp + bj * HALF) = w; }
                asm volatile("" ::: "memory"); }
    }
};


__host__ __device__ __forceinline__ size_t slab_off(int i) { const size_t MiB_ = (size_t)1 << 20; return i < 36 ? 234 * MiB_ + (size_t)i * 262144 : i < 64 ? 249 * MiB_ + (size_t)(i - 36) * 262144 : 14 * MiB_ + (size_t)(i - 64) * 262144; }
struct SplitOrder {
    StaticOrder lat; int G, c;
    __host__ __device__ void init(int G_, int c_) { lat.init(64 * BM, 4 * BM, G_, c_); G = G_; c = c_; }
    __host__ __device__ __forceinline__ bool next(int i, Unit& u) const {
        const long L = (long)i * G + c;
        Unit t; const bool okl = lat.next(i, t);
        const int s = (int)(L - 256), unit = s >> 2; const bool isl = L < 256;
        u.pm = isl ? t.pm : 64 + (unit >> 2); u.pn = isl ? t.pn : (unit & 3); u.ks = isl ? 0 : (s & 3); u.k0t = isl ? 0 : (s & 3) * 16; u.nt = isl ? 0 : 16;
        return isl ? okl : (s < 128);
    }
    __device__ __forceinline__ void a_ready(const Unit&) const {}
    __device__ __forceinline__ void done(const Unit&) const {}
};

struct EpiResid {
    static constexpr bool PERM = true, AFTER_DRAIN = false;
    const float* base_lat; const float* base_ctx; float* out_lat; float* out_ctx; const float* gate;
    bf16_t* aout; const float* gn; const float* scn; float* rsout;
    bool dry;
    float* slab; bool split_ctx;
    __device__ __forceinline__ void operator()(const f32x4 (&acc)[2][2][4][2], const Unit& u, int wr, int wc, int fr_in, int fq_in) const {
        (void)fr_in; (void)fq_in; int ln_e = lane_id(); asm volatile("" : "+v"(ln_e)); const int fr = ln_e & 15, fq = ln_e >> 4;
        if (dry) return;
        const bool lat = u.pm < 64;
        const int b = lat ? (u.pm >> 3) : 8;
        const size_t roff = (size_t)(lat ? u.pm : u.pm - 64) * BM * 1024;
        const float* base = (lat ? base_lat : base_ctx) + roff; float* out = (lat ? out_lat : out_ctx) + roff;
        const int col0 = u.pn * BM + wc * 32 + 8 * fq;
        f32x4 gv[2][2];
#pragma unroll
        for (int bj = 0; bj < 2; ++bj)
#pragma unroll
            for (int n = 0; n < 2; ++n) gv[bj][n] = *(const f32x4*)(gate + (size_t)b * 6144 + col0 + bj * HALF + n * 4);
        if (u.ks != 0) {
            float* sp = (float*)((unsigned char*)slab + slab_off(((u.pm - 64) * 4 + u.pn) * 3 + (u.ks - 1))) + wc * 32 + 8 * fq;
#pragma unroll
            for (int ai = 0; ai < 2; ++ai)
#pragma unroll
                for (int m = 0; m < 4; ++m) { float* rp = sp + (size_t)(ai * HALF + wr * 64 + m * 16 + fr) * 256;
#pragma unroll
                    for (int bj = 0; bj < 2; ++bj) { *(f32x4*)(rp + bj * HALF) = acc[ai][bj][m][0]; *(f32x4*)(rp + bj * HALF + 4) = acc[ai][bj][m][1]; } }
            return;
        }
        if (aout == nullptr || (split_ctx && !lat)) {
#pragma unroll
            for (int ai = 0; ai < 2; ++ai)
#pragma unroll
                for (int m = 0; m < 4; ++m) { const size_t off = (size_t)(ai * HALF + wr * 64 + m * 16 + fr) * 1024 + col0;
#pragma unroll
                    for (int bj = 0; bj < 2; ++bj)
#pragma unroll
                        for (int n = 0; n < 2; ++n) { const f32x4 bs = *(const f32x4*)(base + off + bj * HALF + n * 4);
                            *(f32x4*)(out + off + bj * HALF + n * 4) = bs + gv[bj][n] * acc[ai][bj][m][n]; }
                    if (m & 1) asm volatile("" ::: "memory"); }
            return;
        }
        f32x4 Gv[2][2];
#pragma unroll
        for (int bj = 0; bj < 2; ++bj)
#pragma unroll
            for (int n = 0; n < 2; ++n) Gv[bj][n] = *(const f32x4*)(gn + col0 + bj * HALF + n * 4) * (*(const f32x4*)(scn + (size_t)b * 6144 + col0 + bj * HALF + n * 4) + 1.0f);
        const size_t grow0 = (size_t)u.pm * BM;
#pragma unroll
        for (int ai = 0; ai < 2; ++ai)
#pragma unroll
            for (int m = 0; m < 4; ++m) { const int rl = ai * HALF + wr * 64 + m * 16 + fr; const size_t off = (size_t)rl * 1024 + col0; float ss = 0.f;
                bf16_t* ap = aout + (grow0 + rl) * 1024 + col0;
#pragma unroll
                for (int bj = 0; bj < 2; ++bj) {
                    const f32x4 b0 = *(const f32x4*)(base + off + bj * HALF), b1 = *(const f32x4*)(base + off + bj * HALF + 4);
                    const f32x4 x0 = b0 + gv[bj][0] * acc[ai][bj][m][0], x1 = b1 + gv[bj][1] * acc[ai][bj][m][1];
                    *(f32x4*)(out + off + bj * HALF) = x0; *(f32x4*)(out + off + bj * HALF + 4) = x1;
                    ss += ((x0[0] * x0[0] + x0[1] * x0[1]) + (x0[2] * x0[2] + x0[3] * x0[3])) + ((x1[0] * x1[0] + x1[1] * x1[1]) + (x1[2] * x1[2] + x1[3] * x1[3]));
                    const f32x4 y0 = x0 * Gv[bj][0], y1 = x1 * Gv[bj][1];
                    u32x4 w; w.x = cvt_pk_bf16(y0[0], y0[1]); w.y = cvt_pk_bf16(y0[2], y0[3]); w.z = cvt_pk_bf16(y1[0], y1[1]); w.w = cvt_pk_bf16(y1[2], y1[3]);
                    *(u32x4*)(ap + bj * HALF) = w; }
                ss += shx<16>(ss); ss = sum_halves(ss);
                if (fq == 0) rsout[(grow0 + rl) * 16 + u.pn * 4 + wc] = ss;
                if (m & 1) asm volatile("" ::: "memory"); }
    }
};

struct EpiProj {
    static constexpr bool PERM = true, AFTER_DRAIN = false;
    bf16_t* O; const float* gains;
    const float* rs; const float* bias;
    __device__ __forceinline__ void operator()(const f32x4 (&acc)[2][2][4][2], const Unit& u, int wr, int wc, int fr_in, int fq_in) const {
        (void)fr_in; (void)fq_in; int ln_e = lane_id(); asm volatile("" : "+v"(ln_e)); const int fr = ln_e & 15, fq = ln_e >> 4;
        const int pn = u.pn; const int row0 = u.pm * BM + wr * 64 + fr; const int b = (u.pm < 64) ? (u.pm >> 3) : 8;
        f32x4 bv[2][2];
#pragma unroll
        for (int bj = 0; bj < 2; ++bj)
#pragma unroll
            for (int n = 0; n < 2; ++n) bv[bj][n] = *(const f32x4*)(bias + (size_t)b * 2304 + pn * BM + bj * HALF + wc * 32 + 8 * fq + 4 * n);
        float rsd[2][4]; rows_rstd(rs, row0, fq, rsd);
        if (pn >= 2 && pn <= 5) {
            const int col0 = pn * BM + wc * 32 + 8 * fq;
#pragma unroll
            for (int ai = 0; ai < 2; ++ai)
#pragma unroll
                for (int m = 0; m < 4; ++m) { bf16_t* rowp = O + (size_t)(row0 + ai * HALF + m * 16) * 2304 + col0; const float rstd = rsd[ai][m];
#pragma unroll
                    for (int bj = 0; bj < 2; ++bj) { const f32x4 v0 = acc[ai][bj][m][0] * rstd + bv[bj][0], v1 = acc[ai][bj][m][1] * rstd + bv[bj][1];
                        u32x4 w; w.x = cvt_pk_bf16(v0[0], v0[1]); w.y = cvt_pk_bf16(v0[2], v0[3]); w.z = cvt_pk_bf16(v1[0], v1[1]); w.w = cvt_pk_bf16(v1[2], v1[3]);
                        *(u32x4*)(rowp + bj * HALF) = w; } }
            return;
        }
        const int colh = pn * BM + wc * 64 + 8 * fq;
        const bool vhead = (pn == 8) && (wc >= 2);
        if (vhead) {
#pragma unroll
            for (int ai = 0; ai < 2; ++ai)
#pragma unroll
                for (int m = 0; m < 4; ++m) { bf16_t* rowp = O + (size_t)(row0 + ai * HALF + m * 16) * 2304 + colh; const float rstd = rsd[ai][m];
#pragma unroll
                    for (int bj = 0; bj < 2; ++bj) { const f32x4 v0 = acc[ai][bj][m][0] * rstd + bv[bj][0], v1 = acc[ai][bj][m][1] * rstd + bv[bj][1];
                        u32x4 w; w.x = cvt_pk_bf16(v0[0], v0[1]); w.y = cvt_pk_bf16(v0[2], v0[3]); w.z = cvt_pk_bf16(v1[0], v1[1]); w.w = cvt_pk_bf16(v1[2], v1[3]);
                        *(u32x4*)(rowp + bj * 32) = w; } }
            return;
        }
        const float* gp = gains + 64 * ((pn == 0) ? 0 : (pn == 1) ? 1 : (pn == 8) ? 3 : 2);
        const float qs = (pn == 1 || pn == 8) ? 1.0f : 0.18033688011112042f;
        const bool rope = (pn >= 6) && (u.pm < 64);
        f32x4 gv[2][2];
#pragma unroll
        for (int bj = 0; bj < 2; ++bj)
#pragma unroll
            for (int n = 0; n < 2; ++n) gv[bj][n] = *(const f32x4*)(gp + 32 * bj + 16 * n + 4 * fq);
        float invrev[4];
#pragma unroll
        for (int e = 0; e < 4; ++e) invrev[e] = __builtin_amdgcn_exp2f(-(float)(4 * fq + e) * (13.287712379549449f / 16.0f)) * 0.15915494309189535f;
#pragma unroll
        for (int ai = 0; ai < 2; ++ai)
#pragma unroll
            for (int m = 0; m < 4; ++m) {
                const int row = row0 + ai * HALF + m * 16; const float rstd0 = rsd[ai][m];
                f32x4 v[2][2]; float ss = 0.f;
#pragma unroll
                for (int bj = 0; bj < 2; ++bj)
#pragma unroll
                    for (int n = 0; n < 2; ++n) v[bj][n] = acc[ai][bj][m][n] * rstd0 + bv[bj][n];
                asm volatile("" : "+v"(v[0][0]), "+v"(v[0][1]), "+v"(v[1][0]), "+v"(v[1][1]));
#pragma unroll
                for (int bj = 0; bj < 2; ++bj)
#pragma unroll
                    for (int n = 0; n < 2; ++n) { const f32x4 x = v[bj][n]; ss += (x[0] * x[0] + x[1] * x[1]) + (x[2] * x[2] + x[3] * x[3]); }
                ss += shx<16>(ss); ss = sum_halves(ss);
                const float rstd = 1.0f / sqrtf(ss * (1.0f / 64.0f) + 1e-6f);
#pragma unroll
                for (int bj = 0; bj < 2; ++bj)
#pragma unroll
                    for (int n = 0; n < 2; ++n) v[bj][n] = v[bj][n] * rstd * gv[bj][n];
                if (rope) {
                    const int t = row & 2047;
#pragma unroll
                    for (int bj = 0; bj < 2; ++bj) { const float pos = (float)(bj == 0 ? (t >> 6) : (t & 63));
#pragma unroll
                        for (int e = 0; e < 4; ++e) { float rev = pos * invrev[e]; rev = rev - floorf(rev);
                            const float cs = __builtin_amdgcn_cosf(rev), sn = __builtin_amdgcn_sinf(rev);
                            const float u1 = v[bj][0][e], u2 = v[bj][1][e];
                            v[bj][0][e] = u1 * cs - u2 * sn; v[bj][1][e] = u2 * cs + u1 * sn; } }
                }
                bf16_t* rowp = O + (size_t)row * 2304 + colh;
#pragma unroll
                for (int bj = 0; bj < 2; ++bj) { const f32x4 v0 = v[bj][0] * qs, v1 = v[bj][1] * qs;
                    u32x4 w; w.x = cvt_pk_bf16(v0[0], v0[1]); w.y = cvt_pk_bf16(v0[2], v0[3]); w.z = cvt_pk_bf16(v1[0], v1[1]); w.w = cvt_pk_bf16(v1[2], v1[3]);
                    *(u32x4*)(rowp + bj * 32) = w; }
                asm volatile("" ::: "memory");
            }
    }
};
}

#define LAS __attribute__((address_space(3)))
typedef unsigned short bf16_t;
typedef short bf16x8 __attribute__((ext_vector_type(8)));
typedef short s16x4 __attribute__((ext_vector_type(4)));
typedef float f32x16 __attribute__((ext_vector_type(16)));
typedef float f32x4 __attribute__((ext_vector_type(4)));
typedef unsigned u32x4 __attribute__((ext_vector_type(4)));
typedef unsigned u32x2 __attribute__((ext_vector_type(2)));

constexpr int DM = 1024, NB = 8, SEQ = 2048, CTXL = 256, FFN = 4096, INW = 2304;
constexpr int MLAT = NB * SEQ, MCTX = NB * CTXL, MALL = MLAT + MCTX;
constexpr float EPSN = 1e-6f, LOG2E = 1.4426950408889634f, NEGBIG = -1e30f;
constexpr int MODW = 6 * DM;
constexpr size_t MiB = (size_t)1 << 20;
constexpr size_t WS_MOD = 0;
constexpr size_t WS_GAIN = 512 * 1024;
constexpr size_t WS_BAR = 768 * 1024;
constexpr size_t WS_WIN = 1 * MiB;
constexpr size_t WS_WO = 10 * MiB;
constexpr size_t WS_W1 = 14 * MiB;
constexpr size_t WS_W2 = 30 * MiB;
constexpr size_t WS_CTX = 46 * MiB;
constexpr size_t WS_HN2 = 54 * MiB;
constexpr size_t WS_HN = 207 * MiB;
constexpr size_t WS_H1 = 90 * MiB;
constexpr size_t WS_PROJ = 90 * MiB;
constexpr size_t WS_OB = 171 * MiB;
constexpr size_t WS_RS1 = 243 * MiB;
constexpr size_t WS_RS2 = 245 * MiB;
constexpr size_t WS_BIN = 247 * MiB;
constexpr size_t WS_B1 = 248 * MiB;
constexpr size_t WS_END = 256 * MiB;
static_assert(WS_W1 == 14 * MiB, "pg8::slab_off places 32 slabs in the first layer's fc1 weight copy");

__device__ __forceinline__ float half_sum(float v) { v += pg8::shx<1>(v); v += pg8::shx<2>(v); v += pg8::shx<4>(v); v += pg8::shx<8>(v); v += pg8::shx<16>(v); return v; }
__device__ __forceinline__ float wave_sum(float v) { return pg8::sum_halves(half_sum(v)); }
__device__ __forceinline__ unsigned f2bf(float f) { unsigned u = __builtin_bit_cast(unsigned, f); return (u + 0x7fffu + ((u >> 16) & 1u)) >> 16; }
__device__ __forceinline__ unsigned pk2(float lo, float hi) { return f2bf(lo) | (f2bf(hi) << 16); }
__device__ __forceinline__ float bf_lo(unsigned u) { return __builtin_bit_cast(float, u << 16); }
__device__ __forceinline__ float bf_hi(unsigned u) { return __builtin_bit_cast(float, u & 0xffff0000u); }

namespace att {
constexpr int KROWB = 144, VROWB = 128, WL_V = 64 * KROWB, WL_A = WL_V + 64 * VROWB, WL_TAB = WL_A + 128 + 192, WAVE_LDS = WL_TAB + 15 * 32 * 4;
typedef float f32x2_t __attribute__((ext_vector_type(2))); typedef __bf16 bf16x2_t __attribute__((ext_vector_type(2)));
typedef short v4i16_t __attribute__((ext_vector_type(4)));
__device__ __forceinline__ unsigned cvtpk(float lo, float hi) { f32x2_t v = {lo, hi}; bf16x2_t b = __builtin_convertvector(v, bf16x2_t); return __builtin_bit_cast(unsigned, b); }
__device__ __forceinline__ s16x4 vtr(LAS const unsigned char* p) { return __builtin_bit_cast(s16x4, __builtin_amdgcn_ds_read_tr16_b64_v4i16((LAS v4i16_t*)p)); }
struct AU { int qrow0, qcol, kcol, vcol, ocol, ctxrow0, nloc, locrow0, a0, a1; float negc, l0; const float* rpb; };
template <int KIND> __device__ __forceinline__ void attn_unit(LAS unsigned char* wl, const bf16_t* __restrict__ proj, bf16_t* __restrict__ obuf, const AU u, const int lane_in) {
    int lane = lane_in; asm volatile("" : "+v"(lane));
    const int r32 = lane & 31, hi = lane >> 5;
    LAS float* sc = (LAS float*)(wl + WL_A);
    LAS float* tab = (LAS float*)(wl + WL_TAB);
    bf16x8 qr[4];
    { const bf16_t* qp = proj + (size_t)(u.qrow0 + r32) * INW + u.qcol + hi * 8;
#pragma unroll
      for (int d0 = 0; d0 < 4; ++d0) qr[d0] = *(const bf16x8*)(qp + d0 * 16); }
    if (KIND == 0) { for (int i = lane; i < 15 * 31; i += 64) { const int a = i / 31, b = i - a * 31; tab[a * 32 + b] = u.rpb[i] * LOG2E; } }
    f32x16 o0, o1;
#pragma unroll
    for (int r = 0; r < 16; ++r) { o0[r] = 0.f; o1[r] = 0.f; }
    float l = (hi == 0) ? u.l0 : 0.f;
    const int nt = 4 + u.nloc;
    const int lrow = lane >> 3, lch = lane & 7;
    u32x4 kreg[8], kreg2[8], vreg[8];
#define ATT_ROW0(t) (((t) < 4) ? u.ctxrow0 + 64 * (t) : u.locrow0 + 64 * ((t) - 4))
#define ATT_LOAD_K(KR, t) do { const bf16_t* bp_ = proj + (size_t)(ATT_ROW0(t) + lrow) * INW + lch * 8 + u.kcol; asm volatile("" : "+v"(bp_)); _Pragma("unroll") for (int i_ = 0; i_ < 8; ++i_) KR[i_] = *(const u32x4*)(bp_ + (size_t)i_ * 8 * INW); } while (0)
#define ATT_LOAD_V(t) do { const bf16_t* bp_ = proj + (size_t)(ATT_ROW0(t) + lrow) * INW + lch * 8 + u.vcol; asm volatile("" : "+v"(bp_)); _Pragma("unroll") for (int i_ = 0; i_ < 8; ++i_) vreg[i_] = *(const u32x4*)(bp_ + (size_t)i_ * 8 * INW); } while (0)
    ATT_LOAD_K(kreg, 0); ATT_LOAD_V(0); ATT_LOAD_K(kreg2, 1);
    LAS unsigned char* kw = wl + lrow * KROWB + lch * 16;
    LAS unsigned char* vw = wl + WL_V + lrow * VROWB + lch * 16;
    LAS const unsigned char* kf = wl + r32 * KROWB + hi * 16;
    LAS const unsigned char* vf = wl + WL_V + (4 * hi + ((lane & 15) >> 2)) * VROWB + ((lane >> 4) & 1) * 32 + (lane & 3) * 8;
#define ATT_STEP(KR, T) do { const int tt_ = (T); \
_Pragma("unroll") \
        for (int i = 0; i < 8; ++i) { *(LAS u32x4*)(kw + i * 8 * KROWB) = KR[i]; *(LAS u32x4*)(vw + i * 8 * VROWB) = vreg[i]; } \
        if (tt_ + 2 < nt) ATT_LOAD_K(KR, tt_ + 2); if (tt_ + 1 < nt) ATT_LOAD_V(tt_ + 1); \
        f32x16 p0, p1; \
_Pragma("unroll") \
        for (int r = 0; r < 16; ++r) { p0[r] = 0.f; p1[r] = 0.f; } \
_Pragma("unroll") \
        for (int d0 = 0; d0 < 4; ++d0) { \
            const bf16x8 a0 = *(LAS const bf16x8*)(kf + d0 * 32), a1 = *(LAS const bf16x8*)(kf + 32 * KROWB + d0 * 32); \
            p0 = __builtin_amdgcn_mfma_f32_32x32x16_bf16(a0, qr[d0], p0, 0, 0, 0); \
            p1 = __builtin_amdgcn_mfma_f32_32x32x16_bf16(a1, qr[d0], p1, 0, 0, 0); \
        } \
        if (KIND == 0) { if (tt_ >= 4) { \
            const int dr = u.a0 + (tt_ - 4), qc = u.a1 + r32; const int cs = min(max(qc - 8, 0), 48); \
            const int kb = 4 * hi - cs; const volatile LAS float* tb = tab + dr * 32 + 15 - qc + 4 * hi; \
_Pragma("unroll") \
            for (int r = 0; r < 16; ++r) { const int kc = (r & 3) + 8 * (r >> 2); const float b0_ = tb[kc]; p0[r] = ((unsigned)(kb + kc) < 16u) ? p0[r] + b0_ : NEGBIG; } \
            _Pragma("unroll") \
            for (int r = 0; r < 16; ++r) { const int kc = (r & 3) + 8 * (r >> 2); const float b1_ = tb[kc + 32]; p1[r] = ((unsigned)(kb + kc + 32) < 16u) ? p1[r] + b1_ : NEGBIG; } } } \
        if (KIND == 1) { const int tb0_ = u.a0 + 64 * (tt_ - 4); \
          if (tt_ >= 4 && (tb0_ < -97 || tb0_ > 65)) { \
            const int d0_ = tb0_ + 4 * hi - r32 + 128; \
_Pragma("unroll") \
            for (int r = 0; r < 16; ++r) { const int kc = (r & 3) + 8 * (r >> 2); \
                p0[r] = ((unsigned)(d0_ + kc) <= 256u) ? p0[r] : NEGBIG; \
                p1[r] = ((unsigned)(d0_ + kc + 32) <= 256u) ? p1[r] : NEGBIG; } } } \
        if (u.negc != 0.f) { \
_Pragma("unroll") \
            for (int r = 0; r < 16; ++r) { p0[r] += u.negc; p1[r] += u.negc; } } \
        float rs = 0.f; \
_Pragma("unroll") \
        for (int r = 0; r < 16; ++r) { p0[r] = __builtin_amdgcn_exp2f(p0[r]); p1[r] = __builtin_amdgcn_exp2f(p1[r]); rs += p0[r] + p1[r]; } \
        l += rs; \
        u32x4 pa[4]; \
_Pragma("unroll") \
        for (int j = 0; j < 4; ++j) { pa[0][j] = cvtpk(p0[2 * j], p0[2 * j + 1]); pa[1][j] = cvtpk(p0[8 + 2 * j], p0[8 + 2 * j + 1]); pa[2][j] = cvtpk(p1[2 * j], p1[2 * j + 1]); pa[3][j] = cvtpk(p1[8 + 2 * j], p1[8 + 2 * j + 1]); } \
_Pragma("unroll") \
        for (int ks = 0; ks < 4; ++ks) { \
            const s16x4 l0 = vtr(vf + ks * 16 * VROWB), h0 = vtr(vf + ks * 16 * VROWB + 8 * VROWB); \
            const s16x4 l1 = vtr(vf + ks * 16 * VROWB + 64), h1 = vtr(vf + ks * 16 * VROWB + 8 * VROWB + 64); \
            const bf16x8 b0 = (bf16x8){l0[0], l0[1], l0[2], l0[3], h0[0], h0[1], h0[2], h0[3]}, b1 = (bf16x8){l1[0], l1[1], l1[2], l1[3], h1[0], h1[1], h1[2], h1[3]}; \
            o0 = __builtin_amdgcn_mfma_f32_32x32x16_bf16(__builtin_bit_cast(bf16x8, pa[ks]), b0, o0, 0, 0, 0); \
            o1 = __builtin_amdgcn_mfma_f32_32x32x16_bf16(__builtin_bit_cast(bf16x8, pa[ks]), b1, o1, 0, 0, 0); \
        } \
    } while (0)
    for (int t = 0; t < nt; t += 2) {
        ATT_STEP(kreg, t);
        if (t + 1 < nt) ATT_STEP(kreg2, t + 1);
    }
#undef ATT_STEP
#undef ATT_LOAD_K
#undef ATT_LOAD_V
#undef ATT_ROW0
    const float lt = pg8::sum_halves(l);
    if (hi == 0) sc[r32] = 1.0f / lt;
    int hi_o = hi; asm volatile("" : "+v"(hi_o));
    bf16_t* ob = obuf + (size_t)u.qrow0 * DM + u.ocol + r32;
#pragma unroll
    for (int g = 0; g < 4; ++g) { const f32x4 a = *(LAS const f32x4*)(sc + 8 * g + 4 * hi);
#pragma unroll
        for (int i = 0; i < 4; ++i) { const int q = i + 8 * g + 4 * hi_o; bf16_t* op = ob + (size_t)q * DM;
            op[0] = (bf16_t)f2bf(o0[4 * g + i] * a[i]); op[32] = (bf16_t)f2bf(o1[4 * g + i] * a[i]); } }
}

__device__ __forceinline__ void attn_phase(LAS unsigned char* wl, const bf16_t* proj, bf16_t* obuf, const float* rpb_l, const float* sink_l, const float* cb_l, bool with_ctx, int gw, int ngw, int lane) {
    const float cb_na = fmaxf(cb_l[0] - 64.f, 0.f), cb_wa = fmaxf(cb_l[1] - 64.f, 0.f);
    const int total = 2048 + 4096 + (with_ctx ? 768 : 0);
    for (int i0 = gw; i0 < total; i0 += ngw) {
        int i = i0; AU u;
        if (i < 2048) {
            const int half = i & 1, h = (i >> 1) & 3, r = (i >> 3) & 31, b = i >> 8; const int rs = min(max(r - 4, 0), 24);
            u.qrow0 = b * SEQ + r * 64 + 32 * half; u.qcol = 64 * h; u.kcol = 256 + 64 * h; u.vcol = 512 + 64 * h; u.ocol = 64 * h; u.ctxrow0 = MLAT + b * CTXL;
            u.nloc = 8; u.locrow0 = b * SEQ + rs * 64; u.a0 = rs - r + 7; u.a1 = 32 * half; u.negc = -cb_na; u.l0 = 0.f; u.rpb = rpb_l + h * (15 * 31);
            attn_unit<0>(wl, proj, obuf, u, lane);
            continue;
        }
        i -= 2048;
        if (i < 4096) {
            const int ch = i & 63, h = (i >> 6) & 7, b = i >> 9; const int qpos0 = 32 * ch;
            const int kt0 = max(0, (qpos0 - 128) >> 6), kt1 = min(31, (qpos0 + 159) >> 6);
            u.qrow0 = b * SEQ + qpos0; u.qcol = 1536 + 64 * h; u.kcol = 2048 + 64 * (h >> 2); u.vcol = 2176 + 64 * (h >> 2); u.ocol = 512 + 64 * h; u.ctxrow0 = MLAT + b * CTXL;
            u.nloc = kt1 - kt0 + 1; u.locrow0 = b * SEQ + 64 * kt0; u.a0 = 64 * kt0 - qpos0; u.a1 = 0; u.negc = -cb_wa; u.l0 = __builtin_amdgcn_exp2f(sink_l[h] * LOG2E - cb_wa); u.rpb = nullptr;
            attn_unit<1>(wl, proj, obuf, u, lane);
            continue;
        }
        i -= 4096;
        if (i < 256) {
            const int ch = i & 7, h = (i >> 3) & 3, b = i >> 5;
            u.qrow0 = MLAT + b * CTXL + 32 * ch; u.qcol = 64 * h; u.kcol = 256 + 64 * h; u.vcol = 512 + 64 * h; u.ocol = 64 * h; u.negc = -cb_na; u.l0 = 0.f; u.ctxrow0 = MLAT + b * CTXL;
        } else {
            i -= 256; const int ch = i & 7, h = (i >> 3) & 7, b = i >> 6;
            u.qrow0 = MLAT + b * CTXL + 32 * ch; u.qcol = 1536 + 64 * h; u.kcol = 2048 + 64 * (h >> 2); u.vcol = 2176 + 64 * (h >> 2); u.ocol = 512 + 64 * h; u.negc = -cb_wa; u.l0 = __builtin_amdgcn_exp2f(sink_l[h] * LOG2E - cb_wa); u.ctxrow0 = MLAT + b * CTXL;
        }
        u.nloc = 0; u.locrow0 = 0; u.a0 = 0; u.a1 = 0; u.rpb = nullptr;
        attn_unit<2>(wl, proj, obuf, u, lane);
    }
}
}

__device__ __forceinline__ void prep_pass(const float* __restrict__ xlat, const float* __restrict__ xctx, const float* __restrict__ g, const float* __restrict__ modl, int scoff, bf16_t* __restrict__ hn, float* __restrict__ rs, int m_begin, int m_end, int m_step, int lane) {
#pragma unroll 2
    for (int m = m_begin; m < m_end; m += m_step) {
        const bool lat = m < MLAT; const float* xr = lat ? xlat + (size_t)m * DM : xctx + (size_t)(m - MLAT) * DM; const int b = lat ? (m >> 11) : 8;
        f32x4 v[4]; float ss = 0.f;
#pragma unroll
        for (int j = 0; j < 4; ++j) { v[j] = *(const f32x4*)(xr + 4 * lane + 256 * j); ss += (v[j][0] * v[j][0] + v[j][1] * v[j][1]) + (v[j][2] * v[j][2] + v[j][3] * v[j][3]); }
        ss = wave_sum(ss);
        if (lane < 16) rs[(size_t)m * 16 + lane] = (lane == 0) ? ss : 0.f;
        const float* mb = modl + (size_t)b * MODW;
#pragma unroll
        for (int j = 0; j < 4; ++j) { const int c = 4 * lane + 256 * j;
            const f32x4 gg = *(const f32x4*)(g + c), scv = *(const f32x4*)(mb + scoff + c);
            const f32x4 y = v[j] * gg * (scv + 1.0f);
            u32x2 w; w.x = pk2(y[0], y[1]); w.y = pk2(y[2], y[3]);
            *(u32x2*)(hn + (size_t)m * DM + c) = w; }
    }
}
__device__ __forceinline__ void ctx_rows_pass(const unsigned char* ws, const float* ctxbuf, const float* gate, const float* gn, const float* scn, bf16_t* hn2, float* rs, int gw, int ngw, int lane) {
    for (int r = gw; r < MCTX; r += ngw) {
        const int pmc = r >> 8, rl = r & 255; f32x4 x[4]; float ss = 0.f;
#pragma unroll
        for (int j = 0; j < 4; ++j) { const int c = 4 * lane + 256 * j; f32x4 p = {0.f, 0.f, 0.f, 0.f};
#pragma unroll
            for (int ks = 0; ks < 3; ++ks) p += *(const f32x4*)((const float*)(ws + pg8::slab_off((pmc * 4 + j) * 3 + ks)) + (size_t)rl * 256 + 4 * lane);
            x[j] = *(const f32x4*)(ctxbuf + (size_t)r * DM + c) + *(const f32x4*)(gate + c) * p;
            ss += (x[j][0] * x[j][0] + x[j][1] * x[j][1]) + (x[j][2] * x[j][2] + x[j][3] * x[j][3]); }
        ss = wave_sum(ss);
        const int m = MLAT + r;
        if (lane < 16) rs[(size_t)m * 16 + lane] = (lane == 0) ? ss : 0.f;
#pragma unroll
        for (int j = 0; j < 4; ++j) { const int c = 4 * lane + 256 * j;
            const f32x4 y = x[j] * (*(const f32x4*)(gn + c)) * (*(const f32x4*)(scn + c) + 1.0f);
            u32x2 w; w.x = pk2(y[0], y[1]); w.y = pk2(y[2], y[3]);
            *(u32x2*)(hn2 + (size_t)m * DM + c) = w; }
    }
}

__device__ __forceinline__ void mix_pass(const bf16_t* __restrict__ proj, const bf16_t* __restrict__ obuf, const float* __restrict__ convw, const float* __restrict__ convb, const float* __restrict__ gout, bf16_t* __restrict__ abuf, int nrows, int gw, int ngw, int lane) {
#pragma unroll 2
    for (int m = gw; m < nrows; m += ngw) {
        float va[8];
        if (lane < 32) {
            const u32x4 raw = *(const u32x4*)(obuf + (size_t)m * DM + 8 * lane);
#pragma unroll
            for (int j = 0; j < 4; ++j) { va[2 * j] = bf_lo(raw[j]); va[2 * j + 1] = bf_hi(raw[j]); }
        } else {
            const int c = 8 * (lane - 32); const bool lat = m < MLAT; const int t = lat ? (m & (SEQ - 1)) : ((m - MLAT) & (CTXL - 1)); const int L = lat ? SEQ : CTXL;
            const bf16_t* pr = proj + (size_t)m * INW;
            const u32x4 cx = *(const u32x4*)(pr + 768 + c), cb = *(const u32x4*)(pr + 1024 + c), cc = *(const u32x4*)(pr + 1280 + c);
            u32x4 pxm = {0u, 0u, 0u, 0u}, pcm = {0u, 0u, 0u, 0u}, pxp = {0u, 0u, 0u, 0u}, pcp = {0u, 0u, 0u, 0u};
            if (t > 0) { pxm = *(const u32x4*)(pr - INW + 768 + c); pcm = *(const u32x4*)(pr - INW + 1280 + c); }
            if (t < L - 1) { pxp = *(const u32x4*)(pr + INW + 768 + c); pcp = *(const u32x4*)(pr + INW + 1280 + c); }
            const f32x4 w0a = *(const f32x4*)(convw + c), w0b = *(const f32x4*)(convw + c + 4), w1a = *(const f32x4*)(convw + 256 + c), w1b = *(const f32x4*)(convw + 256 + c + 4),
                        w2a = *(const f32x4*)(convw + 512 + c), w2b = *(const f32x4*)(convw + 512 + c + 4), bba = *(const f32x4*)(convb + c), bbb = *(const f32x4*)(convb + c + 4);
#pragma unroll
            for (int j = 0; j < 4; ++j) {
                const float w0l = j < 2 ? w0a[2 * j] : w0b[2 * j - 4], w0h = j < 2 ? w0a[2 * j + 1] : w0b[2 * j - 3];
                const float w1l = j < 2 ? w1a[2 * j] : w1b[2 * j - 4], w1h = j < 2 ? w1a[2 * j + 1] : w1b[2 * j - 3];
                const float w2l = j < 2 ? w2a[2 * j] : w2b[2 * j - 4], w2h = j < 2 ? w2a[2 * j + 1] : w2b[2 * j - 3];
                const float bl = j < 2 ? bba[2 * j] : bbb[2 * j - 4], bh = j < 2 ? bba[2 * j + 1] : bbb[2 * j - 3];
                const float ul = bf_lo(cc[j]) * bf_lo(cx[j]), uh = bf_hi(cc[j]) * bf_hi(cx[j]);
                const float uml = bf_lo(pcm[j]) * bf_lo(pxm[j]), umh = bf_hi(pcm[j]) * bf_hi(pxm[j]);
                const float upl = bf_lo(pcp[j]) * bf_lo(pxp[j]), uph = bf_hi(pcp[j]) * bf_hi(pxp[j]);
                va[2 * j] = bf_lo(cb[j]) * (bl + w0l * uml + w1l * ul + w2l * upl);
                va[2 * j + 1] = bf_hi(cb[j]) * (bh + w0h * umh + w1h * uh + w2h * uph);
            }
        }
        float ssa = 0.f;
#pragma unroll
        for (int j = 0; j < 8; ++j) ssa += va[j] * va[j];
        ssa = half_sum(ssa); const float rsa = 1.0f / sqrtf(ssa * (1.0f / 256.0f) + EPSN);
        { const f32x4 g0 = *(const f32x4*)(gout + 8 * lane), g1 = *(const f32x4*)(gout + 8 * lane + 4);
          u32x4 w; w.x = pk2(va[0] * rsa * g0[0], va[1] * rsa * g0[1]); w.y = pk2(va[2] * rsa * g0[2], va[3] * rsa * g0[3]); w.z = pk2(va[4] * rsa * g1[0], va[5] * rsa * g1[1]); w.w = pk2(va[6] * rsa * g1[2], va[7] * rsa * g1[3]);
          *(u32x4*)(abuf + (size_t)m * DM + 8 * lane) = w; }
        float vb[8];
        { const u32x4 raw = *(const u32x4*)(obuf + (size_t)m * DM + 512 + 8 * lane);
#pragma unroll
          for (int j = 0; j < 4; ++j) { vb[2 * j] = bf_lo(raw[j]); vb[2 * j + 1] = bf_hi(raw[j]); } }
        float ssb = 0.f;
#pragma unroll
        for (int j = 0; j < 8; ++j) ssb += vb[j] * vb[j];
        ssb = wave_sum(ssb); const float rsb = 1.0f / sqrtf(ssb * (1.0f / 512.0f) + EPSN);
        { const f32x4 g0 = *(const f32x4*)(gout + 512 + 8 * lane), g1 = *(const f32x4*)(gout + 512 + 8 * lane + 4);
          u32x4 w; w.x = pk2(vb[0] * rsb * g0[0], vb[1] * rsb * g0[1]); w.y = pk2(vb[2] * rsb * g0[2], vb[3] * rsb * g0[3]); w.z = pk2(vb[4] * rsb * g1[0], vb[5] * rsb * g1[1]); w.w = pk2(vb[6] * rsb * g1[2], vb[7] * rsb * g1[3]);
          *(u32x4*)(abuf + (size_t)m * DM + 512 + 8 * lane) = w; }
    }
}

__device__ __forceinline__ void mod_item(int item, const float* c, const float* cctx, const float* wmod, const float* bmod, float* mod, LAS unsigned char* lds, int tid, int wave, int lane) {
    LAS float* sl = (LAS float*)lds;
    LAS float* red = (LAS float*)(lds + 9 * 1024 * 4);
    const int l = item / 96, n0 = (item % 96) * 64;
    for (int i = tid; i < 9 * 1024; i += 512) { const int r = i >> 10, k = i & 1023; const float v = r < 8 ? c[r * 1024 + k] : cctx[k]; sl[i] = v / (1.0f + __expf(-v)); }
    __syncthreads();
    float acc[9];
#pragma unroll
    for (int r = 0; r < 9; ++r) acc[r] = 0.f;
    const float* wp = wmod + ((size_t)l * 1024 + wave * 128) * MODW + n0 + lane;
#pragma unroll 4
    for (int k = 0; k < 128; k += 4) {
        const float w0 = wp[(size_t)k * MODW], w1 = wp[(size_t)(k + 1) * MODW], w2 = wp[(size_t)(k + 2) * MODW], w3 = wp[(size_t)(k + 3) * MODW];
#pragma unroll
        for (int r = 0; r < 9; ++r) { const f32x4 s4 = *(LAS const f32x4*)(sl + r * 1024 + wave * 128 + k); acc[r] += (s4[0] * w0 + s4[1] * w1) + (s4[2] * w2 + s4[3] * w3); } }
#pragma unroll
    for (int r = 0; r < 9; ++r) red[(wave * 9 + r) * 64 + lane] = acc[r];
    __syncthreads();
    for (int i = tid; i < 9 * 64; i += 512) { const int r = i >> 6, ln = i & 63; float s = bmod[l * MODW + n0 + ln];
#pragma unroll
        for (int w = 0; w < 8; ++w) s += red[(w * 9 + r) * 64 + ln];
        mod[((size_t)l * 9 + r) * MODW + n0 + ln] = s; }
    __syncthreads();
}
__device__ __forceinline__ int rowmap_in(int c) {
    const int pn = c >> 8; if (pn >= 2 && pn <= 5) return c;
    const int wc = (c >> 6) & 3, d = c & 63, bj = d >> 5; const bool vhead = (pn == 8) && (wc >= 2);
    int n, fq; const int e = d & 3;
    if (!vhead) { n = (d >> 4) & 1; fq = (d >> 2) & 3; } else { fq = (d >> 3) & 3; n = (d >> 2) & 1; }
    return pn * 256 + bj * 128 + wc * 32 + fq * 8 + n * 4 + e;
}
template <bool MAPIN> __device__ __forceinline__ void bias_item(const float* W, int ldw, int n0, const float* shrows  , float* out  , LAS unsigned char* lds, int tid, int wave, int lane) {
    LAS float* sl = (LAS float*)lds;
    LAS float* red = (LAS float*)(lds + 9 * 1024 * 4);
    for (int i = tid; i < 9 * 1024; i += 512) { const int r = i >> 10, k = i & 1023; sl[i] = shrows[(size_t)r * MODW + k]; }
    __syncthreads();
    float acc[9];
#pragma unroll
    for (int r = 0; r < 9; ++r) acc[r] = 0.f;
    const float* wp = W + (size_t)(wave * 128) * ldw + n0 + lane;
#pragma unroll 4
    for (int k = 0; k < 128; k += 4) {
        const float w0 = wp[(size_t)k * ldw], w1 = wp[(size_t)(k + 1) * ldw], w2 = wp[(size_t)(k + 2) * ldw], w3 = wp[(size_t)(k + 3) * ldw];
#pragma unroll
        for (int r = 0; r < 9; ++r) { const f32x4 s4 = *(LAS const f32x4*)(sl + r * 1024 + wave * 128 + k); acc[r] += (s4[0] * w0 + s4[1] * w1) + (s4[2] * w2 + s4[3] * w3); } }
#pragma unroll
    for (int r = 0; r < 9; ++r) red[(wave * 9 + r) * 64 + lane] = acc[r];
    __syncthreads();
    for (int i = tid; i < 9 * 64; i += 512) { const int r = i >> 6, ln = i & 63; float s = 0.f;
#pragma unroll
        for (int w = 0; w < 8; ++w) s += red[(w * 9 + r) * 64 + ln];
        const int n = n0 + ln; out[(size_t)r * ldw + (MAPIN ? rowmap_in(n) : n)] = s; }
    __syncthreads();
}
template <bool MAPIN> __device__ __forceinline__ void transpose_item(const float* W, int K, int N, bf16_t* WT, LAS float* scr, int item, int lane) {
    const int nblk = N / 32, kb = item / nblk, nb = item % nblk, k0 = 64 * kb, n0 = 32 * nb;
#pragma unroll
    for (int i = 0; i < 32; ++i) { const int kk = 2 * i + (lane >> 5); scr[kk * 33 + (lane & 31)] = W[(size_t)(k0 + kk) * N + n0 + (lane & 31)]; }
    asm volatile("s_waitcnt lgkmcnt(0)" ::: "memory");
    const int c = lane & 7;
#pragma unroll
    for (int j = 0; j < 4; ++j) { const int n = (lane >> 3) + 8 * j; const LAS float* s = scr + (8 * c) * 33 + n;
        u32x4 o; o.x = pk2(s[0 * 33], s[1 * 33]); o.y = pk2(s[2 * 33], s[3 * 33]); o.z = pk2(s[4 * 33], s[5 * 33]); o.w = pk2(s[6 * 33], s[7 * 33]);
        const int orow = MAPIN ? rowmap_in(n0 + n) : (n0 + n);
        *(u32x4*)(WT + (size_t)orow * K + k0 + 8 * c) = o; }
    asm volatile("s_waitcnt lgkmcnt(0)" ::: "memory");
}

#define XB_TMO      128
#define XB_XCNT(j)  (256  + 64 * (j))
#define XB_XSUB(j)  (1280 + 64 * (j))
#define XB_XGEN(j)  (2304 + 64 * (j))
#define XB_TOP      3328
#define XB_TOPGEN   3392
#define XCD_BAR_WORDS 3456
#define XB_SPIN_CAP (1u << 18)

__device__ __forceinline__ unsigned xb_ld(unsigned* p)              { return __hip_atomic_load(p, __ATOMIC_RELAXED, __HIP_MEMORY_SCOPE_AGENT); }
__device__ __forceinline__ unsigned xb_add(unsigned* p, unsigned v) { return __hip_atomic_fetch_add(p, v, __ATOMIC_RELAXED, __HIP_MEMORY_SCOPE_AGENT); }
__device__ __forceinline__ unsigned xb_xcc_id() { return (unsigned)__builtin_amdgcn_s_getreg((3 << 11) | 20) & 0xFu; }
#define XB_SPIN(cond, bar) do { unsigned _sp = 0; while (cond) { __builtin_amdgcn_s_sleep(1); \
    if ((++_sp & 255u) == 0u) { if (xb_ld(&(bar)[XB_TMO])) break; if (_sp > XB_SPIN_CAP) { atomicAdd(&(bar)[XB_TMO], 1u); break; } } } } while (0)

struct XcdBarrier {
    unsigned* bar; unsigned x; bool t0;
    volatile LAS unsigned* st;
};

__device__ __forceinline__ XcdBarrier xcd_barrier_post(unsigned* bar, volatile LAS unsigned* st) {
    XcdBarrier b; b.bar = bar; b.x = xb_xcc_id(); b.st = st; b.t0 = (threadIdx.x == 0);
    if (threadIdx.x == 0) (void)xb_add(&bar[XB_XCNT(b.x)], 1u);
    return b;
}
__device__ __forceinline__ void xcd_barrier_complete(unsigned* bar, unsigned x, unsigned& nloc, unsigned& nx) {
    const unsigned G = gridDim.x * gridDim.y * gridDim.z;
    unsigned sum, cnt, mine, sp = 0u;
    for (;;) {
        sum = 0u; cnt = 0u; mine = 0u;
#pragma unroll
        for (unsigned j = 0; j < 16; ++j) { const unsigned c = xb_ld(&bar[XB_XCNT(j)]); sum += c; cnt += (c > 0u) ? 1u : 0u; mine = (j == x) ? c : mine; }
        if (sum == G) break;
        __builtin_amdgcn_s_sleep(1);
        if ((++sp & 255u) == 0u) { if (xb_ld(&bar[XB_TMO])) break; if (sp > XB_SPIN_CAP) { atomicAdd(&bar[XB_TMO], 1u); break; } }
    }
    nloc = mine > 0u ? mine : 1u; nx = cnt > 0u ? cnt : 1u;
}

__device__ __forceinline__ void xcd_barrier(const XcdBarrier& b) {
    asm volatile("s_waitcnt vmcnt(0)" ::: "memory");
    __syncthreads();
    if (b.t0) {
        unsigned* bar = b.bar;
        __builtin_amdgcn_s_waitcnt(0);
        unsigned nloc = b.st[0], nx = b.st[1];
        if (nloc == 0u) { xcd_barrier_complete(bar, b.x, nloc, nx); b.st[0] = nloc; b.st[1] = nx; }
        const unsigned old = xb_add(&bar[XB_XSUB(b.x)], 1u);
        const unsigned gen = old / nloc;
        if (old + 1u == (gen + 1u) * nloc) {
            __builtin_amdgcn_fence(__ATOMIC_RELEASE, "agent");
            asm volatile("s_waitcnt vmcnt(0)" ::: "memory");
            const unsigned og = xb_add(&bar[XB_TOP], 1u);
            const unsigned tg = og / nx;
            if (og + 1u == (tg + 1u) * nx) xb_add(&bar[XB_TOPGEN], 1u);
            else XB_SPIN(xb_ld(&bar[XB_TOPGEN]) == tg, bar);
            __builtin_amdgcn_fence(__ATOMIC_ACQUIRE, "agent");
            xb_add(&bar[XB_XGEN(b.x)], 1u);
            asm volatile("s_waitcnt vmcnt(0)" ::: "memory");
        } else {
            XB_SPIN(xb_ld(&bar[XB_XGEN(b.x)]) == gen, bar);
            __builtin_amdgcn_fence(__ATOMIC_ACQUIRE, "agent");
            asm volatile("s_waitcnt vmcnt(0)" ::: "memory");
        }
    }
    __syncthreads();
}

constexpr int LDS_ST_OFF = 8 * att::WAVE_LDS + 512;
constexpr int LDS_BYTES = LDS_ST_OFF + 64;
static_assert(LDS_BYTES <= 160 * 1024 && LDS_BYTES >= pg8::STAGE_BYTES, "LDS budget");
constexpr int N_PHASES = 15;
struct Params { const float* in[21]; float* out; unsigned char* ws; int ph_lo, ph_hi; };

#ifndef REPMASK
#define REPMASK 0
#endif
#ifndef DRYMASK
#define DRYMASK 0
#endif
#define DRY(k) ((((DRYMASK) >> (k)) & 1) && rep_ == 0)
#ifndef PROBE_PHASE
#define PROBE_PHASE (-1)
#endif
#define PROBE_MULT 8
#ifndef EXTRA_SYNC
#define EXTRA_SYNC 0
#endif
__global__ void __launch_bounds__(512, 2) fwd_kernel(Params P) {
    extern __shared__ __attribute__((aligned(16))) unsigned char lds_raw[];
    LAS unsigned char* lds = (LAS unsigned char*)lds_raw;
    {   volatile LAS unsigned* bst0 = (volatile LAS unsigned*)(lds + LDS_ST_OFF);
        if (threadIdx.x < 16) bst0[threadIdx.x] = 0u;
        __syncthreads();
        (void)xcd_barrier_post((unsigned*)(P.ws + WS_BAR), bst0); }
#define GRID_SYNC() do { unsigned* bp_ = (unsigned*)(P.ws + WS_BAR); asm volatile("" : "+s"(bp_)); XcdBarrier b_; b_.bar = bp_; b_.x = xb_xcc_id(); b_.st = (volatile LAS unsigned*)(lds + LDS_ST_OFF); b_.t0 = (wave == 0) && (pg8::lane_id() == 0); xcd_barrier(b_); } while (0)
#define LANE_OPAQUE int ln_ = pg8::lane_id(); asm volatile("" : "+v"(ln_)); const int tid_ = wave * 64 + ln_; (void)tid_
#define WSP(T, off) ((T*)(ws + (off)))
#define MODL (WSP(const float, WS_MOD) + (size_t)ly * 9 * MODW)
#define XL ((ly == 0) ? P.in[0] : (const float*)P.out)
#define CL ((ly == 0) ? P.in[2] : WSP(const float, WS_CTX))
#define MROWS ((ly == 0) ? MALL : MLAT)
    const int ph_hi = P.ph_hi;
    const int wave = __builtin_amdgcn_readfirstlane(threadIdx.x >> 6);
#pragma unroll 1
    for (int ph = P.ph_lo; ph < ph_hi; ++ph) {
        int phv = ph; asm volatile("" : "+s"(phv));
        const __attribute__((address_space(4))) Params* pp_ = (const __attribute__((address_space(4))) Params*)__builtin_amdgcn_kernarg_segment_ptr(); asm volatile("" : "+s"(pp_));
#define P (*pp_)
        int kind = 0, ly = 0;
        if (phv >= 1) { const int idx = phv - 1; if (idx < 8) { kind = idx + 1 + (idx >= 5 ? 1 : 0); } else { const int j = idx - 8; ly = 1; kind = j + 2 + (j >= 4 ? 1 : 0); } }
        int G_ = gridDim.x, bx_ = blockIdx.x; asm volatile("" : "+s"(G_), "+s"(bx_));
        const int G = G_, bx = bx_; const int vcu = (G % 8 == 0) ? (bx % 8) * (G / 8) + bx / 8 : bx; const int gw = vcu * 8 + wave, ngw = G * 8;
        unsigned char* ws = P.ws;
        if (PROBE_PHASE >= 0 && ph == PROBE_PHASE && blockIdx.x == 0 && wave == 0 && pg8::lane_id() == 0) { const unsigned long long t_ = __builtin_amdgcn_s_memrealtime(); volatile LAS unsigned* pw_ = (volatile LAS unsigned*)(lds + LDS_ST_OFF + 32); pw_[0] = (unsigned)t_; pw_[1] = (unsigned)(t_ >> 32); }
#pragma unroll 1
        for (int rep_ = 0; rep_ <= (((REPMASK | DRYMASK) >> kind) & 1); ++rep_) {
        if (rep_) GRID_SYNC();
        switch (kind) {
        case 0: { LANE_OPAQUE;
            if (bx == G - 1) {
                LAS unsigned* red = (LAS unsigned*)lds;
                if (tid_ < 16) red[tid_] = 0u;
                __syncthreads();
                for (int l2 = 0; l2 < 2; ++l2) {
                    if (tid_ < 256) { const int k = tid_ >> 6, d = tid_ & 63; const float* src = P.in[k == 0 ? 9 : k == 1 ? 10 : k == 2 ? 14 : 15]; atomicMax((unsigned*)(red + l2 * 5 + k), __builtin_bit_cast(unsigned, fabsf(src[l2 * 64 + d]))); }
                    for (int i = tid_; i < 4 * 15 * 31; i += 512) atomicMax((unsigned*)(red + l2 * 5 + 4), __builtin_bit_cast(unsigned, fabsf(P.in[11][(size_t)l2 * 4 * 15 * 31 + i])));
                }
                __syncthreads();
                if (tid_ < 2) { const int l2 = tid_; const float gq = __builtin_bit_cast(float, red[l2 * 5 + 0]), gk = __builtin_bit_cast(float, red[l2 * 5 + 1]), wq = __builtin_bit_cast(float, red[l2 * 5 + 2]), wk = __builtin_bit_cast(float, red[l2 * 5 + 3]), rb = __builtin_bit_cast(float, red[l2 * 5 + 4]);
                    WSP(float, WS_GAIN)[512 + 2 * l2] = 11.5416f * gq * gk + rb * LOG2E + 0.25f; WSP(float, WS_GAIN)[512 + 2 * l2 + 1] = 11.5416f * wq * wk + 0.25f; }
                __syncthreads();
            }
            if (bx == G - 1) { for (int i = tid_; i < 512; i += 512) { const int l2 = i >> 8, k = (i >> 6) & 3, d = i & 63; const float* src = P.in[k == 0 ? 9 : k == 1 ? 10 : k == 2 ? 14 : 15]; WSP(float, WS_GAIN)[i] = src[l2 * 64 + d]; } }
            if (bx < 192) mod_item(bx, P.in[1], P.in[3], P.in[4], P.in[5], WSP(float, WS_MOD), lds, tid_, wave, ln_);
            LAS float* scr = (LAS float*)(lds + wave * 16384);
            constexpr int I_IN = 16 * (INW / 32), I_O = 16 * (DM / 32), I_1 = 16 * (FFN / 32), I_2 = 64 * (DM / 32), I_L = I_IN + I_O + I_1 + I_2;
            const bool bal_ = (G == 256); const int it0 = bal_ ? ((bx < 192) ? 33 * bx : 6336 + 81 * (bx - 192)) + wave : gw, it1 = bal_ ? ((bx < 192) ? 33 * bx + 33 : 6336 + 81 * (bx - 192) + 81) : 2 * I_L, its = bal_ ? 8 : ngw;
            static_assert(192 * 33 + 64 * 81 == 2 * I_L, "transpose item split");
            for (int it = it0; it < it1; it += its) {
                const int l2 = it / I_L; int r = it - l2 * I_L;
                if (r < I_IN) { transpose_item<true>(P.in[8] + (size_t)l2 * DM * INW, DM, INW, WSP(bf16_t, WS_WIN) + (size_t)l2 * INW * DM, scr, r, ln_); continue; } r -= I_IN;
                if (r < I_O) { transpose_item<false>(P.in[18] + (size_t)l2 * DM * DM, DM, DM, WSP(bf16_t, WS_WO) + (size_t)l2 * DM * DM, scr, r, ln_); continue; } r -= I_O;
                if (r < I_1) { transpose_item<false>(P.in[19] + (size_t)l2 * DM * FFN, DM, FFN, WSP(bf16_t, WS_W1) + (size_t)l2 * FFN * DM, scr, r, ln_); continue; } r -= I_1;
                transpose_item<false>(P.in[20] + (size_t)l2 * FFN * DM, FFN, DM, WSP(bf16_t, WS_W2) + (size_t)l2 * DM * FFN, scr, r, ln_);
            }
        } break;
        case 1: { LANE_OPAQUE;
            for (int it = bx; it < 200; it += G) { const int l2 = it / 100, c = it % 100; const float* m2 = WSP(const float, WS_MOD) + (size_t)l2 * 9 * MODW;
                if (c < 36) bias_item<true>(P.in[8] + (size_t)l2 * DM * INW, INW, c * 64, m2, WSP(float, WS_BIN) + (size_t)l2 * 9 * INW, lds, tid_, wave, ln_);
                else bias_item<false>(P.in[19] + (size_t)l2 * DM * FFN, FFN, (c - 36) * 64, m2 + 3 * DM, WSP(float, WS_B1) + (size_t)l2 * 9 * FFN, lds, tid_, wave, ln_); }
            if (G == 256) { const int rb = (bx < 200) ? 59 * bx : min(MALL, 11800 + 119 * (bx - 200)), re = (bx < 200) ? rb + 59 : min(MALL, rb + 119);
                prep_pass(P.in[0], P.in[2], P.in[6], WSP(const float, WS_MOD), DM, WSP(bf16_t, WS_HN2), WSP(float, WS_RS1), rb + wave, re, 8, ln_); }
            else prep_pass(P.in[0], P.in[2], P.in[6], WSP(const float, WS_MOD), DM, WSP(bf16_t, WS_HN2), WSP(float, WS_RS1), gw, MALL, ngw, ln_);
        } break;
        case 2: { LANE_OPAQUE;
            pg8::Gemm g{WSP(bf16_t, WS_HN2), WSP(bf16_t, WS_WIN) + (size_t)ly * INW * DM, MALL, INW, DM}; pg8::StaticOrder S; S.init(MALL, INW, G, bx);
            pg8::EpiProj E{WSP(bf16_t, WS_PROJ), WSP(const float, WS_GAIN) + ly * 256, WSP(const float, WS_RS1), WSP(const float, WS_BIN) + (size_t)ly * 9 * INW};
            pg8::gemm_phase<pg8::EpiProj, pg8::StaticOrder, true, true>(lds, g, S, E, wave);
        } break;
        case 3: { LANE_OPAQUE;
            att::attn_phase(lds + wave * att::WAVE_LDS + 256, WSP(bf16_t, WS_PROJ), WSP(bf16_t, WS_OB), P.in[11] + (size_t)ly * 4 * 15 * 31, P.in[16] + ly * 8, WSP(const float, WS_GAIN) + 512 + 2 * ly, ly == 0, gw, ngw, ln_);
        } break;
        case 4: { LANE_OPAQUE;
            mix_pass(WSP(bf16_t, WS_PROJ), WSP(bf16_t, WS_OB), P.in[12] + (size_t)ly * 3 * 256, P.in[13] + ly * 256, P.in[17] + ly * DM, WSP(bf16_t, WS_HN), MROWS, gw, ngw, ln_);
        } break;
        case 5: { LANE_OPAQUE;
            pg8::Gemm g{WSP(bf16_t, WS_HN), WSP(bf16_t, WS_WO) + (size_t)ly * DM * DM, MROWS, DM, DM}; pg8::StaticOrder S; S.init(MROWS, DM, G, bx);
            pg8::EpiResid E{XL, CL, P.out, WSP(float, WS_CTX), MODL + 2 * DM, WSP(bf16_t, WS_HN2), P.in[7] + ly * DM, MODL + 4 * DM, WSP(float, WS_RS2), DRY(5), nullptr, false};
            pg8::gemm_phase<pg8::EpiResid, pg8::StaticOrder, true, true>(lds, g, S, E, wave);
        } break;
        case 7: { LANE_OPAQUE;
            pg8::Gemm g{WSP(bf16_t, WS_HN2), WSP(bf16_t, WS_W1) + (size_t)ly * FFN * DM, MROWS, FFN, DM}; pg8::StaticOrder S; S.init(MROWS, FFN, G, bx);
            pg8::EpiFc1 E{WSP(bf16_t, WS_H1), FFN, WSP(const float, WS_RS2), WSP(const float, WS_B1) + (size_t)ly * 9 * FFN};
            pg8::gemm_phase<pg8::EpiFc1, pg8::StaticOrder, true, true>(lds, g, S, E, wave);
        } break;
        case 8: { LANE_OPAQUE;
            pg8::Gemm g{WSP(bf16_t, WS_H1), WSP(bf16_t, WS_W2) + (size_t)ly * DM * FFN, MROWS, DM, FFN};
            if (ly == 0) {
                pg8::SplitOrder S; S.init(G, bx);
                pg8::EpiResid E{P.out, WSP(float, WS_CTX), P.out, WSP(float, WS_CTX), MODL + 5 * DM, WSP(bf16_t, WS_HN2), P.in[6] + DM, WSP(const float, WS_MOD) + (size_t)9 * MODW + DM, WSP(float, WS_RS1), DRY(8), (float*)ws, true};
                pg8::gemm_phase<pg8::EpiResid, pg8::SplitOrder, true, true>(lds, g, S, E, wave);
            } else {
                pg8::StaticOrder S; S.init(MROWS, DM, G, bx);
                pg8::EpiResid E{P.out, WSP(float, WS_CTX), P.out, WSP(float, WS_CTX), MODL + 5 * DM, (bf16_t*)nullptr, nullptr, nullptr, nullptr, DRY(8), nullptr, false};
                pg8::gemm_phase<pg8::EpiResid, pg8::StaticOrder, true, true>(lds, g, S, E, wave);
            }
        } break;
        default: { LANE_OPAQUE;
            ctx_rows_pass(ws, WSP(const float, WS_CTX), WSP(const float, WS_MOD) + (size_t)8 * MODW + 5 * DM, P.in[6] + DM, WSP(const float, WS_MOD) + (size_t)(9 + 8) * MODW + DM, WSP(bf16_t, WS_HN2), WSP(float, WS_RS1), gw, ngw, ln_);
        } break;
        }
        }
        for (int es_ = 0; es_ < EXTRA_SYNC; ++es_) GRID_SYNC();
        if (ph + 1 < ph_hi) GRID_SYNC();
        if (PROBE_PHASE >= 0 && ph == PROBE_PHASE && blockIdx.x == 0 && wave == 0 && pg8::lane_id() == 0) { const unsigned long long t_ = __builtin_amdgcn_s_memrealtime(); volatile LAS unsigned* pw_ = (volatile LAS unsigned*)(lds + LDS_ST_OFF + 32); pw_[2] = (unsigned)t_; pw_[3] = (unsigned)(t_ >> 32); }
#undef P
    }
    if (PROBE_PHASE >= 0 && blockIdx.x == 0 && wave == 0 && pg8::lane_id() == 0) {
        volatile LAS unsigned* pw_ = (volatile LAS unsigned*)(lds + LDS_ST_OFF + 32);
        const unsigned long long a_ = ((unsigned long long)pw_[1] << 32) | pw_[0], b_ = ((unsigned long long)pw_[3] << 32) | pw_[2];
        const unsigned long long span_ = (b_ - a_) * PROBE_MULT; const unsigned long long t0_ = __builtin_amdgcn_s_memrealtime();
        if (span_ < 100000000ull) while (__builtin_amdgcn_s_memrealtime() - t0_ < span_) __builtin_amdgcn_s_sleep(8);
    }
}

#ifndef MK_MULTI_LAUNCH
#define MK_MULTI_LAUNCH 0
#endif
extern "C" void kernel_launch(void* const* d_in, const int* in_sizes, int n_in, void* d_out, int out_size, void* d_ws, size_t ws_size, hipStream_t stream) {
    static int grid = 0;
    if (grid == 0) {
        if (n_in != 21 || out_size != MLAT * DM || ws_size < WS_END) { fprintf(stderr, "kernel_launch: unexpected shapes (n_in %d out %d ws %zu)\n", n_in, out_size, ws_size); grid = -1; return; }
        int dev = 0, cus = 0, per_cu = 0;
        if (hipGetDevice(&dev) != hipSuccess || hipDeviceGetAttribute(&cus, hipDeviceAttributeMultiprocessorCount, dev) != hipSuccess) { grid = -1; return; }
        if (hipFuncSetAttribute((const void*)fwd_kernel, hipFuncAttributeMaxDynamicSharedMemorySize, LDS_BYTES) != hipSuccess) { fprintf(stderr, "kernel_launch: hipFuncSetAttribute failed\n"); grid = -1; return; }
        if (hipOccupancyMaxActiveBlocksPerMultiprocessor(&per_cu, (const void*)fwd_kernel, 512, LDS_BYTES) != hipSuccess || per_cu < 1) { fprintf(stderr, "kernel_launch: occupancy query gave %d\n", per_cu); (void)hipGetLastError(); grid = -1; return; }
        grid = cus * per_cu;
    }
    if (grid < 0) return;
    Params p{};
    for (int i = 0; i < 21; ++i) p.in[i] = (const float*)d_in[i];
    p.out = (float*)d_out; p.ws = (unsigned char*)d_ws;
    if (hipMemsetAsync((char*)d_ws + WS_BAR, 0, XCD_BAR_WORDS * 4, stream) != hipSuccess) { fprintf(stderr, "kernel_launch: memset of the barrier words failed\n"); return; }
    void* args[] = {&p};
#if MK_MULTI_LAUNCH
    for (int ph = 0; ph < N_PHASES; ++ph) { p.ph_lo = ph; p.ph_hi = ph + 1;
        hipError_t e = hipLaunchCooperativeKernel((const void*)fwd_kernel, dim3(grid), dim3(512), args, LDS_BYTES, stream);
        if (e != hipSuccess) { fprintf(stderr, "launch %d failed: %s\n", ph, hipGetErrorString(e)); break; } }
#else
    p.ph_lo = 0; p.ph_hi = N_PHASES;
    hipError_t e = hipLaunchCooperativeKernel((const void*)fwd_kernel, dim3(grid), dim3(512), args, LDS_BYTES, stream);
    if (e != hipSuccess) fprintf(stderr, "cooperative launch failed: %s (grid %d)\n", hipGetErrorString(e), grid);
#endif
}
```

```cpp
#include <hip/hip_runtime.h>
#include <cstdio>
#include <cstdint>
namespace pg8 {
#define PG8_LAS __attribute__((address_space(3)))
typedef unsigned short bf16_t;
__device__ __forceinline__ int lane_id() { int r; asm volatile("v_mbcnt_lo_u32_b32 %0, -1, 0\n\tv_mbcnt_hi_u32_b32 %0, -1, %0" : "=v"(r)); return r; }
template <int K> __device__ __forceinline__ float shx(float v) { static_assert(K == 1 || K == 2 || K == 4 || K == 8 || K == 16, "xor mask"); return __builtin_bit_cast(float, __builtin_amdgcn_ds_swizzle(__builtin_bit_cast(int, v), 0x1f | (K << 10))); }
__device__ __forceinline__ void swap_halves(float& a, float& b) { asm("s_nop 1\n\tv_permlane32_swap_b32 %0, %1" : "+v"(a), "+v"(b)); }
__device__ __forceinline__ float sum_halves(float v) { float a = v, b = v; swap_halves(a, b); return a + b; }
__device__ __forceinline__ float max_halves(float v) { float a = v, b = v; swap_halves(a, b); return fmaxf(a, b); }
typedef short bf16x8 __attribute__((ext_vector_type(8)));
typedef float f32x4 __attribute__((ext_vector_type(4)));
typedef unsigned u32x4 __attribute__((ext_vector_type(4)));
constexpr int BM = 256, BK = 64, HALF = 128, HTB = HALF * BK * 2  , STAGE_BYTES = 8 * HTB, NXCD = 8, WGM = 8;

__host__ __device__ __forceinline__ int lds_byte(int r, int c) { const int st = (r >> 4) * 2 + (c >> 5), rr = r & 15, cc = c & 31, ob = rr * 64 + cc * 2; return st * 1024 + (ob ^ (((ob >> 9) & 1) << 5)); }
__host__ __device__ __forceinline__ void stage_rc(int b, int& R, int& C) { const int st = b / 1024, sb = b % 1024, swz = sb ^ (((sb >> 9) & 1) << 5); R = (st >> 1) * 16 + swz / 64; C = (st & 1) * 32 + (swz % 64) / 2; }
__host__ __device__ __forceinline__ int perm32(int rho) { const int n = rho >> 4, i = rho & 15; return 8 * (i >> 2) + 4 * n + (i & 3); }

struct Unit { int pm, pn, k0t, nt, ks; };
struct Gemm { const bf16_t* A; const bf16_t* Bt; int M, N, K; };

struct StaticOrder {
    int nM, nN, nwg, G, c;
    __host__ __device__ void init(int M, int N, int G_, int c_) { nM = M / BM; nN = N / BM; nwg = nM * nN; G = G_; c = c_; }
    __host__ __device__ __forceinline__ bool next(int i, Unit& u) const {
        const long L = (long)i * G + c; if (L >= nwg) { u.pm = 0; u.pn = 0; u.k0t = 0; u.nt = 0; u.ks = 0; return false; }
        int wgid = (int)L; { const int q = nwg / NXCD, r = nwg % NXCD, xcd = wgid % NXCD, off = wgid / NXCD; wgid = (xcd < r ? xcd * (q + 1) : r * (q + 1) + (xcd - r) * q) + off; }
        const int nig = WGM * nN, gid = wgid / nig, fm = gid * WGM, gsz = (nM - fm) < WGM ? (nM - fm) : WGM;
        u.pm = fm + ((wgid % nig) % gsz); u.pn = (wgid % nig) / gsz; u.k0t = 0; u.nt = 0; u.ks = 0; return true;
    }
    __device__ __forceinline__ void a_ready(const Unit&) const {}
    __device__ __forceinline__ void done(const Unit&) const {}
};
__device__ __forceinline__ unsigned cvt_pk_bf16(float lo, float hi) { unsigned r; asm volatile("v_cvt_pk_bf16_f32 %0, %1, %2" : "=v"(r) : "v"(lo), "v"(hi)); return r; }
typedef float f32x2 __attribute__((ext_vector_type(2)));
template <class Epi, class Sched, bool ALIGN_EPI = false, bool SP2 = false>
__device__ __forceinline__ void gemm_phase(PG8_LAS unsigned char* lds, const Gemm g, const Sched& S, const Epi& E, const int wid_in) {
    int tid_ = wid_in * 64 + lane_id(); asm volatile("" : "+v"(tid_));
    const int tid = tid_, wid = __builtin_amdgcn_readfirstlane(tid >> 6), lane = tid & 63, wr = wid >> 2, wc = wid & 3, fr = lane & 15, fq = lane >> 4;
    const int K = g.K, nt_all = K / BK;
    unsigned voffA[2], voffB[2];
#pragma unroll
    for (int i = 0; i < 2; ++i) { int R, C; stage_rc(tid * 16 + i * 8192, R, C); const int Rb = Epi::PERM ? ((R & ~31) + perm32(R & 31)) : R;
        voffA[i] = (unsigned)(R * K + C) * 2u; voffB[i] = (unsigned)(Rb * K + C) * 2u; }
    const size_t kstep = (size_t)(BK * 2);
    const size_t hstep = (size_t)HALF * K * 2;
    const size_t tstep = 2 * hstep;
    const unsigned ldsw = (unsigned)wid * 1024u;
    const int aoff = lds_byte(wr * 64 + fr, fq * 8), boff = lds_byte(wc * 32 + fr, fq * 8);
#define PG8_SA(b, h) (((b) * 2 + (h)) * HTB)
#define PG8_SB(b, h) ((4 + (b) * 2 + (h)) * HTB)
#define PG8_STAGE(bufoff, gbase, voff) do { _Pragma("unroll") for (int _i = 0; _i < 2; ++_i) \
        __builtin_amdgcn_global_load_lds((const unsigned*)((const char*)(gbase) + (voff)[_i]), (PG8_LAS unsigned*)(lds + (bufoff) + ldsw + _i * 8192), 16, 0, 0); } while (0)
#define PG8_LDA(dst, b, h) do { _Pragma("unroll") for (int m = 0; m < 4; ++m) _Pragma("unroll") for (int k = 0; k < 2; ++k) dst[m][k] = *(const PG8_LAS bf16x8*)(lds + PG8_SA(b, h) + aoff + m * 2048 + k * 1024); } while (0)
#define PG8_LDB(dst, b, h) do { _Pragma("unroll") for (int n = 0; n < 2; ++n) _Pragma("unroll") for (int k = 0; k < 2; ++k) dst[n][k] = *(const PG8_LAS bf16x8*)(lds + PG8_SB(b, h) + boff + n * 2048 + k * 1024); } while (0)
#define PG8_MMA(ai, bj, At, Bt) do { __builtin_amdgcn_s_setprio(1); _Pragma("unroll") for (int m = 0; m < 4; ++m) _Pragma("unroll") for (int n = 0; n < 2; ++n) _Pragma("unroll") for (int k = 0; k < 2; ++k) \
        acc[ai][bj][m][n] = __builtin_amdgcn_mfma_f32_16x16x32_bf16(Bt[n][k], At[m][k], acc[ai][bj][m][n], 0, 0, 0); __builtin_amdgcn_s_setprio(0); } while (0)
#define PG8_WAIT_V(n) asm volatile("s_waitcnt vmcnt(" #n ")" ::: "memory")
#define PG8_WAIT_L(n) asm volatile("s_waitcnt lgkmcnt(" #n ")" ::: "memory")
#define PG8_BAR __builtin_amdgcn_s_barrier()
#define PG8_SCHED __builtin_amdgcn_sched_barrier(0)
    Unit cur, nxt; int ui = 0;
    if (!S.next(0, cur)) return;
    f32x4 acc[2][2][4][2];
#pragma unroll
    for (int a = 0; a < 2; ++a)
#pragma unroll
        for (int b = 0; b < 2; ++b)
#pragma unroll
            for (int m = 0; m < 4; ++m)
#pragma unroll
                for (int n = 0; n < 2; ++n) acc[a][b][m][n] = (f32x4){0.f, 0.f, 0.f, 0.f};
    bf16x8 At[4][2], B0[2][2], B1[2][2];
    const char* cA = (const char*)g.A + (size_t)cur.pm * tstep + (size_t)cur.k0t * kstep; const char* cB = (const char*)g.Bt + (size_t)cur.pn * tstep + (size_t)cur.k0t * kstep;
    int nt = cur.nt ? cur.nt : nt_all;
    S.a_ready(cur);
    if constexpr (SP2) {
        PG8_STAGE(PG8_SB(0, 0), cB, voffB); PG8_STAGE(PG8_SB(0, 1), cB + hstep, voffB); PG8_STAGE(PG8_SA(0, 0), cA, voffA); PG8_STAGE(PG8_SA(0, 1), cA + hstep, voffA);
        if (wr == 1) PG8_BAR;
        PG8_WAIT_V(2); PG8_BAR;
        PG8_STAGE(PG8_SB(1, 0), cB + kstep, voffB); PG8_STAGE(PG8_SA(1, 0), cA + kstep, voffA); PG8_STAGE(PG8_SB(1, 1), cB + hstep + kstep, voffB);
        PG8_WAIT_V(6); PG8_BAR;
    } else {
        PG8_STAGE(PG8_SB(0, 0), cB, voffB); PG8_STAGE(PG8_SA(0, 0), cA, voffA); PG8_STAGE(PG8_SB(0, 1), cB + hstep, voffB); PG8_STAGE(PG8_SA(0, 1), cA + hstep, voffA);
        if (wr == 1) PG8_BAR;
        PG8_WAIT_V(4); PG8_BAR;
        PG8_STAGE(PG8_SB(1, 0), cB + kstep, voffB); PG8_STAGE(PG8_SA(1, 0), cA + kstep, voffA); PG8_STAGE(PG8_SB(1, 1), cB + hstep + kstep, voffB);
        PG8_WAIT_V(6); PG8_BAR;
    }
    for (;;) {
        const bool has_next = S.next(ui + 1, nxt);
        const char* nA = has_next ? (const char*)g.A + (size_t)nxt.pm * tstep + (size_t)nxt.k0t * kstep : cA; const char* nB = has_next ? (const char*)g.Bt + (size_t)nxt.pn * tstep + (size_t)nxt.k0t * kstep : cB;
        for (int t = 0; t < nt; t += 2) {
            const bool last = (t == nt - 2);
            const char* a1 = cA + (size_t)(t + 1) * kstep;
            const char* a2 = last ? nA : cA + (size_t)(t + 2) * kstep; const char* b2 = last ? nB : cB + (size_t)(t + 2) * kstep;
            const char* a3 = a2 + kstep; const char* b3 = b2 + kstep;
            if (last && has_next) S.a_ready(nxt);
            if constexpr (SP2) {
            PG8_LDB(B0, 0, 0); PG8_LDB(B1, 0, 1); PG8_SCHED; PG8_LDA(At, 0, 0); PG8_STAGE(PG8_SA(1, 1), a1 + hstep, voffA);
            PG8_WAIT_V(8); PG8_WAIT_L(0); PG8_BAR; PG8_MMA(0, 0, At, B0); PG8_MMA(0, 1, At, B1); PG8_BAR; PG8_SCHED;
            PG8_LDA(At, 0, 1); PG8_STAGE(PG8_SB(0, 0), b2, voffB); PG8_STAGE(PG8_SB(0, 1), b2 + hstep, voffB); PG8_STAGE(PG8_SA(0, 0), a2, voffA);
            PG8_WAIT_V(8); PG8_WAIT_L(0); PG8_BAR; PG8_MMA(1, 0, At, B0); PG8_MMA(1, 1, At, B1); PG8_BAR; PG8_SCHED;
            PG8_LDB(B0, 1, 0); PG8_LDB(B1, 1, 1); PG8_SCHED; PG8_LDA(At, 1, 0); PG8_STAGE(PG8_SA(0, 1), a2 + hstep, voffA);
            PG8_WAIT_V(8); PG8_WAIT_L(0); PG8_BAR; PG8_MMA(0, 0, At, B0); PG8_MMA(0, 1, At, B1); PG8_BAR; PG8_SCHED;
            PG8_LDA(At, 1, 1); PG8_STAGE(PG8_SB(1, 0), b3, voffB); PG8_STAGE(PG8_SB(1, 1), b3 + hstep, voffB); PG8_STAGE(PG8_SA(1, 0), a3, voffA);
            PG8_WAIT_V(8); PG8_WAIT_L(0); PG8_BAR; PG8_MMA(1, 0, At, B0); PG8_MMA(1, 1, At, B1); PG8_BAR; PG8_SCHED;
            } else {
            PG8_LDB(B0, 0, 0); PG8_SCHED; PG8_LDA(At, 0, 0); PG8_STAGE(PG8_SA(1, 1), a1 + hstep, voffA);
            PG8_WAIT_L(8); PG8_BAR; PG8_WAIT_L(0); PG8_MMA(0, 0, At, B0); PG8_BAR; PG8_SCHED;
            PG8_LDB(B1, 0, 1); PG8_STAGE(PG8_SB(0, 0), b2, voffB);
            PG8_BAR; PG8_WAIT_L(0); PG8_MMA(0, 1, At, B1); PG8_BAR;
            PG8_LDA(At, 0, 1); PG8_STAGE(PG8_SA(0, 0), a2, voffA);
            PG8_BAR; PG8_WAIT_L(0); PG8_MMA(1, 0, At, B0); PG8_BAR; PG8_SCHED;
            PG8_STAGE(PG8_SB(0, 1), b2 + hstep, voffB);
            PG8_WAIT_V(6); PG8_BAR; PG8_MMA(1, 1, At, B1); PG8_BAR;
            PG8_LDB(B0, 1, 0); PG8_SCHED; PG8_LDA(At, 1, 0); PG8_STAGE(PG8_SA(0, 1), a2 + hstep, voffA);
            PG8_WAIT_L(8); PG8_BAR; PG8_WAIT_L(0); PG8_MMA(0, 0, At, B0); PG8_BAR; PG8_SCHED;
            PG8_LDB(B1, 1, 1); PG8_STAGE(PG8_SB(1, 0), b3, voffB);
            PG8_BAR; PG8_WAIT_L(0); PG8_MMA(0, 1, At, B1); PG8_BAR;
            PG8_LDA(At, 1, 1); PG8_STAGE(PG8_SA(1, 0), a3, voffA);
            PG8_BAR; PG8_WAIT_L(0); PG8_MMA(1, 0, At, B0); PG8_BAR; PG8_SCHED;
            PG8_STAGE(PG8_SB(1, 1), b3 + hstep, voffB);
            PG8_WAIT_V(6); PG8_BAR; PG8_MMA(1, 1, At, B1); PG8_BAR;
            }
        }
        if constexpr (ALIGN_EPI) { if (wr == 0) PG8_BAR; }
        if constexpr (!Epi::AFTER_DRAIN) { E(acc, cur, wr, wc, fr, fq); S.done(cur); }
        if (!has_next) break;
#pragma unroll
        for (int a = 0; a < 2; ++a)
#pragma unroll
            for (int b = 0; b < 2; ++b)
#pragma unroll
                for (int m = 0; m < 4; ++m)
#pragma unroll
                    for (int n = 0; n < 2; ++n) acc[a][b][m][n] = (f32x4){0.f, 0.f, 0.f, 0.f};
        cur = nxt; cA = nA; cB = nB; ++ui; nt = cur.nt ? cur.nt : nt_all;
        if constexpr (ALIGN_EPI) { if (wr == 1) PG8_BAR; }
    }
    PG8_WAIT_V(0);
    if constexpr (!ALIGN_EPI) { if (wr == 0) PG8_BAR; }
    PG8_BAR;
    if constexpr (Epi::AFTER_DRAIN) { E.fused(acc, cur, wr, wc, fr, fq, lds, wid, lane); S.done(cur); }
#undef PG8_SA
#undef PG8_SB
#undef PG8_STAGE
#undef PG8_LDA
#undef PG8_LDB
#undef PG8_MMA
#undef PG8_WAIT_V
#undef PG8_WAIT_L
#undef PG8_BAR
#undef PG8_SCHED
}
}

namespace pg8 {
typedef unsigned u32x2 __attribute__((ext_vector_type(2)));
template <int ACT> struct EpiStore {
    static constexpr bool PERM = true, AFTER_DRAIN = false;
    bf16_t* O; int ldc;
    __device__ __forceinline__ void operator()(const f32x4 (&acc)[2][2][4][2], const Unit& u, int wr, int wc, int fr, int fq) const {
        const int row0 = u.pm * BM + wr * 64 + fr, col0 = u.pn * BM + wc * 32 + 8 * fq;
#pragma unroll
        for (int ai = 0; ai < 2; ++ai)
#pragma unroll
            for (int m = 0; m < 4; ++m) { bf16_t* rowp = O + (size_t)(row0 + ai * HALF + m * 16) * ldc + col0;
#pragma unroll
                for (int bj = 0; bj < 2; ++bj) { f32x4 v0 = acc[ai][bj][m][0], v1 = acc[ai][bj][m][1];
                    if (ACT == 2) {
#pragma unroll
                        for (int e = 0; e < 4; ++e) { const float a = fmaxf(v0[e], 0.f), b = fmaxf(v1[e], 0.f); v0[e] = a * a; v1[e] = b * b; } }
                    u32x4 w; w.x = cvt_pk_bf16(v0[0], v0[1]); w.y = cvt_pk_bf16(v0[2], v0[3]); w.z = cvt_pk_bf16(v1[0], v1[1]); w.w = cvt_pk_bf16(v1[2], v1[3]);
                    *(u32x4*)(rowp + bj * HALF) = w; } }
    }
};


__device__ __forceinline__ void rows_rstd(const float* rs, int row0, int fq, float (&rstd)[2][4]) {
    f32x4 p[2][4];
#pragma unroll
    for (int ai = 0; ai < 2; ++ai)
#pragma unroll
        for (int m = 0; m < 4; ++m) p[ai][m] = *(const f32x4*)(rs + (size_t)(row0 + ai * HALF + m * 16) * 16 + 4 * fq);
#pragma unroll
    for (int ai = 0; ai < 2; ++ai)
#pragma unroll
        for (int m = 0; m < 4; ++m) { float s = (p[ai][m][0] + p[ai][m][1]) + (p[ai][m][2] + p[ai][m][3]); s += shx<16>(s); s = sum_halves(s); rstd[ai][m] = 1.0f / sqrtf(s * (1.0f / 1024.0f) + 1e-6f); }
}
struct EpiFc1 {
    static constexpr bool PERM = true, AFTER_DRAIN = false;
    bf16_t* O; int ldc; const float* rs; const float* bias;
    __device__ __forceinline__ void operator()(const f32x4 (&acc)[2][2][4][2], const Unit& u, int wr, int wc, int fr_in, int fq_in) const {
        (void)fr_in; (void)fq_in; int ln_e = lane_id(); asm volatile("" : "+v"(ln_e)); const int fr = ln_e & 15, fq = ln_e >> 4;
        const int row0 = u.pm * BM + wr * 64 + fr, col0 = u.pn * BM + wc * 32 + 8 * fq; const int b = (u.pm < 64) ? (u.pm >> 3) : 8;
        f32x4 bv[2][2];
#pragma unroll
        for (int bj = 0; bj < 2; ++bj)
#pragma unroll
            for (int n = 0; n < 2; ++n) bv[bj][n] = *(const f32x4*)(bias + (size_t)b * ldc + col0 + bj * HALF + 4 * n);
        float rsd[2][4]; rows_rstd(rs, row0, fq, rsd);
#pragma unroll
        for (int ai = 0; ai < 2; ++ai)
#pragma unroll
            for (int m = 0; m < 4; ++m) { const int row = row0 + ai * HALF + m * 16; const float rstd = rsd[ai][m]; bf16_t* rowp = O + (size_t)row * ldc + col0;
#pragma unroll
                for (int bj = 0; bj < 2; ++bj) { f32x4 v0 = acc[ai][bj][m][0] * rstd + bv[bj][0], v1 = acc[ai][bj][m][1] * rstd + bv[bj][1];
#pragma unroll
                    for (int e = 0; e < 4; ++e) { const float a = fmaxf(v0[e], 0.f), c = fmaxf(v1[e], 0.f); v0[e] = a * a; v1[e] = c * c; }
                    u32x4 w; w.x = cvt_pk_bf16(v0[0], v0[1]); w.y = cvt_pk_bf16(v0[2], v0[3]); w.z = cvt_pk_bf16(v1[0], v1[1]); w.w = cvt_pk_bf16(v1[2], v1[3]);
                    *(u32x4*)(rowp + bj * HALF) = w; }
                asm volatile("" ::: "memory"); }
    }
};


__host__ __device__ __forceinline__ size_t slab_off(int i, int mode) { const size_t MiB_ = (size_t)1 << 20; if (mode == 1) return 90 * MiB_ + (size_t)i * 262144;
    return i < 36 ? 234 * MiB_ + (size_t)i * 262144 : i < 64 ? 249 * MiB_ + (size_t)(i - 36) * 262144 : 14 * MiB_ + (size_t)(i - 64) * 262144; }
struct SplitOrder {
    StaticOrder lat; int G, c, nts;
    __host__ __device__ void init(int G_, int c_, int nts_) { lat.init(64 * BM, 4 * BM, G_, c_); G = G_; c = c_; nts = nts_; }
    __host__ __device__ __forceinline__ bool next(int i, Unit& u) const {
        const long L = (long)i * G + c;
        Unit t; const bool okl = lat.next(i, t);
        const int s = (int)(L - 256), unit = s >> 2; const bool isl = L < 256;
        u.pm = isl ? t.pm : 64 + (unit >> 2); u.pn = isl ? t.pn : (unit & 3); u.ks = isl ? 0 : (s & 3); u.k0t = isl ? 0 : (s & 3) * nts; u.nt = isl ? 0 : nts;
        return isl ? okl : (s < 128);
    }
    __device__ __forceinline__ void a_ready(const Unit&) const {}
    __device__ __forceinline__ void done(const Unit&) const {}
};

struct EpiResid {
    static constexpr bool PERM = true, AFTER_DRAIN = false;
    const float* base_lat; const float* base_ctx; float* out_lat; float* out_ctx; const float* gate;
    bf16_t* aout; const float* gn; const float* scn; float* rsout;
    bool dry;
    float* slab; bool split_ctx; int slab_mode;
    __device__ __forceinline__ void operator()(const f32x4 (&acc)[2][2][4][2], const Unit& u, int wr, int wc, int fr_in, int fq_in) const {
        (void)fr_in; (void)fq_in; int ln_e = lane_id(); asm volatile("" : "+v"(ln_e)); const int fr = ln_e & 15, fq = ln_e >> 4;
        if (dry) return;
        const bool lat = u.pm < 64;
        const int b = lat ? (u.pm >> 3) : 8;
        const size_t roff = (size_t)(lat ? u.pm : u.pm - 64) * BM * 1024;
        const float* base = (lat ? base_lat : base_ctx) + roff; float* out = (lat ? out_lat : out_ctx) + roff;
        const int col0 = u.pn * BM + wc * 32 + 8 * fq;
        f32x4 gv[2][2];
#pragma unroll
        for (int bj = 0; bj < 2; ++bj)
#pragma unroll
            for (int n = 0; n < 2; ++n) gv[bj][n] = *(const f32x4*)(gate + (size_t)b * 6144 + col0 + bj * HALF + n * 4);
        if (u.ks != 0) {
            float* sp = (float*)((unsigned char*)slab + slab_off(((u.pm - 64) * 4 + u.pn) * 3 + (u.ks - 1), slab_mode)) + wc * 32 + 8 * fq;
#pragma unroll
            for (int ai = 0; ai < 2; ++ai)
#pragma unroll
                for (int m = 0; m < 4; ++m) { float* rp = sp + (size_t)(ai * HALF + wr * 64 + m * 16 + fr) * 256;
#pragma unroll
                    for (int bj = 0; bj < 2; ++bj) { *(f32x4*)(rp + bj * HALF) = acc[ai][bj][m][0]; *(f32x4*)(rp + bj * HALF + 4) = acc[ai][bj][m][1]; } }
            return;
        }
        if (aout == nullptr || (split_ctx && !lat)) {
#pragma unroll
            for (int ai = 0; ai < 2; ++ai)
#pragma unroll
                for (int m = 0; m < 4; ++m) { const size_t off = (size_t)(ai * HALF + wr * 64 + m * 16 + fr) * 1024 + col0;
#pragma unroll
                    for (int bj = 0; bj < 2; ++bj)
#pragma unroll
                        for (int n = 0; n < 2; ++n) { const f32x4 bs = *(const f32x4*)(base + off + bj * HALF + n * 4);
                            *(f32x4*)(out + off + bj * HALF + n * 4) = bs + gv[bj][n] * acc[ai][bj][m][n]; }
                    if (m & 1) asm volatile("" ::: "memory"); }
            return;
        }
        f32x4 Gv[2][2];
#pragma unroll
        for (int bj = 0; bj < 2; ++bj)
#pragma unroll
            for (int n = 0; n < 2; ++n) Gv[bj][n] = *(const f32x4*)(gn + col0 + bj * HALF + n * 4) * (*(const f32x4*)(scn + (size_t)b * 6144 + col0 + bj * HALF + n * 4) + 1.0f);
        const size_t grow0 = (size_t)u.pm * BM;
#pragma unroll
        for (int ai = 0; ai < 2; ++ai)
#pragma unroll
            for (int m = 0; m < 4; ++m) { const int rl = ai * HALF + wr * 64 + m * 16 + fr; const size_t off = (size_t)rl * 1024 + col0; float ss = 0.f;
                bf16_t* ap = aout + (grow0 + rl) * 1024 + col0;
#pragma unroll
                for (int bj = 0; bj < 2; ++bj) {
                    const f32x4 b0 = *(const f32x4*)(base + off + bj * HALF), b1 = *(const f32x4*)(base + off + bj * HALF + 4);
                    const f32x4 x0 = b0 + gv[bj][0] * acc[ai][bj][m][0], x1 = b1 + gv[bj][1] * acc[ai][bj][m][1];
                    *(f32x4*)(out + off + bj * HALF) = x0; *(f32x4*)(out + off + bj * HALF + 4) = x1;
                    ss += ((x0[0] * x0[0] + x0[1] * x0[1]) + (x0[2] * x0[2] + x0[3] * x0[3])) + ((x1[0] * x1[0] + x1[1] * x1[1]) + (x1[2] * x1[2] + x1[3] * x1[3]));
                    const f32x4 y0 = x0 * Gv[bj][0], y1 = x1 * Gv[bj][1];
                    u32x4 w; w.x = cvt_pk_bf16(y0[0], y0[1]); w.y = cvt_pk_bf16(y0[2], y0[3]); w.z = cvt_pk_bf16(y1[0], y1[1]); w.w = cvt_pk_bf16(y1[2], y1[3]);
                    *(u32x4*)(ap + bj * HALF) = w; }
                ss += shx<16>(ss); ss = sum_halves(ss);
                if (fq == 0) rsout[(grow0 + rl) * 16 + u.pn * 4 + wc] = ss;
                if (m & 1) asm volatile("" ::: "memory"); }
    }
};

struct EpiProj {
    static constexpr bool PERM = true, AFTER_DRAIN = false;
    bf16_t* O; const float* gains;
    const float* rs; const float* bias;
    __device__ __forceinline__ void operator()(const f32x4 (&acc)[2][2][4][2], const Unit& u, int wr, int wc, int fr_in, int fq_in) const {
        (void)fr_in; (void)fq_in; int ln_e = lane_id(); asm volatile("" : "+v"(ln_e)); const int fr = ln_e & 15, fq = ln_e >> 4;
        const int pn = u.pn; const int row0 = u.pm * BM + wr * 64 + fr; const int b = (u.pm < 64) ? (u.pm >> 3) : 8;
        f32x4 bv[2][2];
#pragma unroll
        for (int bj = 0; bj < 2; ++bj)
#pragma unroll
            for (int n = 0; n < 2; ++n) bv[bj][n] = *(const f32x4*)(bias + (size_t)b * 2304 + pn * BM + bj * HALF + wc * 32 + 8 * fq + 4 * n);
        float rsd[2][4]; rows_rstd(rs, row0, fq, rsd);
        if (pn >= 2 && pn <= 5) {
            const int col0 = pn * BM + wc * 32 + 8 * fq;
#pragma unroll
            for (int ai = 0; ai < 2; ++ai)
#pragma unroll
                for (int m = 0; m < 4; ++m) { bf16_t* rowp = O + (size_t)(row0 + ai * HALF + m * 16) * 2304 + col0; const float rstd = rsd[ai][m];
#pragma unroll
                    for (int bj = 0; bj < 2; ++bj) { const f32x4 v0 = acc[ai][bj][m][0] * rstd + bv[bj][0], v1 = acc[ai][bj][m][1] * rstd + bv[bj][1];
                        u32x4 w; w.x = cvt_pk_bf16(v0[0], v0[1]); w.y = cvt_pk_bf16(v0[2], v0[3]); w.z = cvt_pk_bf16(v1[0], v1[1]); w.w = cvt_pk_bf16(v1[2], v1[3]);
                        *(u32x4*)(rowp + bj * HALF) = w; } }
            return;
        }
        const int colh = pn * BM + wc * 64 + 8 * fq;
        const bool vhead = (pn == 8) && (wc >= 2);
        if (vhead) {
#pragma unroll
            for (int ai = 0; ai < 2; ++ai)
#pragma unroll
                for (int m = 0; m < 4; ++m) { bf16_t* rowp = O + (size_t)(row0 + ai * HALF + m * 16) * 2304 + colh; const float rstd = rsd[ai][m];
#pragma unroll
                    for (int bj = 0; bj < 2; ++bj) { const f32x4 v0 = acc[ai][bj][m][0] * rstd + bv[bj][0], v1 = acc[ai][bj][m][1] * rstd + bv[bj][1];
                        u32x4 w; w.x = cvt_pk_bf16(v0[0], v0[1]); w.y = cvt_pk_bf16(v0[2], v0[3]); w.z = cvt_pk_bf16(v1[0], v1[1]); w.w = cvt_pk_bf16(v1[2], v1[3]);
                        *(u32x4*)(rowp + bj * 32) = w; } }
            return;
        }
        const float* gp = gains + 64 * ((pn == 0) ? 0 : (pn == 1) ? 1 : (pn == 8) ? 3 : 2);
        const float qs = (pn == 1 || pn == 8) ? 1.0f : 0.18033688011112042f;
        const bool rope = (pn >= 6) && (u.pm < 64);
        f32x4 gv[2][2];
#pragma unroll
        for (int bj = 0; bj < 2; ++bj)
#pragma unroll
            for (int n = 0; n < 2; ++n) gv[bj][n] = *(const f32x4*)(gp + 32 * bj + 16 * n + 4 * fq);
        float invrev[4];
#pragma unroll
        for (int e = 0; e < 4; ++e) invrev[e] = __builtin_amdgcn_exp2f(-(float)(4 * fq + e) * (13.287712379549449f / 16.0f)) * 0.15915494309189535f;
#pragma unroll
        for (int ai = 0; ai < 2; ++ai)
#pragma unroll
            for (int m = 0; m < 4; ++m) {
                const int row = row0 + ai * HALF + m * 16; const float rstd0 = rsd[ai][m];
                f32x4 v[2][2]; float ss = 0.f;
#pragma unroll
                for (int bj = 0; bj < 2; ++bj)
#pragma unroll
                    for (int n = 0; n < 2; ++n) v[bj][n] = acc[ai][bj][m][n] * rstd0 + bv[bj][n];
                asm volatile("" : "+v"(v[0][0]), "+v"(v[0][1]), "+v"(v[1][0]), "+v"(v[1][1]));
#pragma unroll
                for (int bj = 0; bj < 2; ++bj)
#pragma unroll
                    for (int n = 0; n < 2; ++n) { const f32x4 x = v[bj][n]; ss += (x[0] * x[0] + x[1] * x[1]) + (x[2] * x[2] + x[3] * x[3]); }
                ss += shx<16>(ss); ss = sum_halves(ss);
                const float rstd = 1.0f / sqrtf(ss * (1.0f / 64.0f) + 1e-6f);
#pragma unroll
                for (int bj = 0; bj < 2; ++bj)
#pragma unroll
                    for (int n = 0; n < 2; ++n) v[bj][n] = v[bj][n] * rstd * gv[bj][n];
                if (rope) {
                    const int t = row & 2047;
#pragma unroll
                    for (int bj = 0; bj < 2; ++bj) { const float pos = (float)(bj == 0 ? (t >> 6) : (t & 63));
#pragma unroll
                        for (int e = 0; e < 4; ++e) { float rev = pos * invrev[e]; rev = rev - floorf(rev);
                            const float cs = __builtin_amdgcn_cosf(rev), sn = __builtin_amdgcn_sinf(rev);
                            const float u1 = v[bj][0][e], u2 = v[bj][1][e];
                            v[bj][0][e] = u1 * cs - u2 * sn; v[bj][1][e] = u2 * cs + u1 * sn; } }
                }
                bf16_t* rowp = O + (size_t)row * 2304 + colh;
#pragma unroll
                for (int bj = 0; bj < 2; ++bj) { const f32x4 v0 = v[bj][0] * qs, v1 = v[bj][1] * qs;
                    u32x4 w; w.x = cvt_pk_bf16(v0[0], v0[1]); w.y = cvt_pk_bf16(v0[2], v0[3]); w.z = cvt_pk_bf16(v1[0], v1[1]); w.w = cvt_pk_bf16(v1[2], v1[3]);
                    *(u32x4*)(rowp + bj * 32) = w; }
                asm volatile("" ::: "memory");
            }
    }
};
}

#define LAS __attribute__((address_space(3)))
typedef unsigned short bf16_t;
typedef short bf16x8 __attribute__((ext_vector_type(8)));
typedef short s16x4 __attribute__((ext_vector_type(4)));
typedef float f32x16 __attribute__((ext_vector_type(16)));
typedef float f32x4 __attribute__((ext_vector_type(4)));
typedef unsigned u32x4 __attribute__((ext_vector_type(4)));
typedef unsigned u32x2 __attribute__((ext_vector_type(2)));

constexpr int DM = 1024, NB = 8, SEQ = 2048, CTXL = 256, FFN = 4096, INW = 2304;
constexpr int MLAT = NB * SEQ, MCTX = NB * CTXL, MALL = MLAT + MCTX;
constexpr float EPSN = 1e-6f, LOG2E = 1.4426950408889634f, NEGBIG = -1e30f;
constexpr int MODW = 6 * DM;
constexpr size_t MiB = (size_t)1 << 20;
constexpr size_t WS_MOD = 0;
constexpr size_t WS_GAIN = 512 * 1024;
constexpr size_t WS_BAR = 768 * 1024;
constexpr size_t WS_WIN = 1 * MiB;
constexpr size_t WS_WO = 10 * MiB;
constexpr size_t WS_W1 = 14 * MiB;
constexpr size_t WS_W2 = 30 * MiB;
constexpr size_t WS_CTX = 46 * MiB;
constexpr size_t WS_HN2 = 54 * MiB;
constexpr size_t WS_HN = 207 * MiB;
constexpr size_t WS_H1 = 90 * MiB;
constexpr size_t WS_PROJ = 90 * MiB;
constexpr size_t WS_OB = 171 * MiB;
constexpr size_t WS_RS1 = 243 * MiB;
constexpr size_t WS_RS2 = 245 * MiB;
constexpr size_t WS_BIN = 247 * MiB;
constexpr size_t WS_B1 = 248 * MiB;
constexpr size_t WS_END = 256 * MiB;
static_assert(WS_W1 == 14 * MiB, "pg8::slab_off places 32 slabs in the first layer's fc1 weight copy");

__device__ __forceinline__ float half_sum(float v) { v += pg8::shx<1>(v); v += pg8::shx<2>(v); v += pg8::shx<4>(v); v += pg8::shx<8>(v); v += pg8::shx<16>(v); return v; }
__device__ __forceinline__ float wave_sum(float v) { return pg8::sum_halves(half_sum(v)); }
__device__ __forceinline__ unsigned f2bf(float f) { unsigned u = __builtin_bit_cast(unsigned, f); return (u + 0x7fffu + ((u >> 16) & 1u)) >> 16; }
__device__ __forceinline__ unsigned pk2(float lo, float hi) { return f2bf(lo) | (f2bf(hi) << 16); }
__device__ __forceinline__ float bf_lo(unsigned u) { return __builtin_bit_cast(float, u << 16); }
__device__ __forceinline__ float bf_hi(unsigned u) { return __builtin_bit_cast(float, u & 0xffff0000u); }

namespace att {
constexpr int KROWB = 144, VROWB = 128, WL_V = 64 * KROWB, WL_A = WL_V + 64 * VROWB, WL_TAB = WL_A + 128 + 192, WAVE_LDS = WL_TAB + 15 * 32 * 4;
typedef float f32x2_t __attribute__((ext_vector_type(2))); typedef __bf16 bf16x2_t __attribute__((ext_vector_type(2)));
typedef short v4i16_t __attribute__((ext_vector_type(4)));
__device__ __forceinline__ unsigned cvtpk(float lo, float hi) { f32x2_t v = {lo, hi}; bf16x2_t b = __builtin_convertvector(v, bf16x2_t); return __builtin_bit_cast(unsigned, b); }
__device__ __forceinline__ s16x4 vtr(LAS const unsigned char* p) { return __builtin_bit_cast(s16x4, __builtin_amdgcn_ds_read_tr16_b64_v4i16((LAS v4i16_t*)p)); }
struct AU { int qrow0, qcol, kcol, vcol, ocol, ctxrow0, nloc, locrow0, a0, a1; float negc, l0; const float* rpb; };
template <int KIND> __device__ __forceinline__ void attn_unit(LAS unsigned char* wl, const bf16_t* __restrict__ proj, bf16_t* __restrict__ obuf, const AU u, const int lane) {
    const int r32 = lane & 31, hi = lane >> 5;
    LAS float* sc = (LAS float*)(wl + WL_A);
    LAS float* tab = (LAS float*)(wl + WL_TAB);
    bf16x8 qr[4];
    { const bf16_t* qp = proj + (size_t)(u.qrow0 + r32) * INW + u.qcol + hi * 8;
#pragma unroll
      for (int d0 = 0; d0 < 4; ++d0) qr[d0] = *(const bf16x8*)(qp + d0 * 16); }
    if (KIND == 0) { for (int i = lane; i < 15 * 31; i += 64) { const int a = i / 31, b = i - a * 31; tab[a * 32 + b] = u.rpb[i] * LOG2E; } }
    f32x16 o0, o1;
#pragma unroll
    for (int r = 0; r < 16; ++r) { o0[r] = 0.f; o1[r] = 0.f; }
    float l = (hi == 0) ? u.l0 : 0.f;
    const int nt = 4 + u.nloc;
    const int lrow = lane >> 3, lch = lane & 7;
    u32x4 kreg[8], vreg[8];
#define ATT_LOAD_TILE(t) do { const int row0_ = ((t) < 4) ? u.ctxrow0 + 64 * (t) : u.locrow0 + 64 * ((t) - 4); const bf16_t* bp_ = proj + (size_t)(row0_ + lrow) * INW + lch * 8; \
        _Pragma("unroll") for (int i_ = 0; i_ < 8; ++i_) { kreg[i_] = *(const u32x4*)(bp_ + (size_t)i_ * 8 * INW + u.kcol); vreg[i_] = *(const u32x4*)(bp_ + (size_t)i_ * 8 * INW + u.vcol); } } while (0)
    ATT_LOAD_TILE(0);
    LAS unsigned char* kw = wl + lrow * KROWB + lch * 16;
    LAS unsigned char* vw = wl + WL_V + lrow * VROWB + lch * 16;
    LAS const unsigned char* kf = wl + r32 * KROWB + hi * 16;
    LAS const unsigned char* vf = wl + WL_V + (4 * hi + ((lane & 15) >> 2)) * VROWB + ((lane >> 4) & 1) * 32 + (lane & 3) * 8;
    for (int t = 0; t < nt; ++t) {
#pragma unroll
        for (int i = 0; i < 8; ++i) { *(LAS u32x4*)(kw + i * 8 * KROWB) = kreg[i]; *(LAS u32x4*)(vw + i * 8 * VROWB) = vreg[i]; }
        if (t + 1 < nt) ATT_LOAD_TILE(t + 1);
        f32x16 p0, p1;
#pragma unroll
        for (int r = 0; r < 16; ++r) { p0[r] = 0.f; p1[r] = 0.f; }
#pragma unroll
        for (int d0 = 0; d0 < 4; ++d0) {
            const bf16x8 a0 = *(LAS const bf16x8*)(kf + d0 * 32), a1 = *(LAS const bf16x8*)(kf + 32 * KROWB + d0 * 32);
            p0 = __builtin_amdgcn_mfma_f32_32x32x16_bf16(a0, qr[d0], p0, 0, 0, 0);
            p1 = __builtin_amdgcn_mfma_f32_32x32x16_bf16(a1, qr[d0], p1, 0, 0, 0);
        }
        if (KIND == 0) { if (t >= 4) {
            const int dr = u.a0 + (t - 4), qc = u.a1 + r32; const int cs = min(max(qc - 8, 0), 48);
            const int kb = 4 * hi - cs; const volatile LAS float* tb = tab + dr * 32 + 15 - qc + 4 * hi;
#pragma unroll
            for (int r = 0; r < 16; ++r) { const int kc = (r & 3) + 8 * (r >> 2);
                const float b0_ = tb[kc], b1_ = tb[kc + 32];
                p0[r] = ((unsigned)(kb + kc) < 16u) ? p0[r] + b0_ : NEGBIG;
                p1[r] = ((unsigned)(kb + kc + 32) < 16u) ? p1[r] + b1_ : NEGBIG; } } }
        if (KIND == 1) { const int tb0_ = u.a0 + 64 * (t - 4);
          if (t >= 4 && (tb0_ < -97 || tb0_ > 65)) {
            const int d0_ = tb0_ + 4 * hi - r32 + 128;
#pragma unroll
            for (int r = 0; r < 16; ++r) { const int kc = (r & 3) + 8 * (r >> 2);
                p0[r] = ((unsigned)(d0_ + kc) <= 256u) ? p0[r] : NEGBIG;
                p1[r] = ((unsigned)(d0_ + kc + 32) <= 256u) ? p1[r] : NEGBIG; } } }
        if (u.negc != 0.f) {
#pragma unroll
            for (int r = 0; r < 16; ++r) { p0[r] += u.negc; p1[r] += u.negc; } }
        float rs = 0.f;
#pragma unroll
        for (int r = 0; r < 16; ++r) { p0[r] = __builtin_amdgcn_exp2f(p0[r]); p1[r] = __builtin_amdgcn_exp2f(p1[r]); rs += p0[r] + p1[r]; }
        l += rs;
        u32x4 pa[4];
#pragma unroll
        for (int j = 0; j < 4; ++j) { pa[0][j] = cvtpk(p0[2 * j], p0[2 * j + 1]); pa[1][j] = cvtpk(p0[8 + 2 * j], p0[8 + 2 * j + 1]); pa[2][j] = cvtpk(p1[2 * j], p1[2 * j + 1]); pa[3][j] = cvtpk(p1[8 + 2 * j], p1[8 + 2 * j + 1]); }
#pragma unroll
        for (int ks = 0; ks < 4; ++ks) {
            const s16x4 l0 = vtr(vf + ks * 16 * VROWB), h0 = vtr(vf + ks * 16 * VROWB + 8 * VROWB);
            const s16x4 l1 = vtr(vf + ks * 16 * VROWB + 64), h1 = vtr(vf + ks * 16 * VROWB + 8 * VROWB + 64);
            const bf16x8 b0 = (bf16x8){l0[0], l0[1], l0[2], l0[3], h0[0], h0[1], h0[2], h0[3]}, b1 = (bf16x8){l1[0], l1[1], l1[2], l1[3], h1[0], h1[1], h1[2], h1[3]};
            o0 = __builtin_amdgcn_mfma_f32_32x32x16_bf16(__builtin_bit_cast(bf16x8, pa[ks]), b0, o0, 0, 0, 0);
            o1 = __builtin_amdgcn_mfma_f32_32x32x16_bf16(__builtin_bit_cast(bf16x8, pa[ks]), b1, o1, 0, 0, 0);
        }
    }
#undef ATT_LOAD_TILE
    const float lt = pg8::sum_halves(l);
    if (hi == 0) sc[r32] = 1.0f / lt;
    bf16_t* ob = obuf + (size_t)u.qrow0 * DM + u.ocol + r32;
#pragma unroll
    for (int g = 0; g < 4; ++g) { const f32x4 a = *(LAS const f32x4*)(sc + 8 * g + 4 * hi);
#pragma unroll
        for (int i = 0; i < 4; ++i) { const int q = i + 8 * g + 4 * hi; bf16_t* op = ob + (size_t)q * DM;
            op[0] = (bf16_t)f2bf(o0[4 * g + i] * a[i]); op[32] = (bf16_t)f2bf(o1[4 * g + i] * a[i]); } }
}

__device__ __forceinline__ void attn_phase(LAS unsigned char* wl, const bf16_t* proj, bf16_t* obuf, const float* rpb_l, const float* sink_l, const float* cb_l, bool with_ctx, int gw, int ngw, int lane) {
    const float cb_na = fmaxf(cb_l[0] - 64.f, 0.f), cb_wa = fmaxf(cb_l[1] - 64.f, 0.f);
    const int total = 2048 + 4096 + (with_ctx ? 768 : 0);
    for (int i0 = gw; i0 < total; i0 += ngw) {
        int i = i0; AU u;
        if (i < 2048) {
            const int half = i & 1, h = (i >> 1) & 3, r = (i >> 3) & 31, b = i >> 8; const int rs = min(max(r - 4, 0), 24);
            u.qrow0 = b * SEQ + r * 64 + 32 * half; u.qcol = 64 * h; u.kcol = 256 + 64 * h; u.vcol = 512 + 64 * h; u.ocol = 64 * h; u.ctxrow0 = MLAT + b * CTXL;
            u.nloc = 8; u.locrow0 = b * SEQ + rs * 64; u.a0 = rs - r + 7; u.a1 = 32 * half; u.negc = -cb_na; u.l0 = 0.f; u.rpb = rpb_l + h * (15 * 31);
            attn_unit<0>(wl, proj, obuf, u, lane);
            continue;
        }
        i -= 2048;
        if (i < 4096) {
            const int ch = i & 63, h = (i >> 6) & 7, b = i >> 9; const int qpos0 = 32 * ch;
            const int kt0 = max(0, (qpos0 - 128) >> 6), kt1 = min(31, (qpos0 + 159) >> 6);
            u.qrow0 = b * SEQ + qpos0; u.qcol = 1536 + 64 * h; u.kcol = 2048 + 64 * (h >> 2); u.vcol = 2176 + 64 * (h >> 2); u.ocol = 512 + 64 * h; u.ctxrow0 = MLAT + b * CTXL;
            u.nloc = kt1 - kt0 + 1; u.locrow0 = b * SEQ + 64 * kt0; u.a0 = 64 * kt0 - qpos0; u.a1 = 0; u.negc = -cb_wa; u.l0 = __builtin_amdgcn_exp2f(sink_l[h] * LOG2E - cb_wa); u.rpb = nullptr;
            attn_unit<1>(wl, proj, obuf, u, lane);
            continue;
        }
        i -= 4096;
        if (i < 256) {
            const int ch = i & 7, h = (i >> 3) & 3, b = i >> 5;
            u.qrow0 = MLAT + b * CTXL + 32 * ch; u.qcol = 64 * h; u.kcol = 256 + 64 * h; u.vcol = 512 + 64 * h; u.ocol = 64 * h; u.negc = -cb_na; u.l0 = 0.f; u.ctxrow0 = MLAT + b * CTXL;
        } else {
            i -= 256; const int ch = i & 7, h = (i >> 3) & 7, b = i >> 6;
            u.qrow0 = MLAT + b * CTXL + 32 * ch; u.qcol = 1536 + 64 * h; u.kcol = 2048 + 64 * (h >> 2); u.vcol = 2176 + 64 * (h >> 2); u.ocol = 512 + 64 * h; u.negc = -cb_wa; u.l0 = __builtin_amdgcn_exp2f(sink_l[h] * LOG2E - cb_wa); u.ctxrow0 = MLAT + b * CTXL;
        }
        u.nloc = 0; u.locrow0 = 0; u.a0 = 0; u.a1 = 0; u.rpb = nullptr;
        attn_unit<2>(wl, proj, obuf, u, lane);
    }
}
}

__device__ __forceinline__ void prep_pass(const float* __restrict__ xlat, const float* __restrict__ xctx, const float* __restrict__ g, const float* __restrict__ modl, int scoff, bf16_t* __restrict__ hn, float* __restrict__ rs, int m_begin, int m_end, int m_step, int lane) {
#pragma unroll 2
    for (int m = m_begin; m < m_end; m += m_step) {
        const bool lat = m < MLAT; const float* xr = lat ? xlat + (size_t)m * DM : xctx + (size_t)(m - MLAT) * DM; const int b = lat ? (m >> 11) : 8;
        f32x4 v[4]; float ss = 0.f;
#pragma unroll
        for (int j = 0; j < 4; ++j) { v[j] = *(const f32x4*)(xr + 4 * lane + 256 * j); ss += (v[j][0] * v[j][0] + v[j][1] * v[j][1]) + (v[j][2] * v[j][2] + v[j][3] * v[j][3]); }
        ss = wave_sum(ss);
        if (lane < 16) rs[(size_t)m * 16 + lane] = (lane == 0) ? ss : 0.f;
        const float* mb = modl + (size_t)b * MODW;
#pragma unroll
        for (int j = 0; j < 4; ++j) { const int c = 4 * lane + 256 * j;
            const f32x4 gg = *(const f32x4*)(g + c), scv = *(const f32x4*)(mb + scoff + c);
            const f32x4 y = v[j] * gg * (scv + 1.0f);
            u32x2 w; w.x = pk2(y[0], y[1]); w.y = pk2(y[2], y[3]);
            *(u32x2*)(hn + (size_t)m * DM + c) = w; }
    }
}
__device__ __forceinline__ void ctx_rows_pass(const unsigned char* ws, float* ctxbuf, const float* gate, const float* gn, const float* scn, bf16_t* hn2, float* rs, int slab_mode, bool writeback, int gw, int ngw, int lane) {
    for (int r = gw; r < MCTX; r += ngw) {
        const int pmc = r >> 8, rl = r & 255; f32x4 x[4]; float ss = 0.f;
#pragma unroll
        for (int j = 0; j < 4; ++j) { const int c = 4 * lane + 256 * j; f32x4 p = {0.f, 0.f, 0.f, 0.f};
#pragma unroll
            for (int ks = 0; ks < 3; ++ks) p += *(const f32x4*)((const float*)(ws + pg8::slab_off((pmc * 4 + j) * 3 + ks, slab_mode)) + (size_t)rl * 256 + 4 * lane);
            x[j] = *(const f32x4*)(ctxbuf + (size_t)r * DM + c) + *(const f32x4*)(gate + c) * p;
            if (writeback) *(f32x4*)(ctxbuf + (size_t)r * DM + c) = x[j];
            ss += (x[j][0] * x[j][0] + x[j][1] * x[j][1]) + (x[j][2] * x[j][2] + x[j][3] * x[j][3]); }
        ss = wave_sum(ss);
        const int m = MLAT + r;
        if (lane < 16) rs[(size_t)m * 16 + lane] = (lane == 0) ? ss : 0.f;
#pragma unroll
        for (int j = 0; j < 4; ++j) { const int c = 4 * lane + 256 * j;
            const f32x4 y = x[j] * (*(const f32x4*)(gn + c)) * (*(const f32x4*)(scn + c) + 1.0f);
            u32x2 w; w.x = pk2(y[0], y[1]); w.y = pk2(y[2], y[3]);
            *(u32x2*)(hn2 + (size_t)m * DM + c) = w; }
    }
}

__device__ __forceinline__ void mix_pass(const bf16_t* __restrict__ proj, const bf16_t* __restrict__ obuf, const float* __restrict__ convw, const float* __restrict__ convb, const float* __restrict__ gout, bf16_t* __restrict__ abuf, int nrows, int gw, int ngw, int lane) {
#pragma unroll 2
    for (int m = gw; m < nrows; m += ngw) {
        float va[8];
        if (lane < 32) {
            const u32x4 raw = *(const u32x4*)(obuf + (size_t)m * DM + 8 * lane);
#pragma unroll
            for (int j = 0; j < 4; ++j) { va[2 * j] = bf_lo(raw[j]); va[2 * j + 1] = bf_hi(raw[j]); }
        } else {
            const int c = 8 * (lane - 32); const bool lat = m < MLAT; const int t = lat ? (m & (SEQ - 1)) : ((m - MLAT) & (CTXL - 1)); const int L = lat ? SEQ : CTXL;
            const bf16_t* pr = proj + (size_t)m * INW;
            const u32x4 cx = *(const u32x4*)(pr + 768 + c), cb = *(const u32x4*)(pr + 1024 + c), cc = *(const u32x4*)(pr + 1280 + c);
            u32x4 pxm = {0u, 0u, 0u, 0u}, pcm = {0u, 0u, 0u, 0u}, pxp = {0u, 0u, 0u, 0u}, pcp = {0u, 0u, 0u, 0u};
            if (t > 0) { pxm = *(const u32x4*)(pr - INW + 768 + c); pcm = *(const u32x4*)(pr - INW + 1280 + c); }
            if (t < L - 1) { pxp = *(const u32x4*)(pr + INW + 768 + c); pcp = *(const u32x4*)(pr + INW + 1280 + c); }
            const f32x4 w0a = *(const f32x4*)(convw + c), w0b = *(const f32x4*)(convw + c + 4), w1a = *(const f32x4*)(convw + 256 + c), w1b = *(const f32x4*)(convw + 256 + c + 4),
                        w2a = *(const f32x4*)(convw + 512 + c), w2b = *(const f32x4*)(convw + 512 + c + 4), bba = *(const f32x4*)(convb + c), bbb = *(const f32x4*)(convb + c + 4);
#pragma unroll
            for (int j = 0; j < 4; ++j) {
                const float w0l = j < 2 ? w0a[2 * j] : w0b[2 * j - 4], w0h = j < 2 ? w0a[2 * j + 1] : w0b[2 * j - 3];
                const float w1l = j < 2 ? w1a[2 * j] : w1b[2 * j - 4], w1h = j < 2 ? w1a[2 * j + 1] : w1b[2 * j - 3];
                const float w2l = j < 2 ? w2a[2 * j] : w2b[2 * j - 4], w2h = j < 2 ? w2a[2 * j + 1] : w2b[2 * j - 3];
                const float bl = j < 2 ? bba[2 * j] : bbb[2 * j - 4], bh = j < 2 ? bba[2 * j + 1] : bbb[2 * j - 3];
                const float ul = bf_lo(cc[j]) * bf_lo(cx[j]), uh = bf_hi(cc[j]) * bf_hi(cx[j]);
                const float uml = bf_lo(pcm[j]) * bf_lo(pxm[j]), umh = bf_hi(pcm[j]) * bf_hi(pxm[j]);
                const float upl = bf_lo(pcp[j]) * bf_lo(pxp[j]), uph = bf_hi(pcp[j]) * bf_hi(pxp[j]);
                va[2 * j] = bf_lo(cb[j]) * (bl + w0l * uml + w1l * ul + w2l * upl);
                va[2 * j + 1] = bf_hi(cb[j]) * (bh + w0h * umh + w1h * uh + w2h * uph);
            }
        }
        float ssa = 0.f;
#pragma unroll
        for (int j = 0; j < 8; ++j) ssa += va[j] * va[j];
        ssa = half_sum(ssa); const float rsa = 1.0f / sqrtf(ssa * (1.0f / 256.0f) + EPSN);
        { const f32x4 g0 = *(const f32x4*)(gout + 8 * lane), g1 = *(const f32x4*)(gout + 8 * lane + 4);
          u32x4 w; w.x = pk2(va[0] * rsa * g0[0], va[1] * rsa * g0[1]); w.y = pk2(va[2] * rsa * g0[2], va[3] * rsa * g0[3]); w.z = pk2(va[4] * rsa * g1[0], va[5] * rsa * g1[1]); w.w = pk2(va[6] * rsa * g1[2], va[7] * rsa * g1[3]);
          *(u32x4*)(abuf + (size_t)m * DM + 8 * lane) = w; }
        float vb[8];
        { const u32x4 raw = *(const u32x4*)(obuf + (size_t)m * DM + 512 + 8 * lane);
#pragma unroll
          for (int j = 0; j < 4; ++j) { vb[2 * j] = bf_lo(raw[j]); vb[2 * j + 1] = bf_hi(raw[j]); } }
        float ssb = 0.f;
#pragma unroll
        for (int j = 0; j < 8; ++j) ssb += vb[j] * vb[j];
        ssb = wave_sum(ssb); const float rsb = 1.0f / sqrtf(ssb * (1.0f / 512.0f) + EPSN);
        { const f32x4 g0 = *(const f32x4*)(gout + 512 + 8 * lane), g1 = *(const f32x4*)(gout + 512 + 8 * lane + 4);
          u32x4 w; w.x = pk2(vb[0] * rsb * g0[0], vb[1] * rsb * g0[1]); w.y = pk2(vb[2] * rsb * g0[2], vb[3] * rsb * g0[3]); w.z = pk2(vb[4] * rsb * g1[0], vb[5] * rsb * g1[1]); w.w = pk2(vb[6] * rsb * g1[2], vb[7] * rsb * g1[3]);
          *(u32x4*)(abuf + (size_t)m * DM + 512 + 8 * lane) = w; }
    }
}

__device__ __forceinline__ void mod_item(int item, const float* c, const float* cctx, const float* wmod, const float* bmod, float* mod, LAS unsigned char* lds, int tid, int wave, int lane) {
    LAS float* sl = (LAS float*)lds;
    LAS float* red = (LAS float*)(lds + 9 * 1024 * 4);
    const int l = item / 96, n0 = (item % 96) * 64;
    for (int i = tid; i < 9 * 1024; i += 512) { const int r = i >> 10, k = i & 1023; const float v = r < 8 ? c[r * 1024 + k] : cctx[k]; sl[i] = v / (1.0f + __expf(-v)); }
    __syncthreads();
    float acc[9];
#pragma unroll
    for (int r = 0; r < 9; ++r) acc[r] = 0.f;
    const float* wp = wmod + ((size_t)l * 1024 + wave * 128) * MODW + n0 + lane;
#pragma unroll 4
    for (int k = 0; k < 128; k += 4) {
        const float w0 = wp[(size_t)k * MODW], w1 = wp[(size_t)(k + 1) * MODW], w2 = wp[(size_t)(k + 2) * MODW], w3 = wp[(size_t)(k + 3) * MODW];
#pragma unroll
        for (int r = 0; r < 9; ++r) { const f32x4 s4 = *(LAS const f32x4*)(sl + r * 1024 + wave * 128 + k); acc[r] += (s4[0] * w0 + s4[1] * w1) + (s4[2] * w2 + s4[3] * w3); } }
#pragma unroll
    for (int r = 0; r < 9; ++r) red[(wave * 9 + r) * 64 + lane] = acc[r];
    __syncthreads();
    for (int i = tid; i < 9 * 64; i += 512) { const int r = i >> 6, ln = i & 63; float s = bmod[l * MODW + n0 + ln];
#pragma unroll
        for (int w = 0; w < 8; ++w) s += red[(w * 9 + r) * 64 + ln];
        mod[((size_t)l * 9 + r) * MODW + n0 + ln] = s; }
    __syncthreads();
}
__device__ __forceinline__ int rowmap_in(int c) {
    const int pn = c >> 8; if (pn >= 2 && pn <= 5) return c;
    const int wc = (c >> 6) & 3, d = c & 63, bj = d >> 5; const bool vhead = (pn == 8) && (wc >= 2);
    int n, fq; const int e = d & 3;
    if (!vhead) { n = (d >> 4) & 1; fq = (d >> 2) & 3; } else { fq = (d >> 3) & 3; n = (d >> 2) & 1; }
    return pn * 256 + bj * 128 + wc * 32 + fq * 8 + n * 4 + e;
}
template <bool MAPIN> __device__ __forceinline__ void bias_item(const float* W, int ldw, int n0, const float* shrows  , float* out  , LAS unsigned char* lds, int tid, int wave, int lane) {
    LAS float* sl = (LAS float*)lds;
    LAS float* red = (LAS float*)(lds + 9 * 1024 * 4);
    for (int i = tid; i < 9 * 1024; i += 512) { const int r = i >> 10, k = i & 1023; sl[i] = shrows[(size_t)r * MODW + k]; }
    __syncthreads();
    float acc[9];
#pragma unroll
    for (int r = 0; r < 9; ++r) acc[r] = 0.f;
    const float* wp = W + (size_t)(wave * 128) * ldw + n0 + lane;
#pragma unroll 4
    for (int k = 0; k < 128; k += 4) {
        const float w0 = wp[(size_t)k * ldw], w1 = wp[(size_t)(k + 1) * ldw], w2 = wp[(size_t)(k + 2) * ldw], w3 = wp[(size_t)(k + 3) * ldw];
#pragma unroll
        for (int r = 0; r < 9; ++r) { const f32x4 s4 = *(LAS const f32x4*)(sl + r * 1024 + wave * 128 + k); acc[r] += (s4[0] * w0 + s4[1] * w1) + (s4[2] * w2 + s4[3] * w3); } }
#pragma unroll
    for (int r = 0; r < 9; ++r) red[(wave * 9 + r) * 64 + lane] = acc[r];
    __syncthreads();
    for (int i = tid; i < 9 * 64; i += 512) { const int r = i >> 6, ln = i & 63; float s = 0.f;
#pragma unroll
        for (int w = 0; w < 8; ++w) s += red[(w * 9 + r) * 64 + ln];
        const int n = n0 + ln; out[(size_t)r * ldw + (MAPIN ? rowmap_in(n) : n)] = s; }
    __syncthreads();
}
template <bool MAPIN> __device__ __forceinline__ void transpose_item(const float* W, int K, int N, bf16_t* WT, LAS float* scr, int item, int lane) {
    const int nblk = N / 32, kb = item / nblk, nb = item % nblk, k0 = 64 * kb, n0 = 32 * nb;
#pragma unroll
    for (int i = 0; i < 32; ++i) { const int kk = 2 * i + (lane >> 5); scr[kk * 33 + (lane & 31)] = W[(size_t)(k0 + kk) * N + n0 + (lane & 31)]; }
    asm volatile("s_waitcnt lgkmcnt(0)" ::: "memory");
    const int c = lane & 7;
#pragma unroll
    for (int j = 0; j < 4; ++j) { const int n = (lane >> 3) + 8 * j; const LAS float* s = scr + (8 * c) * 33 + n;
        u32x4 o; o.x = pk2(s[0 * 33], s[1 * 33]); o.y = pk2(s[2 * 33], s[3 * 33]); o.z = pk2(s[4 * 33], s[5 * 33]); o.w = pk2(s[6 * 33], s[7 * 33]);
        const int orow = MAPIN ? rowmap_in(n0 + n) : (n0 + n);
        *(u32x4*)(WT + (size_t)orow * K + k0 + 8 * c) = o; }
    asm volatile("s_waitcnt lgkmcnt(0)" ::: "memory");
}

#define XB_TMO      128
#define XB_XCNT(j)  (256  + 64 * (j))
#define XB_XSUB(j)  (1280 + 64 * (j))
#define XB_XGEN(j)  (2304 + 64 * (j))
#define XB_TOP      3328
#define XB_TOPGEN   3392
#define XCD_BAR_WORDS 3456
#define XB_SPIN_CAP (1u << 18)

__device__ __forceinline__ unsigned xb_ld(unsigned* p)              { return __hip_atomic_load(p, __ATOMIC_RELAXED, __HIP_MEMORY_SCOPE_AGENT); }
__device__ __forceinline__ unsigned xb_add(unsigned* p, unsigned v) { return __hip_atomic_fetch_add(p, v, __ATOMIC_RELAXED, __HIP_MEMORY_SCOPE_AGENT); }
__device__ __forceinline__ unsigned xb_xcc_id() { return (unsigned)__builtin_amdgcn_s_getreg((3 << 11) | 20) & 0xFu; }
#define XB_SPIN(cond, bar) do { unsigned _sp = 0; while (cond) { __builtin_amdgcn_s_sleep(1); \
    if ((++_sp & 255u) == 0u) { if (xb_ld(&(bar)[XB_TMO])) break; if (_sp > XB_SPIN_CAP) { atomicAdd(&(bar)[XB_TMO], 1u); break; } } } } while (0)

struct XcdBarrier {
    unsigned* bar; unsigned x; bool t0;
    volatile LAS unsigned* st;
};

__device__ __forceinline__ XcdBarrier xcd_barrier_post(unsigned* bar, volatile LAS unsigned* st) {
    XcdBarrier b; b.bar = bar; b.x = xb_xcc_id(); b.st = st; b.t0 = (threadIdx.x == 0);
    if (threadIdx.x == 0) (void)xb_add(&bar[XB_XCNT(b.x)], 1u);
    return b;
}
__device__ __forceinline__ void xcd_barrier_complete(unsigned* bar, unsigned x, unsigned& nloc, unsigned& nx) {
    const unsigned G = gridDim.x * gridDim.y * gridDim.z;
    unsigned sum, cnt, mine, sp = 0u;
    for (;;) {
        sum = 0u; cnt = 0u; mine = 0u;
#pragma unroll
        for (unsigned j = 0; j < 16; ++j) { const unsigned c = xb_ld(&bar[XB_XCNT(j)]); sum += c; cnt += (c > 0u) ? 1u : 0u; mine = (j == x) ? c : mine; }
        if (sum == G) break;
        __builtin_amdgcn_s_sleep(1);
        if ((++sp & 255u) == 0u) { if (xb_ld(&bar[XB_TMO])) break; if (sp > XB_SPIN_CAP) { atomicAdd(&bar[XB_TMO], 1u); break; } }
    }
    nloc = mine > 0u ? mine : 1u; nx = cnt > 0u ? cnt : 1u;
}

__device__ __forceinline__ void xcd_barrier(const XcdBarrier& b) {
    asm volatile("s_waitcnt vmcnt(0)" ::: "memory");
    __syncthreads();
    if (b.t0) {
        unsigned* bar = b.bar;
        __builtin_amdgcn_s_waitcnt(0);
        unsigned nloc = b.st[0], nx = b.st[1];
        if (nloc == 0u) { xcd_barrier_complete(bar, b.x, nloc, nx); b.st[0] = nloc; b.st[1] = nx; }
        const unsigned old = xb_add(&bar[XB_XSUB(b.x)], 1u);
        const unsigned gen = old / nloc;
        if (old + 1u == (gen + 1u) * nloc) {
            __builtin_amdgcn_fence(__ATOMIC_RELEASE, "agent");
            asm volatile("s_waitcnt vmcnt(0)" ::: "memory");
            const unsigned og = xb_add(&bar[XB_TOP], 1u);
            const unsigned tg = og / nx;
            if (og + 1u == (tg + 1u) * nx) xb_add(&bar[XB_TOPGEN], 1u);
            else XB_SPIN(xb_ld(&bar[XB_TOPGEN]) == tg, bar);
            __builtin_amdgcn_fence(__ATOMIC_ACQUIRE, "agent");
            xb_add(&bar[XB_XGEN(b.x)], 1u);
            asm volatile("s_waitcnt vmcnt(0)" ::: "memory");
        } else {
            XB_SPIN(xb_ld(&bar[XB_XGEN(b.x)]) == gen, bar);
            __builtin_amdgcn_fence(__ATOMIC_ACQUIRE, "agent");
            asm volatile("s_waitcnt vmcnt(0)" ::: "memory");
        }
    }
    __syncthreads();
}

constexpr int LDS_ST_OFF = 8 * att::WAVE_LDS + 512;
constexpr int LDS_BYTES = LDS_ST_OFF + 64;
static_assert(LDS_BYTES <= 160 * 1024 && LDS_BYTES >= pg8::STAGE_BYTES, "LDS budget");
constexpr int N_PHASES = 16;
struct Params { const float* in[21]; float* out; unsigned char* ws; int ph_lo, ph_hi; };

#ifndef REPMASK
#define REPMASK 0
#endif
#ifndef DRYMASK
#define DRYMASK 0
#endif
#define DRY(k) ((((DRYMASK) >> (k)) & 1) && rep_ == 0)
#ifndef PROBE_PHASE
#define PROBE_PHASE (-1)
#endif
#define PROBE_MULT 8
#ifndef EXTRA_SYNC
#define EXTRA_SYNC 0
#endif
__global__ void __launch_bounds__(512, 2) fwd_kernel(Params P) {
    extern __shared__ __attribute__((aligned(16))) unsigned char lds_raw[];
    LAS unsigned char* lds = (LAS unsigned char*)lds_raw;
    {   volatile LAS unsigned* bst0 = (volatile LAS unsigned*)(lds + LDS_ST_OFF);
        if (threadIdx.x < 16) bst0[threadIdx.x] = 0u;
        __syncthreads();
        (void)xcd_barrier_post((unsigned*)(P.ws + WS_BAR), bst0); }
#define GRID_SYNC() do { unsigned* bp_ = (unsigned*)(P.ws + WS_BAR); asm volatile("" : "+s"(bp_)); XcdBarrier b_; b_.bar = bp_; b_.x = xb_xcc_id(); b_.st = (volatile LAS unsigned*)(lds + LDS_ST_OFF); b_.t0 = (wave == 0) && (pg8::lane_id() == 0); xcd_barrier(b_); } while (0)
#define LANE_OPAQUE int ln_ = pg8::lane_id(); asm volatile("" : "+v"(ln_)); const int tid_ = wave * 64 + ln_; (void)tid_
#define WSP(T, off) ((T*)(ws + (off)))
#define MODL (WSP(const float, WS_MOD) + (size_t)ly * 9 * MODW)
#define XL ((ly == 0) ? P.in[0] : (const float*)P.out)
#define CL ((ly == 0) ? P.in[2] : WSP(const float, WS_CTX))
#define MROWS ((ly == 0) ? MALL : MLAT)
    const int ph_hi = P.ph_hi;
    const int wave = __builtin_amdgcn_readfirstlane(threadIdx.x >> 6);
#pragma unroll 1
    for (int ph = P.ph_lo; ph < ph_hi; ++ph) {
        int phv = ph; asm volatile("" : "+s"(phv));
        const __attribute__((address_space(4))) Params* pp_ = (const __attribute__((address_space(4))) Params*)__builtin_amdgcn_kernarg_segment_ptr(); asm volatile("" : "+s"(pp_));
#define P (*pp_)
        int kind = 0, ly = 0;
        if (phv >= 1) { const int idx = phv - 1; if (idx < 9) { kind = idx + 1; } else { const int j = idx - 9; ly = 1; kind = j + 2 + (j >= 4 ? 1 : 0); } }
        int G_ = gridDim.x, bx_ = blockIdx.x; asm volatile("" : "+s"(G_), "+s"(bx_));
        const int G = G_, bx = bx_; const int vcu = (G % 8 == 0) ? (bx % 8) * (G / 8) + bx / 8 : bx; const int gw = vcu * 8 + wave, ngw = G * 8;
        unsigned char* ws = P.ws;
        if (PROBE_PHASE >= 0 && ph == PROBE_PHASE && blockIdx.x == 0 && wave == 0 && pg8::lane_id() == 0) { const unsigned long long t_ = __builtin_amdgcn_s_memrealtime(); volatile LAS unsigned* pw_ = (volatile LAS unsigned*)(lds + LDS_ST_OFF + 32); pw_[0] = (unsigned)t_; pw_[1] = (unsigned)(t_ >> 32); }
#pragma unroll 1
        for (int rep_ = 0; rep_ <= (((REPMASK | DRYMASK) >> kind) & 1); ++rep_) {
        if (rep_) GRID_SYNC();
        switch (kind) {
        case 0: { LANE_OPAQUE;
            if (bx == G - 1) {
                LAS unsigned* red = (LAS unsigned*)lds;
                if (tid_ < 16) red[tid_] = 0u;
                __syncthreads();
                for (int l2 = 0; l2 < 2; ++l2) {
                    if (tid_ < 256) { const int k = tid_ >> 6, d = tid_ & 63; const float* src = P.in[k == 0 ? 9 : k == 1 ? 10 : k == 2 ? 14 : 15]; atomicMax((unsigned*)(red + l2 * 5 + k), __builtin_bit_cast(unsigned, fabsf(src[l2 * 64 + d]))); }
                    for (int i = tid_; i < 4 * 15 * 31; i += 512) atomicMax((unsigned*)(red + l2 * 5 + 4), __builtin_bit_cast(unsigned, fabsf(P.in[11][(size_t)l2 * 4 * 15 * 31 + i])));
                }
                __syncthreads();
                if (tid_ < 2) { const int l2 = tid_; const float gq = __builtin_bit_cast(float, red[l2 * 5 + 0]), gk = __builtin_bit_cast(float, red[l2 * 5 + 1]), wq = __builtin_bit_cast(float, red[l2 * 5 + 2]), wk = __builtin_bit_cast(float, red[l2 * 5 + 3]), rb = __builtin_bit_cast(float, red[l2 * 5 + 4]);
                    WSP(float, WS_GAIN)[512 + 2 * l2] = 11.5416f * gq * gk + rb * LOG2E + 0.25f; WSP(float, WS_GAIN)[512 + 2 * l2 + 1] = 11.5416f * wq * wk + 0.25f; }
                __syncthreads();
            }
            if (bx == G - 1) { for (int i = tid_; i < 512; i += 512) { const int l2 = i >> 8, k = (i >> 6) & 3, d = i & 63; const float* src = P.in[k == 0 ? 9 : k == 1 ? 10 : k == 2 ? 14 : 15]; WSP(float, WS_GAIN)[i] = src[l2 * 64 + d]; } }
            if (bx < 192) mod_item(bx, P.in[1], P.in[3], P.in[4], P.in[5], WSP(float, WS_MOD), lds, tid_, wave, ln_);
            LAS float* scr = (LAS float*)(lds + wave * 16384);
            constexpr int I_IN = 16 * (INW / 32), I_O = 16 * (DM / 32), I_1 = 16 * (FFN / 32), I_2 = 64 * (DM / 32), I_L = I_IN + I_O + I_1 + I_2;
            const bool bal_ = (G == 256); const int it0 = bal_ ? ((bx < 192) ? 33 * bx : 6336 + 81 * (bx - 192)) + wave : gw, it1 = bal_ ? ((bx < 192) ? 33 * bx + 33 : 6336 + 81 * (bx - 192) + 81) : 2 * I_L, its = bal_ ? 8 : ngw;
            static_assert(192 * 33 + 64 * 81 == 2 * I_L, "transpose item split");
            for (int it = it0; it < it1; it += its) {
                const int l2 = it / I_L; int r = it - l2 * I_L;
                if (r < I_IN) { transpose_item<true>(P.in[8] + (size_t)l2 * DM * INW, DM, INW, WSP(bf16_t, WS_WIN) + (size_t)l2 * INW * DM, scr, r, ln_); continue; } r -= I_IN;
                if (r < I_O) { transpose_item<false>(P.in[18] + (size_t)l2 * DM * DM, DM, DM, WSP(bf16_t, WS_WO) + (size_t)l2 * DM * DM, scr, r, ln_); continue; } r -= I_O;
                if (r < I_1) { transpose_item<false>(P.in[19] + (size_t)l2 * DM * FFN, DM, FFN, WSP(bf16_t, WS_W1) + (size_t)l2 * FFN * DM, scr, r, ln_); continue; } r -= I_1;
                transpose_item<false>(P.in[20] + (size_t)l2 * FFN * DM, FFN, DM, WSP(bf16_t, WS_W2) + (size_t)l2 * DM * FFN, scr, r, ln_);
            }
        } break;
        case 1: { LANE_OPAQUE;
            for (int it = bx; it < 200; it += G) { const int l2 = it / 100, c = it % 100; const float* m2 = WSP(const float, WS_MOD) + (size_t)l2 * 9 * MODW;
                if (c < 36) bias_item<true>(P.in[8] + (size_t)l2 * DM * INW, INW, c * 64, m2, WSP(float, WS_BIN) + (size_t)l2 * 9 * INW, lds, tid_, wave, ln_);
                else bias_item<false>(P.in[19] + (size_t)l2 * DM * FFN, FFN, (c - 36) * 64, m2 + 3 * DM, WSP(float, WS_B1) + (size_t)l2 * 9 * FFN, lds, tid_, wave, ln_); }
            if (G == 256) { const int rb = (bx < 200) ? 59 * bx : min(MALL, 11800 + 119 * (bx - 200)), re = (bx < 200) ? rb + 59 : min(MALL, rb + 119);
                prep_pass(P.in[0], P.in[2], P.in[6], WSP(const float, WS_MOD), DM, WSP(bf16_t, WS_HN2), WSP(float, WS_RS1), rb + wave, re, 8, ln_); }
            else prep_pass(P.in[0], P.in[2], P.in[6], WSP(const float, WS_MOD), DM, WSP(bf16_t, WS_HN2), WSP(float, WS_RS1), gw, MALL, ngw, ln_);
        } break;
        case 2: { LANE_OPAQUE;
            pg8::Gemm g{WSP(bf16_t, WS_HN2), WSP(bf16_t, WS_WIN) + (size_t)ly * INW * DM, MALL, INW, DM}; pg8::StaticOrder S; S.init(MALL, INW, G, bx);
            pg8::EpiProj E{WSP(bf16_t, WS_PROJ), WSP(const float, WS_GAIN) + ly * 256, WSP(const float, WS_RS1), WSP(const float, WS_BIN) + (size_t)ly * 9 * INW};
            pg8::gemm_phase<pg8::EpiProj, pg8::StaticOrder, true, true>(lds, g, S, E, wave);
        } break;
        case 3: { LANE_OPAQUE;
            att::attn_phase(lds + wave * att::WAVE_LDS + 256, WSP(bf16_t, WS_PROJ), WSP(bf16_t, WS_OB), P.in[11] + (size_t)ly * 4 * 15 * 31, P.in[16] + ly * 8, WSP(const float, WS_GAIN) + 512 + 2 * ly, ly == 0, gw, ngw, ln_);
        } break;
        case 4: { LANE_OPAQUE;
            mix_pass(WSP(bf16_t, WS_PROJ), WSP(bf16_t, WS_OB), P.in[12] + (size_t)ly * 3 * 256, P.in[13] + ly * 256, P.in[17] + ly * DM, WSP(bf16_t, WS_HN), MROWS, gw, ngw, ln_);
        } break;
        case 5: { LANE_OPAQUE;
            pg8::Gemm g{WSP(bf16_t, WS_HN), WSP(bf16_t, WS_WO) + (size_t)ly * DM * DM, MROWS, DM, DM};
            if (ly == 0) {
                pg8::SplitOrder S; S.init(G, bx, 4);
                pg8::EpiResid E{P.in[0], P.in[2], P.out, WSP(float, WS_CTX), MODL + 2 * DM, WSP(bf16_t, WS_HN2), P.in[7], MODL + 4 * DM, WSP(float, WS_RS2), DRY(5), (float*)ws, true, 1};
                pg8::gemm_phase<pg8::EpiResid, pg8::SplitOrder, true, true>(lds, g, S, E, wave);
            } else {
                pg8::StaticOrder S; S.init(MROWS, DM, G, bx);
                pg8::EpiResid E{(const float*)P.out, WSP(const float, WS_CTX), P.out, WSP(float, WS_CTX), MODL + 2 * DM, WSP(bf16_t, WS_HN2), P.in[7] + ly * DM, MODL + 4 * DM, WSP(float, WS_RS2), DRY(5), nullptr, false, 0};
                pg8::gemm_phase<pg8::EpiResid, pg8::StaticOrder, true, true>(lds, g, S, E, wave);
            }
        } break;
        case 6: { LANE_OPAQUE;
            ctx_rows_pass(ws, WSP(float, WS_CTX), WSP(const float, WS_MOD) + (size_t)8 * MODW + 2 * DM, P.in[7], WSP(const float, WS_MOD) + (size_t)8 * MODW + 4 * DM, WSP(bf16_t, WS_HN2), WSP(float, WS_RS2), 1, true, gw, ngw, ln_);
        } break;
        case 7: { LANE_OPAQUE;
            pg8::Gemm g{WSP(bf16_t, WS_HN2), WSP(bf16_t, WS_W1) + (size_t)ly * FFN * DM, MROWS, FFN, DM}; pg8::StaticOrder S; S.init(MROWS, FFN, G, bx);
            pg8::EpiFc1 E{WSP(bf16_t, WS_H1), FFN, WSP(const float, WS_RS2), WSP(const float, WS_B1) + (size_t)ly * 9 * FFN};
            pg8::gemm_phase<pg8::EpiFc1, pg8::StaticOrder, true, true>(lds, g, S, E, wave);
        } break;
        case 8: { LANE_OPAQUE;
            pg8::Gemm g{WSP(bf16_t, WS_H1), WSP(bf16_t, WS_W2) + (size_t)ly * DM * FFN, MROWS, DM, FFN};
            if (ly == 0) {
                pg8::SplitOrder S; S.init(G, bx, 16);
                pg8::EpiResid E{P.out, WSP(float, WS_CTX), P.out, WSP(float, WS_CTX), MODL + 5 * DM, WSP(bf16_t, WS_HN2), P.in[6] + DM, WSP(const float, WS_MOD) + (size_t)9 * MODW + DM, WSP(float, WS_RS1), DRY(8), (float*)ws, true, 0};
                pg8::gemm_phase<pg8::EpiResid, pg8::SplitOrder, true, true>(lds, g, S, E, wave);
            } else {
                pg8::StaticOrder S; S.init(MROWS, DM, G, bx);
                pg8::EpiResid E{P.out, WSP(float, WS_CTX), P.out, WSP(float, WS_CTX), MODL + 5 * DM, (bf16_t*)nullptr, nullptr, nullptr, nullptr, DRY(8), nullptr, false, 0};
                pg8::gemm_phase<pg8::EpiResid, pg8::StaticOrder, true, true>(lds, g, S, E, wave);
            }
        } break;
        default: { LANE_OPAQUE;
            ctx_rows_pass(ws, WSP(float, WS_CTX), WSP(const float, WS_MOD) + (size_t)8 * MODW + 5 * DM, P.in[6] + DM, WSP(const float, WS_MOD) + (size_t)(9 + 8) * MODW + DM, WSP(bf16_t, WS_HN2), WSP(float, WS_RS1), 0, false, gw, ngw, ln_);
        } break;
        }
        }
        for (int es_ = 0; es_ < EXTRA_SYNC; ++es_) GRID_SYNC();
        if (ph + 1 < ph_hi) GRID_SYNC();
        if (PROBE_PHASE >= 0 && ph == PROBE_PHASE && blockIdx.x == 0 && wave == 0 && pg8::lane_id() == 0) { const unsigned long long t_ = __builtin_amdgcn_s_memrealtime(); volatile LAS unsigned* pw_ = (volatile LAS unsigned*)(lds + LDS_ST_OFF + 32); pw_[2] = (unsigned)t_; pw_[3] = (unsigned)(t_ >> 32); }
#undef P
    }
    if (PROBE_PHASE >= 0 && blockIdx.x == 0 && wave == 0 && pg8::lane_id() == 0) {
        volatile LAS unsigned* pw_ = (volatile LAS unsigned*)(lds + LDS_ST_OFF + 32);
        const unsigned long long a_ = ((unsigned long long)pw_[1] << 32) | pw_[0], b_ = ((unsigned long long)pw_[3] << 32) | pw_[2];
        const unsigned long long span_ = (b_ - a_) * PROBE_MULT; const unsigned long long t0_ = __builtin_amdgcn_s_memrealtime();
        if (span_ < 100000000ull) while (__builtin_amdgcn_s_memrealtime() - t0_ < span_) __builtin_amdgcn_s_sleep(8);
    }
}

#ifndef MK_MULTI_LAUNCH
#define MK_MULTI_LAUNCH 0
#endif
extern "C" void kernel_launch(void* const* d_in, const int* in_sizes, int n_in, void* d_out, int out_size, void* d_ws, size_t ws_size, hipStream_t stream) {
    static int grid = 0;
    if (grid == 0) {
        if (n_in != 21 || out_size != MLAT * DM || ws_size < WS_END) { fprintf(stderr, "kernel_launch: unexpected shapes (n_in %d out %d ws %zu)\n", n_in, out_size, ws_size); grid = -1; return; }
        int dev = 0, cus = 0, per_cu = 0;
        if (hipGetDevice(&dev) != hipSuccess || hipDeviceGetAttribute(&cus, hipDeviceAttributeMultiprocessorCount, dev) != hipSuccess) { grid = -1; return; }
        if (hipFuncSetAttribute((const void*)fwd_kernel, hipFuncAttributeMaxDynamicSharedMemorySize, LDS_BYTES) != hipSuccess) { fprintf(stderr, "kernel_launch: hipFuncSetAttribute failed\n"); grid = -1; return; }
        if (hipOccupancyMaxActiveBlocksPerMultiprocessor(&per_cu, (const void*)fwd_kernel, 512, LDS_BYTES) != hipSuccess || per_cu < 1) { fprintf(stderr, "kernel_launch: occupancy query gave %d\n", per_cu); (void)hipGetLastError(); grid = -1; return; }
        grid = cus * per_cu;
    }
    if (grid < 0) return;
    Params p{};
    for (int i = 0; i < 21; ++i) p.in[i] = (const float*)d_in[i];
    p.out = (float*)d_out; p.ws = (unsigned char*)d_ws;
    if (hipMemsetAsync((char*)d_ws + WS_BAR, 0, XCD_BAR_WORDS * 4, stream) != hipSuccess) { fprintf(stderr, "kernel_launch: memset of the barrier words failed\n"); return; }
    void* args[] = {&p};
#if MK_MULTI_LAUNCH
    for (int ph = 0; ph < N_PHASES; ++ph) { p.ph_lo = ph; p.ph_hi = ph + 1;
        hipError_t e = hipLaunchCooperativeKernel((const void*)fwd_kernel, dim3(grid), dim3(512), args, LDS_BYTES, stream);
        if (e != hipSuccess) { fprintf(stderr, "launch %d failed: %s\n", ph, hipGetErrorString(e)); break; } }
#else
    p.ph_lo = 0; p.ph_hi = N_PHASES;
    hipError_t e = hipLaunchCooperativeKernel((const void*)fwd_kernel, dim3(grid), dim3(512), args, LDS_BYTES, stream);
    if (e != hipSuccess) fprintf(stderr, "cooperative launch failed: %s (grid %d)\n", hipGetErrorString(e), grid);
#endif
}
```

```cpp
#include <hip/hip_runtime.h>
#include <cstdio>
#include <cstdint>
namespace pg8 {
#define PG8_LAS __attribute__((address_space(3)))
typedef unsigned short bf16_t;
__device__ __forceinline__ int lane_id() { int r; asm volatile("v_mbcnt_lo_u32_b32 %0, -1, 0\n\tv_mbcnt_hi_u32_b32 %0, -1, %0" : "=v"(r)); return r; }
template <int K> __device__ __forceinline__ float shx(float v) { static_assert(K == 1 || K == 2 || K == 4 || K == 8 || K == 16, "xor mask"); return __builtin_bit_cast(float, __builtin_amdgcn_ds_swizzle(__builtin_bit_cast(int, v), 0x1f | (K << 10))); }
__device__ __forceinline__ void swap_halves(float& a, float& b) { asm("s_nop 1\n\tv_permlane32_swap_b32 %0, %1" : "+v"(a), "+v"(b)); }
__device__ __forceinline__ float sum_halves(float v) { float a = v, b = v; swap_halves(a, b); return a + b; }
__device__ __forceinline__ float max_halves(float v) { float a = v, b = v; swap_halves(a, b); return fmaxf(a, b); }
typedef short bf16x8 __attribute__((ext_vector_type(8)));
typedef float f32x4 __attribute__((ext_vector_type(4)));
typedef unsigned u32x4 __attribute__((ext_vector_type(4)));
constexpr int BM = 256, BK = 64, HALF = 128, HTB = HALF * BK * 2  , STAGE_BYTES = 8 * HTB, NXCD = 8, WGM = 8;

__host__ __device__ __forceinline__ int lds_byte(int r, int c) { const int st = (r >> 4) * 2 + (c >> 5), rr = r & 15, cc = c & 31, ob = rr * 64 + cc * 2; return st * 1024 + (ob ^ (((ob >> 9) & 1) << 5)); }
__host__ __device__ __forceinline__ void stage_rc(int b, int& R, int& C) { const int st = b / 1024, sb = b % 1024, swz = sb ^ (((sb >> 9) & 1) << 5); R = (st >> 1) * 16 + swz / 64; C = (st & 1) * 32 + (swz % 64) / 2; }
__host__ __device__ __forceinline__ int perm32(int rho) { const int n = rho >> 4, i = rho & 15; return 8 * (i >> 2) + 4 * n + (i & 3); }

struct Unit { int pm, pn, k0t, nt, ks; };
struct Gemm { const bf16_t* A; const bf16_t* Bt; int M, N, K; };

struct StaticOrder {
    int nM, nN, nwg, G, c;
    __host__ __device__ void init(int M, int N, int G_, int c_) { nM = M / BM; nN = N / BM; nwg = nM * nN; G = G_; c = c_; }
    __host__ __device__ __forceinline__ bool next(int i, Unit& u) const {
        const long L = (long)i * G + c; if (L >= nwg) { u.pm = 0; u.pn = 0; u.k0t = 0; u.nt = 0; u.ks = 0; return false; }
        int wgid = (int)L; { const int q = nwg / NXCD, r = nwg % NXCD, xcd = wgid % NXCD, off = wgid / NXCD; wgid = (xcd < r ? xcd * (q + 1) : r * (q + 1) + (xcd - r) * q) + off; }
        const int nig = WGM * nN, gid = wgid / nig, fm = gid * WGM, gsz = (nM - fm) < WGM ? (nM - fm) : WGM;
        u.pm = fm + ((wgid % nig) % gsz); u.pn = (wgid % nig) / gsz; u.k0t = 0; u.nt = 0; u.ks = 0; return true;
    }
    __device__ __forceinline__ void a_ready(const Unit&) const {}
    __device__ __forceinline__ void done(const Unit&) const {}
};
__device__ __forceinline__ unsigned cvt_pk_bf16(float lo, float hi) { unsigned r; asm volatile("v_cvt_pk_bf16_f32 %0, %1, %2" : "=v"(r) : "v"(lo), "v"(hi)); return r; }
typedef float f32x2 __attribute__((ext_vector_type(2)));
template <class Epi, class Sched, bool ALIGN_EPI = false, bool SP2 = false>
__device__ __forceinline__ void gemm_phase(PG8_LAS unsigned char* lds, const Gemm g, const Sched& S, const Epi& E, const int wid_in) {
    int tid_ = wid_in * 64 + lane_id(); asm volatile("" : "+v"(tid_));
    const int tid = tid_, wid = __builtin_amdgcn_readfirstlane(tid >> 6), lane = tid & 63, wr = wid >> 2, wc = wid & 3, fr = lane & 15, fq = lane >> 4;
    const int K = g.K, nt_all = K / BK;
    unsigned voffA[2], voffB[2];
#pragma unroll
    for (int i = 0; i < 2; ++i) { int R, C; stage_rc(tid * 16 + i * 8192, R, C); const int Rb = Epi::PERM ? ((R & ~31) + perm32(R & 31)) : R;
        voffA[i] = (unsigned)(R * K + C) * 2u; voffB[i] = (unsigned)(Rb * K + C) * 2u; }
    const size_t kstep = (size_t)(BK * 2);
    const size_t hstep = (size_t)HALF * K * 2;
    const size_t tstep = 2 * hstep;
    const unsigned ldsw = (unsigned)wid * 1024u;
    const int aoff = lds_byte(wr * 64 + fr, fq * 8), boff = lds_byte(wc * 32 + fr, fq * 8);
#define PG8_SA(b, h) (((b) * 2 + (h)) * HTB)
#define PG8_SB(b, h) ((4 + (b) * 2 + (h)) * HTB)
#define PG8_STAGE(bufoff, gbase, voff) do { _Pragma("unroll") for (int _i = 0; _i < 2; ++_i) \
        __builtin_amdgcn_global_load_lds((const unsigned*)((const char*)(gbase) + (voff)[_i]), (PG8_LAS unsigned*)(lds + (bufoff) + ldsw + _i * 8192), 16, 0, 0); } while (0)
#define PG8_LDA(dst, b, h) do { _Pragma("unroll") for (int m = 0; m < 4; ++m) _Pragma("unroll") for (int k = 0; k < 2; ++k) dst[m][k] = *(const PG8_LAS bf16x8*)(lds + PG8_SA(b, h) + aoff + m * 2048 + k * 1024); } while (0)
#define PG8_LDB(dst, b, h) do { _Pragma("unroll") for (int n = 0; n < 2; ++n) _Pragma("unroll") for (int k = 0; k < 2; ++k) dst[n][k] = *(const PG8_LAS bf16x8*)(lds + PG8_SB(b, h) + boff + n * 2048 + k * 1024); } while (0)
#define PG8_MMA(ai, bj, At, Bt) do { __builtin_amdgcn_s_setprio(1); _Pragma("unroll") for (int m = 0; m < 4; ++m) _Pragma("unroll") for (int n = 0; n < 2; ++n) _Pragma("unroll") for (int k = 0; k < 2; ++k) \
        acc[ai][bj][m][n] = __builtin_amdgcn_mfma_f32_16x16x32_bf16(Bt[n][k], At[m][k], acc[ai][bj][m][n], 0, 0, 0); __builtin_amdgcn_s_setprio(0); } while (0)
#define PG8_WAIT_V(n) asm volatile("s_waitcnt vmcnt(" #n ")" ::: "memory")
#define PG8_WAIT_L(n) asm volatile("s_waitcnt lgkmcnt(" #n ")" ::: "memory")
#define PG8_BAR __builtin_amdgcn_s_barrier()
#define PG8_SCHED __builtin_amdgcn_sched_barrier(0)
    Unit cur, nxt; int ui = 0;
    if (!S.next(0, cur)) return;
    f32x4 acc[2][2][4][2];
#pragma unroll
    for (int a = 0; a < 2; ++a)
#pragma unroll
        for (int b = 0; b < 2; ++b)
#pragma unroll
            for (int m = 0; m < 4; ++m)
#pragma unroll
                for (int n = 0; n < 2; ++n) acc[a][b][m][n] = (f32x4){0.f, 0.f, 0.f, 0.f};
    bf16x8 At[4][2], B0[2][2], B1[2][2];
    const char* cA = (const char*)g.A + (size_t)cur.pm * tstep + (size_t)cur.k0t * kstep; const char* cB = (const char*)g.Bt + (size_t)cur.pn * tstep + (size_t)cur.k0t * kstep;
    int nt = cur.nt ? cur.nt : nt_all;
    S.a_ready(cur);
    if constexpr (SP2) {
        PG8_STAGE(PG8_SB(0, 0), cB, voffB); PG8_STAGE(PG8_SB(0, 1), cB + hstep, voffB); PG8_STAGE(PG8_SA(0, 0), cA, voffA); PG8_STAGE(PG8_SA(0, 1), cA + hstep, voffA);
        if (wr == 1) PG8_BAR;
        PG8_WAIT_V(2); PG8_BAR;
        PG8_STAGE(PG8_SB(1, 0), cB + kstep, voffB); PG8_STAGE(PG8_SA(1, 0), cA + kstep, voffA); PG8_STAGE(PG8_SB(1, 1), cB + hstep + kstep, voffB);
        PG8_WAIT_V(6); PG8_BAR;
    } else {
        PG8_STAGE(PG8_SB(0, 0), cB, voffB); PG8_STAGE(PG8_SA(0, 0), cA, voffA); PG8_STAGE(PG8_SB(0, 1), cB + hstep, voffB); PG8_STAGE(PG8_SA(0, 1), cA + hstep, voffA);
        if (wr == 1) PG8_BAR;
        PG8_WAIT_V(4); PG8_BAR;
        PG8_STAGE(PG8_SB(1, 0), cB + kstep, voffB); PG8_STAGE(PG8_SA(1, 0), cA + kstep, voffA); PG8_STAGE(PG8_SB(1, 1), cB + hstep + kstep, voffB);
        PG8_WAIT_V(6); PG8_BAR;
    }
    for (;;) {
        const bool has_next = S.next(ui + 1, nxt);
        const char* nA = has_next ? (const char*)g.A + (size_t)nxt.pm * tstep + (size_t)nxt.k0t * kstep : cA; const char* nB = has_next ? (const char*)g.Bt + (size_t)nxt.pn * tstep + (size_t)nxt.k0t * kstep : cB;
        for (int t = 0; t < nt; t += 2) {
            const bool last = (t == nt - 2);
            const char* a1 = cA + (size_t)(t + 1) * kstep;
            const char* a2 = last ? nA : cA + (size_t)(t + 2) * kstep; const char* b2 = last ? nB : cB + (size_t)(t + 2) * kstep;
            const char* a3 = a2 + kstep; const char* b3 = b2 + kstep;
            if (last && has_next) S.a_ready(nxt);
            if constexpr (SP2) {
            PG8_LDB(B0, 0, 0); PG8_LDB(B1, 0, 1); PG8_SCHED; PG8_LDA(At, 0, 0); PG8_STAGE(PG8_SA(1, 1), a1 + hstep, voffA);
            PG8_WAIT_V(8); PG8_WAIT_L(0); PG8_BAR; PG8_MMA(0, 0, At, B0); PG8_MMA(0, 1, At, B1); PG8_BAR; PG8_SCHED;
            PG8_LDA(At, 0, 1); PG8_STAGE(PG8_SB(0, 0), b2, voffB); PG8_STAGE(PG8_SB(0, 1), b2 + hstep, voffB); PG8_STAGE(PG8_SA(0, 0), a2, voffA);
            PG8_WAIT_V(8); PG8_WAIT_L(0); PG8_BAR; PG8_MMA(1, 0, At, B0); PG8_MMA(1, 1, At, B1); PG8_BAR; PG8_SCHED;
            PG8_LDB(B0, 1, 0); PG8_LDB(B1, 1, 1); PG8_SCHED; PG8_LDA(At, 1, 0); PG8_STAGE(PG8_SA(0, 1), a2 + hstep, voffA);
            PG8_WAIT_V(8); PG8_WAIT_L(0); PG8_BAR; PG8_MMA(0, 0, At, B0); PG8_MMA(0, 1, At, B1); PG8_BAR; PG8_SCHED;
            PG8_LDA(At, 1, 1); PG8_STAGE(PG8_SB(1, 0), b3, voffB); PG8_STAGE(PG8_SB(1, 1), b3 + hstep, voffB); PG8_STAGE(PG8_SA(1, 0), a3, voffA);
            PG8_WAIT_V(8); PG8_WAIT_L(0); PG8_BAR; PG8_MMA(1, 0, At, B0); PG8_MMA(1, 1, At, B1); PG8_BAR; PG8_SCHED;
            } else {
            PG8_LDB(B0, 0, 0); PG8_SCHED; PG8_LDA(At, 0, 0); PG8_STAGE(PG8_SA(1, 1), a1 + hstep, voffA);
            PG8_WAIT_L(8); PG8_BAR; PG8_WAIT_L(0); PG8_MMA(0, 0, At, B0); PG8_BAR; PG8_SCHED;
            PG8_LDB(B1, 0, 1); PG8_STAGE(PG8_SB(0, 0), b2, voffB);
            PG8_BAR; PG8_WAIT_L(0); PG8_MMA(0, 1, At, B1); PG8_BAR;
            PG8_LDA(At, 0, 1); PG8_STAGE(PG8_SA(0, 0), a2, voffA);
            PG8_BAR; PG8_WAIT_L(0); PG8_MMA(1, 0, At, B0); PG8_BAR; PG8_SCHED;
            PG8_STAGE(PG8_SB(0, 1), b2 + hstep, voffB);
            PG8_WAIT_V(6); PG8_BAR; PG8_MMA(1, 1, At, B1); PG8_BAR;
            PG8_LDB(B0, 1, 0); PG8_SCHED; PG8_LDA(At, 1, 0); PG8_STAGE(PG8_SA(0, 1), a2 + hstep, voffA);
            PG8_WAIT_L(8); PG8_BAR; PG8_WAIT_L(0); PG8_MMA(0, 0, At, B0); PG8_BAR; PG8_SCHED;
            PG8_LDB(B1, 1, 1); PG8_STAGE(PG8_SB(1, 0), b3, voffB);
            PG8_BAR; PG8_WAIT_L(0); PG8_MMA(0, 1, At, B1); PG8_BAR;
            PG8_LDA(At, 1, 1); PG8_STAGE(PG8_SA(1, 0), a3, voffA);
            PG8_BAR; PG8_WAIT_L(0); PG8_MMA(1, 0, At, B0); PG8_BAR; PG8_SCHED;
            PG8_STAGE(PG8_SB(1, 1), b3 + hstep, voffB);
            PG8_WAIT_V(6); PG8_BAR; PG8_MMA(1, 1, At, B1); PG8_BAR;
            }
        }
        if constexpr (ALIGN_EPI) { if (wr == 0) PG8_BAR; }
        if constexpr (!Epi::AFTER_DRAIN) { E(acc, cur, wr, wc, fr, fq); S.done(cur); }
        if (!has_next) break;
#pragma unroll
        for (int a = 0; a < 2; ++a)
#pragma unroll
            for (int b = 0; b < 2; ++b)
#pragma unroll
                for (int m = 0; m < 4; ++m)
#pragma unroll
                    for (int n = 0; n < 2; ++n) acc[a][b][m][n] = (f32x4){0.f, 0.f, 0.f, 0.f};
        cur = nxt; cA = nA; cB = nB; ++ui; nt = cur.nt ? cur.nt : nt_all;
        if constexpr (ALIGN_EPI) { if (wr == 1) PG8_BAR; }
    }
    PG8_WAIT_V(0);
    if constexpr (!ALIGN_EPI) { if (wr == 0) PG8_BAR; }
    PG8_BAR;
    if constexpr (Epi::AFTER_DRAIN) { E.fused(acc, cur, wr, wc, fr, fq, lds, wid, lane); S.done(cur); }
#undef PG8_SA
#undef PG8_SB
#undef PG8_STAGE
#undef PG8_LDA
#undef PG8_LDB
#undef PG8_MMA
#undef PG8_WAIT_V
#undef PG8_WAIT_L
#undef PG8_BAR
#undef PG8_SCHED
}
}

namespace pg8 {
typedef unsigned u32x2 __attribute__((ext_vector_type(2)));
template <int ACT> struct EpiStore {
    static constexpr bool PERM = true, AFTER_DRAIN = false;
    bf16_t* O; int ldc;
    __device__ __forceinline__ void operator()(const f32x4 (&acc)[2][2][4][2], const Unit& u, int wr, int wc, int fr, int fq) const {
        const int row0 = u.pm * BM + wr * 64 + fr, col0 = u.pn * BM + wc * 32 + 8 * fq;
#pragma unroll
        for (int ai = 0; ai < 2; ++ai)
#pragma unroll
            for (int m = 0; m < 4; ++m) { bf16_t* rowp = O + (size_t)(row0 + ai * HALF + m * 16) * ldc + col0;
#pragma unroll
                for (int bj = 0; bj < 2; ++bj) { f32x4 v0 = acc[ai][bj][m][0], v1 = acc[ai][bj][m][1];
                    if (ACT == 2) {
#pragma unroll
                        for (int e = 0; e < 4; ++e) { const float a = fmaxf(v0[e], 0.f), b = fmaxf(v1[e], 0.f); v0[e] = a * a; v1[e] = b * b; } }
                    u32x4 w; w.x = cvt_pk_bf16(v0[0], v0[1]); w.y = cvt_pk_bf16(v0[2], v0[3]); w.z = cvt_pk_bf16(v1[0], v1[1]); w.w = cvt_pk_bf16(v1[2], v1[3]);
                    *(u32x4*)(rowp + bj * HALF) = w; } }
    }
};


__device__ __forceinline__ void rows_rstd(const float* rs, int row0, int fq, float (&rstd)[2][4]) {
    f32x4 p[2][4];
#pragma unroll
    for (int ai = 0; ai < 2; ++ai)
#pragma unroll
        for (int m = 0; m < 4; ++m) p[ai][m] = *(const f32x4*)(rs + (size_t)(row0 + ai * HALF + m * 16) * 16 + 4 * fq);
#pragma unroll
    for (int ai = 0; ai < 2; ++ai)
#pragma unroll
        for (int m = 0; m < 4; ++m) { float s = (p[ai][m][0] + p[ai][m][1]) + (p[ai][m][2] + p[ai][m][3]); s += shx<16>(s); s = sum_halves(s); rstd[ai][m] = 1.0f / sqrtf(s * (1.0f / 1024.0f) + 1e-6f); }
}
struct EpiFc1 {
    static constexpr bool PERM = true, AFTER_DRAIN = false;
    bf16_t* O; int ldc; const float* rs; const float* bias;
    __device__ __forceinline__ void operator()(const f32x4 (&acc)[2][2][4][2], const Unit& u, int wr, int wc, int fr_in, int fq_in) const {
        (void)fr_in; (void)fq_in; int ln_e = lane_id(); asm volatile("" : "+v"(ln_e)); const int fr = ln_e & 15, fq = ln_e >> 4;
        const int row0 = u.pm * BM + wr * 64 + fr, col0 = u.pn * BM + wc * 32 + 8 * fq; const int b = (u.pm < 64) ? (u.pm >> 3) : 8;
        f32x4 bv[2][2];
#pragma unroll
        for (int bj = 0; bj < 2; ++bj)
#pragma unroll
            for (int n = 0; n < 2; ++n) bv[bj][n] = *(const f32x4*)(bias + (size_t)b * ldc + col0 + bj * HALF + 4 * n);
        float rsd[2][4]; rows_rstd(rs, row0, fq, rsd);
#pragma unroll
        for (int ai = 0; ai < 2; ++ai)
#pragma unroll
            for (int m = 0; m < 4; ++m) { const int row = row0 + ai * HALF + m * 16; const float rstd = rsd[ai][m]; bf16_t* rowp = O + (size_t)row * ldc + col0;
#pragma unroll
                for (int bj = 0; bj < 2; ++bj) { f32x4 v0 = acc[ai][bj][m][0] * rstd + bv[bj][0], v1 = acc[ai][bj][m][1] * rstd + bv[bj][1];
#pragma unroll
                    for (int e = 0; e < 4; ++e) { const float a = fmaxf(v0[e], 0.f), c = fmaxf(v1[e], 0.f); v0[e] = a * a; v1[e] = c * c; }
                    u32x4 w; w.x = cvt_pk_bf16(v0[0], v0[1]); w.y = cvt_pk_bf16(v0[2], v0[3]); w.z = cvt_pk_bf16(v1[0], v1[1]); w.w = cvt_pk_bf16(v1[2], v1[3]);
                    *(u32x4*)(rowp + bj * HALF) = w; }
                asm volatile("" ::: "memory"); }
    }
};


__host__ __device__ __forceinline__ size_t slab_off(int i) { const size_t MiB_ = (size_t)1 << 20; return i < 36 ? 234 * MiB_ + (size_t)i * 262144 : i < 64 ? 249 * MiB_ + (size_t)(i - 36) * 262144 : 14 * MiB_ + (size_t)(i - 64) * 262144; }
struct SplitOrder {
    StaticOrder lat; int G, c;
    __host__ __device__ void init(int G_, int c_) { lat.init(64 * BM, 4 * BM, G_, c_); G = G_; c = c_; }
    __host__ __device__ __forceinline__ bool next(int i, Unit& u) const {
        const long L = (long)i * G + c;
        Unit t; const bool okl = lat.next(i, t);
        const int s = (int)(L - 256), unit = s >> 2; const bool isl = L < 256;
        u.pm = isl ? t.pm : 64 + (unit >> 2); u.pn = isl ? t.pn : (unit & 3); u.ks = isl ? 0 : (s & 3); u.k0t = isl ? 0 : (s & 3) * 16; u.nt = isl ? 0 : 16;
        return isl ? okl : (s < 128);
    }
    __device__ __forceinline__ void a_ready(const Unit&) const {}
    __device__ __forceinline__ void done(const Unit&) const {}
};

struct EpiResid {
    static constexpr bool PERM = true, AFTER_DRAIN = false;
    const float* base_lat; const float* base_ctx; float* out_lat; float* out_ctx; const float* gate;
    bf16_t* aout; const float* gn; const float* scn; float* rsout;
    bool dry;
    float* slab; bool split_ctx;
    __device__ __forceinline__ void operator()(const f32x4 (&acc)[2][2][4][2], const Unit& u, int wr, int wc, int fr_in, int fq_in) const {
        (void)fr_in; (void)fq_in; int ln_e = lane_id(); asm volatile("" : "+v"(ln_e)); const int fr = ln_e & 15, fq = ln_e >> 4;
        if (dry) return;
        const bool lat = u.pm < 64;
        const int b = lat ? (u.pm >> 3) : 8;
        const size_t roff = (size_t)(lat ? u.pm : u.pm - 64) * BM * 1024;
        const float* base = (lat ? base_lat : base_ctx) + roff; float* out = (lat ? out_lat : out_ctx) + roff;
        const int col0 = u.pn * BM + wc * 32 + 8 * fq;
        f32x4 gv[2][2];
#pragma unroll
        for (int bj = 0; bj < 2; ++bj)
#pragma unroll
            for (int n = 0; n < 2; ++n) gv[bj][n] = *(const f32x4*)(gate + (size_t)b * 6144 + col0 + bj * HALF + n * 4);
        if (u.ks != 0) {
            float* sp = (float*)((unsigned char*)slab + slab_off(((u.pm - 64) * 4 + u.pn) * 3 + (u.ks - 1))) + wc * 32 + 8 * fq;
#pragma unroll
            for (int ai = 0; ai < 2; ++ai)
#pragma unroll
                for (int m = 0; m < 4; ++m) { float* rp = sp + (size_t)(ai * HALF + wr * 64 + m * 16 + fr) * 256;
#pragma unroll
                    for (int bj = 0; bj < 2; ++bj) { *(f32x4*)(rp + bj * HALF) = acc[ai][bj][m][0]; *(f32x4*)(rp + bj * HALF + 4) = acc[ai][bj][m][1]; } }
            return;
        }
        if (aout == nullptr || (split_ctx && !lat)) {
#pragma unroll
            for (int ai = 0; ai < 2; ++ai)
#pragma unroll
                for (int m = 0; m < 4; ++m) { const size_t off = (size_t)(ai * HALF + wr * 64 + m * 16 + fr) * 1024 + col0;
#pragma unroll
                    for (int bj = 0; bj < 2; ++bj)
#pragma unroll
                        for (int n = 0; n < 2; ++n) { const f32x4 bs = *(const f32x4*)(base + off + bj * HALF + n * 4);
                            *(f32x4*)(out + off + bj * HALF + n * 4) = bs + gv[bj][n] * acc[ai][bj][m][n]; }
                    if (m & 1) asm volatile("" ::: "memory"); }
            return;
        }
        f32x4 Gv[2][2];
#pragma unroll
        for (int bj = 0; bj < 2; ++bj)
#pragma unroll
            for (int n = 0; n < 2; ++n) Gv[bj][n] = *(const f32x4*)(gn + col0 + bj * HALF + n * 4) * (*(const f32x4*)(scn + (size_t)b * 6144 + col0 + bj * HALF + n * 4) + 1.0f);
        const size_t grow0 = (size_t)u.pm * BM;
#pragma unroll
        for (int ai = 0; ai < 2; ++ai)
#pragma unroll
            for (int m = 0; m < 4; ++m) { const int rl = ai * HALF + wr * 64 + m * 16 + fr; const size_t off = (size_t)rl * 1024 + col0; float ss = 0.f;
                bf16_t* ap = aout + (grow0 + rl) * 1024 + col0;
#pragma unroll
                for (int bj = 0; bj < 2; ++bj) {
                    const f32x4 b0 = *(const f32x4*)(base + off + bj * HALF), b1 = *(const f32x4*)(base + off + bj * HALF + 4);
                    const f32x4 x0 = b0 + gv[bj][0] * acc[ai][bj][m][0], x1 = b1 + gv[bj][1] * acc[ai][bj][m][1];
                    *(f32x4*)(out + off + bj * HALF) = x0; *(f32x4*)(out + off + bj * HALF + 4) = x1;
                    ss += ((x0[0] * x0[0] + x0[1] * x0[1]) + (x0[2] * x0[2] + x0[3] * x0[3])) + ((x1[0] * x1[0] + x1[1] * x1[1]) + (x1[2] * x1[2] + x1[3] * x1[3]));
                    const f32x4 y0 = x0 * Gv[bj][0], y1 = x1 * Gv[bj][1];
                    u32x4 w; w.x = cvt_pk_bf16(y0[0], y0[1]); w.y = cvt_pk_bf16(y0[2], y0[3]); w.z = cvt_pk_bf16(y1[0], y1[1]); w.w = cvt_pk_bf16(y1[2], y1[3]);
                    *(u32x4*)(ap + bj * HALF) = w; }
                ss += shx<16>(ss); ss = sum_halves(ss);
                if (fq == 0) rsout[(grow0 + rl) * 16 + u.pn * 4 + wc] = ss;
                if (m & 1) asm volatile("" ::: "memory"); }
    }
};

struct EpiProj {
    static constexpr bool PERM = true, AFTER_DRAIN = false;
    bf16_t* O; const float* gains;
    const float* rs; const float* bias;
    __device__ __forceinline__ void operator()(const f32x4 (&acc)[2][2][4][2], const Unit& u, int wr, int wc, int fr_in, int fq_in) const {
        (void)fr_in; (void)fq_in; int ln_e = lane_id(); asm volatile("" : "+v"(ln_e)); const int fr = ln_e & 15, fq = ln_e >> 4;
        const int pn = u.pn; const int row0 = u.pm * BM + wr * 64 + fr; const int b = (u.pm < 64) ? (u.pm >> 3) : 8;
        f32x4 bv[2][2];
#pragma unroll
        for (int bj = 0; bj < 2; ++bj)
#pragma unroll
            for (int n = 0; n < 2; ++n) bv[bj][n] = *(const f32x4*)(bias + (size_t)b * 2304 + pn * BM + bj * HALF + wc * 32 + 8 * fq + 4 * n);
        float rsd[2][4]; rows_rstd(rs, row0, fq, rsd);
        if (pn >= 2 && pn <= 5) {
            const int col0 = pn * BM + wc * 32 + 8 * fq;
#pragma unroll
            for (int ai = 0; ai < 2; ++ai)
#pragma unroll
                for (int m = 0; m < 4; ++m) { bf16_t* rowp = O + (size_t)(row0 + ai * HALF + m * 16) * 2304 + col0; const float rstd = rsd[ai][m];
#pragma unroll
                    for (int bj = 0; bj < 2; ++bj) { const f32x4 v0 = acc[ai][bj][m][0] * rstd + bv[bj][0], v1 = acc[ai][bj][m][1] * rstd + bv[bj][1];
                        u32x4 w; w.x = cvt_pk_bf16(v0[0], v0[1]); w.y = cvt_pk_bf16(v0[2], v0[3]); w.z = cvt_pk_bf16(v1[0], v1[1]); w.w = cvt_pk_bf16(v1[2], v1[3]);
                        *(u32x4*)(rowp + bj * HALF) = w; } }
            return;
        }
        const int colh = pn * BM + wc * 64 + 8 * fq;
        const bool vhead = (pn == 8) && (wc >= 2);
        if (vhead) {
#pragma unroll
            for (int ai = 0; ai < 2; ++ai)
#pragma unroll
                for (int m = 0; m < 4; ++m) { bf16_t* rowp = O + (size_t)(row0 + ai * HALF + m * 16) * 2304 + colh; const float rstd = rsd[ai][m];
#pragma unroll
                    for (int bj = 0; bj < 2; ++bj) { const f32x4 v0 = acc[ai][bj][m][0] * rstd + bv[bj][0], v1 = acc[ai][bj][m][1] * rstd + bv[bj][1];
                        u32x4 w; w.x = cvt_pk_bf16(v0[0], v0[1]); w.y = cvt_pk_bf16(v0[2], v0[3]); w.z = cvt_pk_bf16(v1[0], v1[1]); w.w = cvt_pk_bf16(v1[2], v1[3]);
                        *(u32x4*)(rowp + bj * 32) = w; } }
            return;
        }
        const float* gp = gains + 64 * ((pn == 0) ? 0 : (pn == 1) ? 1 : (pn == 8) ? 3 : 2);
        const float qs = (pn == 1 || pn == 8) ? 1.0f : 0.18033688011112042f;
        const bool rope = (pn >= 6) && (u.pm < 64);
        f32x4 gv[2][2];
#pragma unroll
        for (int bj = 0; bj < 2; ++bj)
#pragma unroll
            for (int n = 0; n < 2; ++n) gv[bj][n] = *(const f32x4*)(gp + 32 * bj + 16 * n + 4 * fq);
        float invrev[4];
#pragma unroll
        for (int e = 0; e < 4; ++e) invrev[e] = __builtin_amdgcn_exp2f(-(float)(4 * fq + e) * (13.287712379549449f / 16.0f)) * 0.15915494309189535f;
#pragma unroll
        for (int ai = 0; ai < 2; ++ai)
#pragma unroll
            for (int m = 0; m < 4; ++m) {
                const int row = row0 + ai * HALF + m * 16; const float rstd0 = rsd[ai][m];
                f32x4 v[2][2]; float ss = 0.f;
#pragma unroll
                for (int bj = 0; bj < 2; ++bj)
#pragma unroll
                    for (int n = 0; n < 2; ++n) v[bj][n] = acc[ai][bj][m][n] * rstd0 + bv[bj][n];
                asm volatile("" : "+v"(v[0][0]), "+v"(v[0][1]), "+v"(v[1][0]), "+v"(v[1][1]));
#pragma unroll
                for (int bj = 0; bj < 2; ++bj)
#pragma unroll
                    for (int n = 0; n < 2; ++n) { const f32x4 x = v[bj][n]; ss += (x[0] * x[0] + x[1] * x[1]) + (x[2] * x[2] + x[3] * x[3]); }
                ss += shx<16>(ss); ss = sum_halves(ss);
                const float rstd = 1.0f / sqrtf(ss * (1.0f / 64.0f) + 1e-6f);
#pragma unroll
                for (int bj = 0; bj < 2; ++bj)
#pragma unroll
                    for (int n = 0; n < 2; ++n) v[bj][n] = v[bj][n] * rstd * gv[bj][n];
                if (rope) {
                    const int t = row & 2047;
#pragma unroll
                    for (int bj = 0; bj < 2; ++bj) { const float pos = (float)(bj == 0 ? (t >> 6) : (t & 63));
#pragma unroll
                        for (int e = 0; e < 4; ++e) { float rev = pos * invrev[e]; rev = rev - floorf(rev);
                            const float cs = __builtin_amdgcn_cosf(rev), sn = __builtin_amdgcn_sinf(rev);
                            const float u1 = v[bj][0][e], u2 = v[bj][1][e];
                            v[bj][0][e] = u1 * cs - u2 * sn; v[bj][1][e] = u2 * cs + u1 * sn; } }
                }
                bf16_t* rowp = O + (size_t)row * 2304 + colh;
#pragma unroll
                for (int bj = 0; bj < 2; ++bj) { const f32x4 v0 = v[bj][0] * qs, v1 = v[bj][1] * qs;
                    u32x4 w; w.x = cvt_pk_bf16(v0[0], v0[1]); w.y = cvt_pk_bf16(v0[2], v0[3]); w.z = cvt_pk_bf16(v1[0], v1[1]); w.w = cvt_pk_bf16(v1[2], v1[3]);
                    *(u32x4*)(rowp + bj * 32) = w; }
                asm volatile("" ::: "memory");
            }
    }
};
}

#define LAS __attribute__((address_space(3)))
typedef unsigned short bf16_t;
typedef short bf16x8 __attribute__((ext_vector_type(8)));
typedef short s16x4 __attribute__((ext_vector_type(4)));
typedef float f32x16 __attribute__((ext_vector_type(16)));
typedef float f32x4 __attribute__((ext_vector_type(4)));
typedef unsigned u32x4 __attribute__((ext_vector_type(4)));
typedef unsigned u32x2 __attribute__((ext_vector_type(2)));

constexpr int DM = 1024, NB = 8, SEQ = 2048, CTXL = 256, FFN = 4096, INW = 2304;
constexpr int MLAT = NB * SEQ, MCTX = NB * CTXL, MALL = MLAT + MCTX;
constexpr float EPSN = 1e-6f, LOG2E = 1.4426950408889634f, NEGBIG = -1e30f;
constexpr int MODW = 6 * DM;
constexpr size_t MiB = (size_t)1 << 20;
constexpr size_t WS_MOD = 0;
constexpr size_t WS_GAIN = 512 * 1024;
constexpr size_t WS_BAR = 768 * 1024;
constexpr size_t WS_WIN = 1 * MiB;
constexpr size_t WS_WO = 10 * MiB;
constexpr size_t WS_W1 = 14 * MiB;
constexpr size_t WS_W2 = 30 * MiB;
constexpr size_t WS_CTX = 46 * MiB;
constexpr size_t WS_HN2 = 54 * MiB;
constexpr size_t WS_HN = 207 * MiB;
constexpr size_t WS_H1 = 90 * MiB;
constexpr size_t WS_PROJ = 90 * MiB;
constexpr size_t WS_OB = 171 * MiB;
constexpr size_t WS_RS1 = 243 * MiB;
constexpr size_t WS_RS2 = 245 * MiB;
constexpr size_t WS_BIN = 247 * MiB;
constexpr size_t WS_B1 = 248 * MiB;
constexpr size_t WS_END = 256 * MiB;
static_assert(WS_W1 == 14 * MiB, "pg8::slab_off places 32 slabs in the first layer's fc1 weight copy");

__device__ __forceinline__ float half_sum(float v) { v += pg8::shx<1>(v); v += pg8::shx<2>(v); v += pg8::shx<4>(v); v += pg8::shx<8>(v); v += pg8::shx<16>(v); return v; }
__device__ __forceinline__ float wave_sum(float v) { return pg8::sum_halves(half_sum(v)); }
__device__ __forceinline__ unsigned f2bf(float f) { unsigned u = __builtin_bit_cast(unsigned, f); return (u + 0x7fffu + ((u >> 16) & 1u)) >> 16; }
__device__ __forceinline__ unsigned pk2(float lo, float hi) { return f2bf(lo) | (f2bf(hi) << 16); }
__device__ __forceinline__ float bf_lo(unsigned u) { return __builtin_bit_cast(float, u << 16); }
__device__ __forceinline__ float bf_hi(unsigned u) { return __builtin_bit_cast(float, u & 0xffff0000u); }

namespace att {
constexpr int KROWB = 144, VROWB = 128, WL_V = 64 * KROWB, WL_A = WL_V + 64 * VROWB, WL_TAB = WL_A + 128 + 192, WAVE_LDS = WL_TAB + 15 * 32 * 4;
typedef float f32x2_t __attribute__((ext_vector_type(2))); typedef __bf16 bf16x2_t __attribute__((ext_vector_type(2)));
typedef short v4i16_t __attribute__((ext_vector_type(4)));
__device__ __forceinline__ unsigned cvtpk(float lo, float hi) { f32x2_t v = {lo, hi}; bf16x2_t b = __builtin_convertvector(v, bf16x2_t); return __builtin_bit_cast(unsigned, b); }
__device__ __forceinline__ s16x4 vtr(LAS const unsigned char* p) { return __builtin_bit_cast(s16x4, __builtin_amdgcn_ds_read_tr16_b64_v4i16((LAS v4i16_t*)p)); }
struct AU { int qrow0, qcol, kcol, vcol, ocol, ctxrow0, nloc, locrow0, a0, a1; float negc, l0; const float* rpb; };
template <int KIND> __device__ __forceinline__ void attn_unit(LAS unsigned char* wl, const bf16_t* __restrict__ proj, bf16_t* __restrict__ obuf, const AU u, const int lane) {
    const int r32 = lane & 31, hi = lane >> 5;
    LAS float* sc = (LAS float*)(wl + WL_A);
    LAS float* tab = (LAS float*)(wl + WL_TAB);
    bf16x8 qr[4];
    { const bf16_t* qp = proj + (size_t)(u.qrow0 + r32) * INW + u.qcol + hi * 8;
#pragma unroll
      for (int d0 = 0; d0 < 4; ++d0) qr[d0] = *(const bf16x8*)(qp + d0 * 16); }
    if (KIND == 0) { for (int i = lane; i < 15 * 31; i += 64) { const int a = i / 31, b = i - a * 31; tab[a * 32 + b] = u.rpb[i] * LOG2E; } }
    f32x16 o0, o1;
#pragma unroll
    for (int r = 0; r < 16; ++r) { o0[r] = 0.f; o1[r] = 0.f; }
    float l = (hi == 0) ? u.l0 : 0.f;
    const int nt = 4 + u.nloc;
    const int lrow = lane >> 3, lch = lane & 7;
    u32x4 kreg[8], vreg[8];
#define ATT_LOAD_TILE(t) do { const int row0_ = ((t) < 4) ? u.ctxrow0 + 64 * (t) : u.locrow0 + 64 * ((t) - 4); const bf16_t* bp_ = proj + (size_t)(row0_ + lrow) * INW + lch * 8; \
        _Pragma("unroll") for (int i_ = 0; i_ < 8; ++i_) { kreg[i_] = *(const u32x4*)(bp_ + (size_t)i_ * 8 * INW + u.kcol); vreg[i_] = *(const u32x4*)(bp_ + (size_t)i_ * 8 * INW + u.vcol); } } while (0)
    ATT_LOAD_TILE(0);
    LAS unsigned char* kw = wl + lrow * KROWB + lch * 16;
    LAS unsigned char* vw = wl + WL_V + lrow * VROWB + lch * 16;
    LAS const unsigned char* kf = wl + r32 * KROWB + hi * 16;
    LAS const unsigned char* vf = wl + WL_V + (4 * hi + ((lane & 15) >> 2)) * VROWB + ((lane >> 4) & 1) * 32 + (lane & 3) * 8;
    for (int t = 0; t < nt; ++t) {
#pragma unroll
        for (int i = 0; i < 8; ++i) { *(LAS u32x4*)(kw + i * 8 * KROWB) = kreg[i]; *(LAS u32x4*)(vw + i * 8 * VROWB) = vreg[i]; }
        if (t + 1 < nt) ATT_LOAD_TILE(t + 1);
        f32x16 p0, p1;
#pragma unroll
        for (int r = 0; r < 16; ++r) { p0[r] = 0.f; p1[r] = 0.f; }
#pragma unroll
        for (int d0 = 0; d0 < 4; ++d0) {
            const bf16x8 a0 = *(LAS const bf16x8*)(kf + d0 * 32), a1 = *(LAS const bf16x8*)(kf + 32 * KROWB + d0 * 32);
            p0 = __builtin_amdgcn_mfma_f32_32x32x16_bf16(a0, qr[d0], p0, 0, 0, 0);
            p1 = __builtin_amdgcn_mfma_f32_32x32x16_bf16(a1, qr[d0], p1, 0, 0, 0);
        }
        if (KIND == 0) { if (t >= 4) {
            const int dr = u.a0 + (t - 4), qc = u.a1 + r32; const int cs = min(max(qc - 8, 0), 48);
            const int kb = 4 * hi - cs; const volatile LAS float* tb = tab + dr * 32 + 15 - qc + 4 * hi;
#pragma unroll
            for (int r = 0; r < 16; ++r) { const int kc = (r & 3) + 8 * (r >> 2);
                const float b0_ = tb[kc], b1_ = tb[kc + 32];
                p0[r] = ((unsigned)(kb + kc) < 16u) ? p0[r] + b0_ : NEGBIG;
                p1[r] = ((unsigned)(kb + kc + 32) < 16u) ? p1[r] + b1_ : NEGBIG; } } }
        if (KIND == 1) { const int tb0_ = u.a0 + 64 * (t - 4);
          if (t >= 4 && (tb0_ < -97 || tb0_ > 65)) {
            const int d0_ = tb0_ + 4 * hi - r32 + 128;
#pragma unroll
            for (int r = 0; r < 16; ++r) { const int kc = (r & 3) + 8 * (r >> 2);
                p0[r] = ((unsigned)(d0_ + kc) <= 256u) ? p0[r] : NEGBIG;
                p1[r] = ((unsigned)(d0_ + kc + 32) <= 256u) ? p1[r] : NEGBIG; } } }
        if (u.negc != 0.f) {
#pragma unroll
            for (int r = 0; r < 16; ++r) { p0[r] += u.negc; p1[r] += u.negc; } }
        float rs = 0.f;
#pragma unroll
        for (int r = 0; r < 16; ++r) { p0[r] = __builtin_amdgcn_exp2f(p0[r]); p1[r] = __builtin_amdgcn_exp2f(p1[r]); rs += p0[r] + p1[r]; }
        l += rs;
        u32x4 pa[4];
#pragma unroll
        for (int j = 0; j < 4; ++j) { pa[0][j] = cvtpk(p0[2 * j], p0[2 * j + 1]); pa[1][j] = cvtpk(p0[8 + 2 * j], p0[8 + 2 * j + 1]); pa[2][j] = cvtpk(p1[2 * j], p1[2 * j + 1]); pa[3][j] = cvtpk(p1[8 + 2 * j], p1[8 + 2 * j + 1]); }
#pragma unroll
        for (int ks = 0; ks < 4; ++ks) {
            const s16x4 l0 = vtr(vf + ks * 16 * VROWB), h0 = vtr(vf + ks * 16 * VROWB + 8 * VROWB);
            const s16x4 l1 = vtr(vf + ks * 16 * VROWB + 64), h1 = vtr(vf + ks * 16 * VROWB + 8 * VROWB + 64);
            const bf16x8 b0 = (bf16x8){l0[0], l0[1], l0[2], l0[3], h0[0], h0[1], h0[2], h0[3]}, b1 = (bf16x8){l1[0], l1[1], l1[2], l1[3], h1[0], h1[1], h1[2], h1[3]};
            o0 = __builtin_amdgcn_mfma_f32_32x32x16_bf16(__builtin_bit_cast(bf16x8, pa[ks]), b0, o0, 0, 0, 0);
            o1 = __builtin_amdgcn_mfma_f32_32x32x16_bf16(__builtin_bit_cast(bf16x8, pa[ks]), b1, o1, 0, 0, 0);
        }
    }
#undef ATT_LOAD_TILE
    const float lt = pg8::sum_halves(l);
    if (hi == 0) sc[r32] = 1.0f / lt;
    bf16_t* ob = obuf + (size_t)u.qrow0 * DM + u.ocol + r32;
#pragma unroll
    for (int g = 0; g < 4; ++g) { const f32x4 a = *(LAS const f32x4*)(sc + 8 * g + 4 * hi);
#pragma unroll
        for (int i = 0; i < 4; ++i) { const int q = i + 8 * g + 4 * hi; bf16_t* op = ob + (size_t)q * DM;
            op[0] = (bf16_t)f2bf(o0[4 * g + i] * a[i]); op[32] = (bf16_t)f2bf(o1[4 * g + i] * a[i]); } }
}

__device__ __forceinline__ void attn_phase(LAS unsigned char* wl, const bf16_t* proj, bf16_t* obuf, const float* rpb_l, const float* sink_l, const float* cb_l, bool with_ctx, int gw, int ngw, int lane) {
    const float cb_na = fmaxf(cb_l[0] - 64.f, 0.f), cb_wa = fmaxf(cb_l[1] - 64.f, 0.f);
    const int total = 2048 + 4096 + (with_ctx ? 768 : 0);
    for (int i0 = gw; i0 < total; i0 += ngw) {
        int i = i0; AU u;
        if (i < 2048) {
            const int half = i & 1, h = (i >> 1) & 3, r = (i >> 3) & 31, b = i >> 8; const int rs = min(max(r - 4, 0), 24);
            u.qrow0 = b * SEQ + r * 64 + 32 * half; u.qcol = 64 * h; u.kcol = 256 + 64 * h; u.vcol = 512 + 64 * h; u.ocol = 64 * h; u.ctxrow0 = MLAT + b * CTXL;
            u.nloc = 8; u.locrow0 = b * SEQ + rs * 64; u.a0 = rs - r + 7; u.a1 = 32 * half; u.negc = -cb_na; u.l0 = 0.f; u.rpb = rpb_l + h * (15 * 31);
            attn_unit<0>(wl, proj, obuf, u, lane);
            continue;
        }
        i -= 2048;
        if (i < 4096) {
            const int ch = i & 63, h = (i >> 6) & 7, b = i >> 9; const int qpos0 = 32 * ch;
            const int kt0 = max(0, (qpos0 - 128) >> 6), kt1 = min(31, (qpos0 + 159) >> 6);
            u.qrow0 = b * SEQ + qpos0; u.qcol = 1536 + 64 * h; u.kcol = 2048 + 64 * (h >> 2); u.vcol = 2176 + 64 * (h >> 2); u.ocol = 512 + 64 * h; u.ctxrow0 = MLAT + b * CTXL;
            u.nloc = kt1 - kt0 + 1; u.locrow0 = b * SEQ + 64 * kt0; u.a0 = 64 * kt0 - qpos0; u.a1 = 0; u.negc = -cb_wa; u.l0 = __builtin_amdgcn_exp2f(sink_l[h] * LOG2E - cb_wa); u.rpb = nullptr;
            attn_unit<1>(wl, proj, obuf, u, lane);
            continue;
        }
        i -= 4096;
        if (i < 256) {
            const int ch = i & 7, h = (i >> 3) & 3, b = i >> 5;
            u.qrow0 = MLAT + b * CTXL + 32 * ch; u.qcol = 64 * h; u.kcol = 256 + 64 * h; u.vcol = 512 + 64 * h; u.ocol = 64 * h; u.negc = -cb_na; u.l0 = 0.f; u.ctxrow0 = MLAT + b * CTXL;
        } else {
            i -= 256; const int ch = i & 7, h = (i >> 3) & 7, b = i >> 6;
            u.qrow0 = MLAT + b * CTXL + 32 * ch; u.qcol = 1536 + 64 * h; u.kcol = 2048 + 64 * (h >> 2); u.vcol = 2176 + 64 * (h >> 2); u.ocol = 512 + 64 * h; u.negc = -cb_wa; u.l0 = __builtin_amdgcn_exp2f(sink_l[h] * LOG2E - cb_wa); u.ctxrow0 = MLAT + b * CTXL;
        }
        u.nloc = 0; u.locrow0 = 0; u.a0 = 0; u.a1 = 0; u.rpb = nullptr;
        attn_unit<2>(wl, proj, obuf, u, lane);
    }
}
}

__device__ __forceinline__ void prep_pass(const float* __restrict__ xlat, const float* __restrict__ xctx, const float* __restrict__ g, const float* __restrict__ modl, int scoff, bf16_t* __restrict__ hn, float* __restrict__ rs, int m_begin, int m_end, int m_step, int lane) {
#pragma unroll 2
    for (int m = m_begin; m < m_end; m += m_step) {
        const bool lat = m < MLAT; const float* xr = lat ? xlat + (size_t)m * DM : xctx + (size_t)(m - MLAT) * DM; const int b = lat ? (m >> 11) : 8;
        f32x4 v[4]; float ss = 0.f;
#pragma unroll
        for (int j = 0; j < 4; ++j) { v[j] = *(const f32x4*)(xr + 4 * lane + 256 * j); ss += (v[j][0] * v[j][0] + v[j][1] * v[j][1]) + (v[j][2] * v[j][2] + v[j][3] * v[j][3]); }
        ss = wave_sum(ss);
        if (lane < 16) rs[(size_t)m * 16 + lane] = (lane == 0) ? ss : 0.f;
        const float* mb = modl + (size_t)b * MODW;
#pragma unroll
        for (int j = 0; j < 4; ++j) { const int c = 4 * lane + 256 * j;
            const f32x4 gg = *(const f32x4*)(g + c), scv = *(const f32x4*)(mb + scoff + c);
            const f32x4 y = v[j] * gg * (scv + 1.0f);
            u32x2 w; w.x = pk2(y[0], y[1]); w.y = pk2(y[2], y[3]);
            *(u32x2*)(hn + (size_t)m * DM + c) = w; }
    }
}
__device__ __forceinline__ void ctx_rows_pass(const unsigned char* ws, const float* ctxbuf, const float* gate, const float* gn, const float* scn, bf16_t* hn2, float* rs, int gw, int ngw, int lane) {
    for (int r = gw; r < MCTX; r += ngw) {
        const int pmc = r >> 8, rl = r & 255; f32x4 x[4]; float ss = 0.f;
#pragma unroll
        for (int j = 0; j < 4; ++j) { const int c = 4 * lane + 256 * j; f32x4 p = {0.f, 0.f, 0.f, 0.f};
#pragma unroll
            for (int ks = 0; ks < 3; ++ks) p += *(const f32x4*)((const float*)(ws + pg8::slab_off((pmc * 4 + j) * 3 + ks)) + (size_t)rl * 256 + 4 * lane);
            x[j] = *(const f32x4*)(ctxbuf + (size_t)r * DM + c) + *(const f32x4*)(gate + c) * p;
            ss += (x[j][0] * x[j][0] + x[j][1] * x[j][1]) + (x[j][2] * x[j][2] + x[j][3] * x[j][3]); }
        ss = wave_sum(ss);
        const int m = MLAT + r;
        if (lane < 16) rs[(size_t)m * 16 + lane] = (lane == 0) ? ss : 0.f;
#pragma unroll
        for (int j = 0; j < 4; ++j) { const int c = 4 * lane + 256 * j;
            const f32x4 y = x[j] * (*(const f32x4*)(gn + c)) * (*(const f32x4*)(scn + c) + 1.0f);
            u32x2 w; w.x = pk2(y[0], y[1]); w.y = pk2(y[2], y[3]);
            *(u32x2*)(hn2 + (size_t)m * DM + c) = w; }
    }
}

__device__ __forceinline__ void mix_pass(const bf16_t* __restrict__ proj, const bf16_t* __restrict__ obuf, const float* __restrict__ convw, const float* __restrict__ convb, const float* __restrict__ gout, bf16_t* __restrict__ abuf, int nrows, int gw, int ngw, int lane) {
#pragma unroll 2
    for (int m = gw; m < nrows; m += ngw) {
        float va[8];
        if (lane < 32) {
            const u32x4 raw = *(const u32x4*)(obuf + (size_t)m * DM + 8 * lane);
#pragma unroll
            for (int j = 0; j < 4; ++j) { va[2 * j] = bf_lo(raw[j]); va[2 * j + 1] = bf_hi(raw[j]); }
        } else {
            const int c = 8 * (lane - 32); const bool lat = m < MLAT; const int t = lat ? (m & (SEQ - 1)) : ((m - MLAT) & (CTXL - 1)); const int L = lat ? SEQ : CTXL;
            const bf16_t* pr = proj + (size_t)m * INW;
            const u32x4 cx = *(const u32x4*)(pr + 768 + c), cb = *(const u32x4*)(pr + 1024 + c), cc = *(const u32x4*)(pr + 1280 + c);
            u32x4 pxm = {0u, 0u, 0u, 0u}, pcm = {0u, 0u, 0u, 0u}, pxp = {0u, 0u, 0u, 0u}, pcp = {0u, 0u, 0u, 0u};
            if (t > 0) { pxm = *(const u32x4*)(pr - INW + 768 + c); pcm = *(const u32x4*)(pr - INW + 1280 + c); }
            if (t < L - 1) { pxp = *(const u32x4*)(pr + INW + 768 + c); pcp = *(const u32x4*)(pr + INW + 1280 + c); }
            const f32x4 w0a = *(const f32x4*)(convw + c), w0b = *(const f32x4*)(convw + c + 4), w1a = *(const f32x4*)(convw + 256 + c), w1b = *(const f32x4*)(convw + 256 + c + 4),
                        w2a = *(const f32x4*)(convw + 512 + c), w2b = *(const f32x4*)(convw + 512 + c + 4), bba = *(const f32x4*)(convb + c), bbb = *(const f32x4*)(convb + c + 4);
#pragma unroll
            for (int j = 0; j < 4; ++j) {
                const float w0l = j < 2 ? w0a[2 * j] : w0b[2 * j - 4], w0h = j < 2 ? w0a[2 * j + 1] : w0b[2 * j - 3];
                const float w1l = j < 2 ? w1a[2 * j] : w1b[2 * j - 4], w1h = j < 2 ? w1a[2 * j + 1] : w1b[2 * j - 3];
                const float w2l = j < 2 ? w2a[2 * j] : w2b[2 * j - 4], w2h = j < 2 ? w2a[2 * j + 1] : w2b[2 * j - 3];
                const float bl = j < 2 ? bba[2 * j] : bbb[2 * j - 4], bh = j < 2 ? bba[2 * j + 1] : bbb[2 * j - 3];
                const float ul = bf_lo(cc[j]) * bf_lo(cx[j]), uh = bf_hi(cc[j]) * bf_hi(cx[j]);
                const float uml = bf_lo(pcm[j]) * bf_lo(pxm[j]), umh = bf_hi(pcm[j]) * bf_hi(pxm[j]);
                const float upl = bf_lo(pcp[j]) * bf_lo(pxp[j]), uph = bf_hi(pcp[j]) * bf_hi(pxp[j]);
                va[2 * j] = bf_lo(cb[j]) * (bl + w0l * uml + w1l * ul + w2l * upl);
                va[2 * j + 1] = bf_hi(cb[j]) * (bh + w0h * umh + w1h * uh + w2h * uph);
            }
        }
        float ssa = 0.f;
#pragma unroll
        for (int j = 0; j < 8; ++j) ssa += va[j] * va[j];
        ssa = half_sum(ssa); const float rsa = 1.0f / sqrtf(ssa * (1.0f / 256.0f) + EPSN);
        { const f32x4 g0 = *(const f32x4*)(gout + 8 * lane), g1 = *(const f32x4*)(gout + 8 * lane + 4);
          u32x4 w; w.x = pk2(va[0] * rsa * g0[0], va[1] * rsa * g0[1]); w.y = pk2(va[2] * rsa * g0[2], va[3] * rsa * g0[3]); w.z = pk2(va[4] * rsa * g1[0], va[5] * rsa * g1[1]); w.w = pk2(va[6] * rsa * g1[2], va[7] * rsa * g1[3]);
          *(u32x4*)(abuf + (size_t)m * DM + 8 * lane) = w; }
        float vb[8];
        { const u32x4 raw = *(const u32x4*)(obuf + (size_t)m * DM + 512 + 8 * lane);
#pragma unroll
          for (int j = 0; j < 4; ++j) { vb[2 * j] = bf_lo(raw[j]); vb[2 * j + 1] = bf_hi(raw[j]); } }
        float ssb = 0.f;
#pragma unroll
        for (int j = 0; j < 8; ++j) ssb += vb[j] * vb[j];
        ssb = wave_sum(ssb); const float rsb = 1.0f / sqrtf(ssb * (1.0f / 512.0f) + EPSN);
        { const f32x4 g0 = *(const f32x4*)(gout + 512 + 8 * lane), g1 = *(const f32x4*)(gout + 512 + 8 * lane + 4);
          u32x4 w; w.x = pk2(vb[0] * rsb * g0[0], vb[1] * rsb * g0[1]); w.y = pk2(vb[2] * rsb * g0[2], vb[3] * rsb * g0[3]); w.z = pk2(vb[4] * rsb * g1[0], vb[5] * rsb * g1[1]); w.w = pk2(vb[6] * rsb * g1[2], vb[7] * rsb * g1[3]);
          *(u32x4*)(abuf + (size_t)m * DM + 512 + 8 * lane) = w; }
    }
}

__device__ __forceinline__ void mod_item(int item, const float* c, const float* cctx, const float* wmod, const float* bmod, float* mod, LAS unsigned char* lds, int tid, int wave, int lane) {
    LAS float* sl = (LAS float*)lds;
    LAS float* red = (LAS float*)(lds + 9 * 1024 * 4);
    const int l = item / 96, n0 = (item % 96) * 64;
    for (int i = tid; i < 9 * 1024; i += 512) { const int r = i >> 10, k = i & 1023; const float v = r < 8 ? c[r * 1024 + k] : cctx[k]; sl[i] = v / (1.0f + __expf(-v)); }
    __syncthreads();
    float acc[9];
#pragma unroll
    for (int r = 0; r < 9; ++r) acc[r] = 0.f;
    const float* wp = wmod + ((size_t)l * 1024 + wave * 128) * MODW + n0 + lane;
#pragma unroll 4
    for (int k = 0; k < 128; k += 4) {
        const float w0 = wp[(size_t)k * MODW], w1 = wp[(size_t)(k + 1) * MODW], w2 = wp[(size_t)(k + 2) * MODW], w3 = wp[(size_t)(k + 3) * MODW];
#pragma unroll
        for (int r = 0; r < 9; ++r) { const f32x4 s4 = *(LAS const f32x4*)(sl + r * 1024 + wave * 128 + k); acc[r] += (s4[0] * w0 + s4[1] * w1) + (s4[2] * w2 + s4[3] * w3); } }
#pragma unroll
    for (int r = 0; r < 9; ++r) red[(wave * 9 + r) * 64 + lane] = acc[r];
    __syncthreads();
    for (int i = tid; i < 9 * 64; i += 512) { const int r = i >> 6, ln = i & 63; float s = bmod[l * MODW + n0 + ln];
#pragma unroll
        for (int w = 0; w < 8; ++w) s += red[(w * 9 + r) * 64 + ln];
        mod[((size_t)l * 9 + r) * MODW + n0 + ln] = s; }
    __syncthreads();
}
__device__ __forceinline__ int rowmap_in(int c) {
    const int pn = c >> 8; if (pn >= 2 && pn <= 5) return c;
    const int wc = (c >> 6) & 3, d = c & 63, bj = d >> 5; const bool vhead = (pn == 8) && (wc >= 2);
    int n, fq; const int e = d & 3;
    if (!vhead) { n = (d >> 4) & 1; fq = (d >> 2) & 3; } else { fq = (d >> 3) & 3; n = (d >> 2) & 1; }
    return pn * 256 + bj * 128 + wc * 32 + fq * 8 + n * 4 + e;
}
template <bool MAPIN> __device__ __forceinline__ void bias_item(const float* W, int ldw, int n0, const float* shrows  , float* out  , LAS unsigned char* lds, int tid, int wave, int lane) {
    LAS float* sl = (LAS float*)lds;
    LAS float* red = (LAS float*)(lds + 9 * 1024 * 4);
    for (int i = tid; i < 9 * 1024; i += 512) { const int r = i >> 10, k = i & 1023; sl[i] = shrows[(size_t)r * MODW + k]; }
    __syncthreads();
    float acc[9];
#pragma unroll
    for (int r = 0; r < 9; ++r) acc[r] = 0.f;
    const float* wp = W + (size_t)(wave * 128) * ldw + n0 + lane;
#pragma unroll 4
    for (int k = 0; k < 128; k += 4) {
        const float w0 = wp[(size_t)k * ldw], w1 = wp[(size_t)(k + 1) * ldw], w2 = wp[(size_t)(k + 2) * ldw], w3 = wp[(size_t)(k + 3) * ldw];
#pragma unroll
        for (int r = 0; r < 9; ++r) { const f32x4 s4 = *(LAS const f32x4*)(sl + r * 1024 + wave * 128 + k); acc[r] += (s4[0] * w0 + s4[1] * w1) + (s4[2] * w2 + s4[3] * w3); } }
#pragma unroll
    for (int r = 0; r < 9; ++r) red[(wave * 9 + r) * 64 + lane] = acc[r];
    __syncthreads();
    for (int i = tid; i < 9 * 64; i += 512) { const int r = i >> 6, ln = i & 63; float s = 0.f;
#pragma unroll
        for (int w = 0; w < 8; ++w) s += red[(w * 9 + r) * 64 + ln];
        const int n = n0 + ln; out[(size_t)r * ldw + (MAPIN ? rowmap_in(n) : n)] = s; }
    __syncthreads();
}
template <bool MAPIN> __device__ __forceinline__ void transpose_item(const float* W, int K, int N, bf16_t* WT, LAS float* scr, int item, int lane) {
    const int nblk = N / 32, kb = item / nblk, nb = item % nblk, k0 = 64 * kb, n0 = 32 * nb;
#pragma unroll
    for (int i = 0; i < 32; ++i) { const int kk = 2 * i + (lane >> 5); scr[kk * 33 + (lane & 31)] = W[(size_t)(k0 + kk) * N + n0 + (lane & 31)]; }
    asm volatile("s_waitcnt lgkmcnt(0)" ::: "memory");
    const int c = lane & 7;
#pragma unroll
    for (int j = 0; j < 4; ++j) { const int n = (lane >> 3) + 8 * j; const LAS float* s = scr + (8 * c) * 33 + n;
        u32x4 o; o.x = pk2(s[0 * 33], s[1 * 33]); o.y = pk2(s[2 * 33], s[3 * 33]); o.z = pk2(s[4 * 33], s[5 * 33]); o.w = pk2(s[6 * 33], s[7 * 33]);
        const int orow = MAPIN ? rowmap_in(n0 + n) : (n0 + n);
        *(u32x4*)(WT + (size_t)orow * K + k0 + 8 * c) = o; }
    asm volatile("s_waitcnt lgkmcnt(0)" ::: "memory");
}

#define XB_TMO      128
#define XB_XCNT(j)  (256  + 64 * (j))
#define XB_XSUB(j)  (1280 + 64 * (j))
#define XB_XGEN(j)  (2304 + 64 * (j))
#define XB_TOP      3328
#define XB_TOPGEN   3392
#define XCD_BAR_WORDS 3456
#define XB_SPIN_CAP (1u << 18)

__device__ __forceinline__ unsigned xb_ld(unsigned* p)              { return __hip_atomic_load(p, __ATOMIC_RELAXED, __HIP_MEMORY_SCOPE_AGENT); }
__device__ __forceinline__ unsigned xb_add(unsigned* p, unsigned v) { return __hip_atomic_fetch_add(p, v, __ATOMIC_RELAXED, __HIP_MEMORY_SCOPE_AGENT); }
__device__ __forceinline__ unsigned xb_xcc_id() { return (unsigned)__builtin_amdgcn_s_getreg((3 << 11) | 20) & 0xFu; }
#define XB_SPIN(cond, bar) do { unsigned _sp = 0; while (cond) { __builtin_amdgcn_s_sleep(1); \
    if ((++_sp & 255u) == 0u) { if (xb_ld(&(bar)[XB_TMO])) break; if (_sp > XB_SPIN_CAP) { atomicAdd(&(bar)[XB_TMO], 1u); break; } } } } while (0)

struct XcdBarrier {
    unsigned* bar; unsigned x; bool t0;
    volatile LAS unsigned* st;
};

__device__ __forceinline__ XcdBarrier xcd_barrier_post(unsigned* bar, volatile LAS unsigned* st) {
    XcdBarrier b; b.bar = bar; b.x = xb_xcc_id(); b.st = st; b.t0 = (threadIdx.x == 0);
    if (threadIdx.x == 0) (void)xb_add(&bar[XB_XCNT(b.x)], 1u);
    return b;
}
__device__ __forceinline__ void xcd_barrier_complete(unsigned* bar, unsigned x, unsigned& nloc, unsigned& nx) {
    const unsigned G = gridDim.x * gridDim.y * gridDim.z;
    unsigned sum, cnt, mine, sp = 0u;
    for (;;) {
        sum = 0u; cnt = 0u; mine = 0u;
#pragma unroll
        for (unsigned j = 0; j < 16; ++j) { const unsigned c = xb_ld(&bar[XB_XCNT(j)]); sum += c; cnt += (c > 0u) ? 1u : 0u; mine = (j == x) ? c : mine; }
        if (sum == G) break;
        __builtin_amdgcn_s_sleep(1);
        if ((++sp & 255u) == 0u) { if (xb_ld(&bar[XB_TMO])) break; if (sp > XB_SPIN_CAP) { atomicAdd(&bar[XB_TMO], 1u); break; } }
    }
    nloc = mine > 0u ? mine : 1u; nx = cnt > 0u ? cnt : 1u;
}

__device__ __forceinline__ void xcd_barrier(const XcdBarrier& b) {
    asm volatile("s_waitcnt vmcnt(0)" ::: "memory");
    __syncthreads();
    if (b.t0) {
        unsigned* bar = b.bar;
        __builtin_amdgcn_s_waitcnt(0);
        unsigned nloc = b.st[0], nx = b.st[1];
        if (nloc == 0u) { xcd_barrier_complete(bar, b.x, nloc, nx); b.st[0] = nloc; b.st[1] = nx; }
        const unsigned old = xb_add(&bar[XB_XSUB(b.x)], 1u);
        const unsigned gen = old / nloc;
        if (old + 1u == (gen + 1u) * nloc) {
            __builtin_amdgcn_fence(__ATOMIC_RELEASE, "agent");
            asm volatile("s_waitcnt vmcnt(0)" ::: "memory");
            const unsigned og = xb_add(&bar[XB_TOP], 1u);
            const unsigned tg = og / nx;
            if (og + 1u == (tg + 1u) * nx) xb_add(&bar[XB_TOPGEN], 1u);
            else XB_SPIN(xb_ld(&bar[XB_TOPGEN]) == tg, bar);
            __builtin_amdgcn_fence(__ATOMIC_ACQUIRE, "agent");
            xb_add(&bar[XB_XGEN(b.x)], 1u);
            asm volatile("s_waitcnt vmcnt(0)" ::: "memory");
        } else {
            XB_SPIN(xb_ld(&bar[XB_XGEN(b.x)]) == gen, bar);
            __builtin_amdgcn_fence(__ATOMIC_ACQUIRE, "agent");
            asm volatile("s_waitcnt vmcnt(0)" ::: "memory");
        }
    }
    __syncthreads();
}

constexpr int LDS_ST_OFF = 8 * att::WAVE_LDS + 512;
constexpr int LDS_BYTES = LDS_ST_OFF + 64;
static_assert(LDS_BYTES <= 160 * 1024 && LDS_BYTES >= pg8::STAGE_BYTES, "LDS budget");
constexpr int N_PHASES = 14;
struct Params { const float* in[21]; float* out; unsigned char* ws; int ph_lo, ph_hi; };

#ifndef REPMASK
#define REPMASK 0
#endif
#ifndef DRYMASK
#define DRYMASK 0
#endif
#define DRY(k) ((((DRYMASK) >> (k)) & 1) && rep_ == 0)
#ifndef PROBE_PHASE
#define PROBE_PHASE (-1)
#endif
#define PROBE_MULT 8
#ifndef EXTRA_SYNC
#define EXTRA_SYNC 0
#endif
__global__ void __launch_bounds__(512, 2) fwd_kernel(Params P) {
    extern __shared__ __attribute__((aligned(16))) unsigned char lds_raw[];
    LAS unsigned char* lds = (LAS unsigned char*)lds_raw;
    {   volatile LAS unsigned* bst0 = (volatile LAS unsigned*)(lds + LDS_ST_OFF);
        if (threadIdx.x < 16) bst0[threadIdx.x] = 0u;
        __syncthreads();
        (void)xcd_barrier_post((unsigned*)(P.ws + WS_BAR), bst0); }
#define GRID_SYNC() do { unsigned* bp_ = (unsigned*)(P.ws + WS_BAR); asm volatile("" : "+s"(bp_)); XcdBarrier b_; b_.bar = bp_; b_.x = xb_xcc_id(); b_.st = (volatile LAS unsigned*)(lds + LDS_ST_OFF); b_.t0 = (wave == 0) && (pg8::lane_id() == 0); xcd_barrier(b_); } while (0)
#define LANE_OPAQUE int ln_ = pg8::lane_id(); asm volatile("" : "+v"(ln_)); const int tid_ = wave * 64 + ln_; (void)tid_
#define WSP(T, off) ((T*)(ws + (off)))
#define MODL (WSP(const float, WS_MOD) + (size_t)ly * 9 * MODW)
#define XL ((ly == 0) ? P.in[0] : (const float*)P.out)
#define CL ((ly == 0) ? P.in[2] : WSP(const float, WS_CTX))
#define MROWS ((ly == 0) ? MALL : MLAT)
    const int ph_hi = P.ph_hi;
    const int wave = __builtin_amdgcn_readfirstlane(threadIdx.x >> 6);
#pragma unroll 1
    for (int ph = P.ph_lo; ph < ph_hi; ++ph) {
        int phv = ph; asm volatile("" : "+s"(phv));
        const __attribute__((address_space(4))) Params* pp_ = (const __attribute__((address_space(4))) Params*)__builtin_amdgcn_kernarg_segment_ptr(); asm volatile("" : "+s"(pp_));
#define P (*pp_)
        int kind = 0, ly = 0;
        if (phv >= 1) { const int idx = phv - 1; if (idx < 7) { kind = idx + 2 + (idx >= 4 ? 1 : 0); } else { const int j = idx - 7; ly = 1; kind = j + 2 + (j >= 4 ? 1 : 0); } }
        int G_ = gridDim.x, bx_ = blockIdx.x; asm volatile("" : "+s"(G_), "+s"(bx_));
        const int G = G_, bx = bx_; const int vcu = (G % 8 == 0) ? (bx % 8) * (G / 8) + bx / 8 : bx; const int gw = vcu * 8 + wave, ngw = G * 8;
        unsigned char* ws = P.ws;
        if (PROBE_PHASE >= 0 && ph == PROBE_PHASE && blockIdx.x == 0 && wave == 0 && pg8::lane_id() == 0) { const unsigned long long t_ = __builtin_amdgcn_s_memrealtime(); volatile LAS unsigned* pw_ = (volatile LAS unsigned*)(lds + LDS_ST_OFF + 32); pw_[0] = (unsigned)t_; pw_[1] = (unsigned)(t_ >> 32); }
#pragma unroll 1
        for (int rep_ = 0; rep_ <= (((REPMASK | DRYMASK) >> kind) & 1); ++rep_) {
        if (rep_) GRID_SYNC();
        switch (kind) {
        case 0: { LANE_OPAQUE;
            if (bx == G - 1) {
                LAS unsigned* red = (LAS unsigned*)lds;
                if (tid_ < 16) red[tid_] = 0u;
                __syncthreads();
                for (int l2 = 0; l2 < 2; ++l2) {
                    if (tid_ < 256) { const int k = tid_ >> 6, d = tid_ & 63; const float* src = P.in[k == 0 ? 9 : k == 1 ? 10 : k == 2 ? 14 : 15]; atomicMax((unsigned*)(red + l2 * 5 + k), __builtin_bit_cast(unsigned, fabsf(src[l2 * 64 + d]))); }
                    for (int i = tid_; i < 4 * 15 * 31; i += 512) atomicMax((unsigned*)(red + l2 * 5 + 4), __builtin_bit_cast(unsigned, fabsf(P.in[11][(size_t)l2 * 4 * 15 * 31 + i])));
                }
                __syncthreads();
                if (tid_ < 2) { const int l2 = tid_; const float gq = __builtin_bit_cast(float, red[l2 * 5 + 0]), gk = __builtin_bit_cast(float, red[l2 * 5 + 1]), wq = __builtin_bit_cast(float, red[l2 * 5 + 2]), wk = __builtin_bit_cast(float, red[l2 * 5 + 3]), rb = __builtin_bit_cast(float, red[l2 * 5 + 4]);
                    WSP(float, WS_GAIN)[512 + 2 * l2] = 11.5416f * gq * gk + rb * LOG2E + 0.25f; WSP(float, WS_GAIN)[512 + 2 * l2 + 1] = 11.5416f * wq * wk + 0.25f; }
                __syncthreads();
            }
            if (bx == G - 1) { for (int i = tid_; i < 512; i += 512) { const int l2 = i >> 8, k = (i >> 6) & 3, d = i & 63; const float* src = P.in[k == 0 ? 9 : k == 1 ? 10 : k == 2 ? 14 : 15]; WSP(float, WS_GAIN)[i] = src[l2 * 64 + d]; } }
            unsigned* modcnt = (unsigned*)(ws + WS_BAR) + 64;
            if (bx < 192) { mod_item(bx, P.in[1], P.in[3], P.in[4], P.in[5], WSP(float, WS_MOD), lds, tid_, wave, ln_);
                asm volatile("s_waitcnt vmcnt(0)" ::: "memory"); __syncthreads();
                if (tid_ == 0) { __builtin_amdgcn_fence(__ATOMIC_RELEASE, "agent"); asm volatile("s_waitcnt vmcnt(0)" ::: "memory"); (void)xb_add(modcnt, 1u); } }
            LAS float* scr = (LAS float*)(lds + wave * 16384);
            constexpr int I_IN = 16 * (INW / 32), I_O = 16 * (DM / 32), I_1 = 16 * (FFN / 32), I_2 = 64 * (DM / 32), I_L = I_IN + I_O + I_1 + I_2;
            const bool bal_ = (G == 256); const int it0 = bal_ ? ((bx < 192) ? 33 * bx : 6336 + 81 * (bx - 192)) + wave : gw, it1 = bal_ ? ((bx < 192) ? 33 * bx + 33 : 6336 + 81 * (bx - 192) + 81) : 2 * I_L, its = bal_ ? 8 : ngw;
            static_assert(192 * 33 + 64 * 81 == 2 * I_L, "transpose item split");
            for (int it = it0; it < it1; it += its) {
                const int l2 = it / I_L; int r = it - l2 * I_L;
                if (r < I_IN) { transpose_item<true>(P.in[8] + (size_t)l2 * DM * INW, DM, INW, WSP(bf16_t, WS_WIN) + (size_t)l2 * INW * DM, scr, r, ln_); continue; } r -= I_IN;
                if (r < I_O) { transpose_item<false>(P.in[18] + (size_t)l2 * DM * DM, DM, DM, WSP(bf16_t, WS_WO) + (size_t)l2 * DM * DM, scr, r, ln_); continue; } r -= I_O;
                if (r < I_1) { transpose_item<false>(P.in[19] + (size_t)l2 * DM * FFN, DM, FFN, WSP(bf16_t, WS_W1) + (size_t)l2 * FFN * DM, scr, r, ln_); continue; } r -= I_1;
                transpose_item<false>(P.in[20] + (size_t)l2 * FFN * DM, FFN, DM, WSP(bf16_t, WS_W2) + (size_t)l2 * DM * FFN, scr, r, ln_);
            }
            if (tid_ == 0) { const unsigned want = (unsigned)min(192, G); unsigned sp_ = 0u;
                while (xb_ld(modcnt) < want) { __builtin_amdgcn_s_sleep(2); if (++sp_ > (1u << 22)) break; }
                __builtin_amdgcn_fence(__ATOMIC_ACQUIRE, "agent"); asm volatile("s_waitcnt vmcnt(0)" ::: "memory"); }
            __syncthreads();
            for (int it = bx; it < 200; it += G) { const int l2 = it / 100, c = it % 100; const float* m2 = WSP(const float, WS_MOD) + (size_t)l2 * 9 * MODW;
                if (c < 36) bias_item<true>(P.in[8] + (size_t)l2 * DM * INW, INW, c * 64, m2, WSP(float, WS_BIN) + (size_t)l2 * 9 * INW, lds, tid_, wave, ln_);
                else bias_item<false>(P.in[19] + (size_t)l2 * DM * FFN, FFN, (c - 36) * 64, m2 + 3 * DM, WSP(float, WS_B1) + (size_t)l2 * 9 * FFN, lds, tid_, wave, ln_); }
            if (G == 256) { const int rb = (bx < 200) ? 59 * bx : min(MALL, 11800 + 119 * (bx - 200)), re = (bx < 200) ? rb + 59 : min(MALL, rb + 119);
                prep_pass(P.in[0], P.in[2], P.in[6], WSP(const float, WS_MOD), DM, WSP(bf16_t, WS_HN2), WSP(float, WS_RS1), rb + wave, re, 8, ln_); }
            else prep_pass(P.in[0], P.in[2], P.in[6], WSP(const float, WS_MOD), DM, WSP(bf16_t, WS_HN2), WSP(float, WS_RS1), gw, MALL, ngw, ln_);
        } break;
        case 2: { LANE_OPAQUE;
            pg8::Gemm g{WSP(bf16_t, WS_HN2), WSP(bf16_t, WS_WIN) + (size_t)ly * INW * DM, MALL, INW, DM}; pg8::StaticOrder S; S.init(MALL, INW, G, bx);
            pg8::EpiProj E{WSP(bf16_t, WS_PROJ), WSP(const float, WS_GAIN) + ly * 256, WSP(const float, WS_RS1), WSP(const float, WS_BIN) + (size_t)ly * 9 * INW};
            pg8::gemm_phase<pg8::EpiProj, pg8::StaticOrder, true, true>(lds, g, S, E, wave);
        } break;
        case 3: { LANE_OPAQUE;
            att::attn_phase(lds + wave * att::WAVE_LDS + 256, WSP(bf16_t, WS_PROJ), WSP(bf16_t, WS_OB), P.in[11] + (size_t)ly * 4 * 15 * 31, P.in[16] + ly * 8, WSP(const float, WS_GAIN) + 512 + 2 * ly, ly == 0, gw, ngw, ln_);
        } break;
        case 4: { LANE_OPAQUE;
            mix_pass(WSP(bf16_t, WS_PROJ), WSP(bf16_t, WS_OB), P.in[12] + (size_t)ly * 3 * 256, P.in[13] + ly * 256, P.in[17] + ly * DM, WSP(bf16_t, WS_HN), MROWS, gw, ngw, ln_);
        } break;
        case 5: { LANE_OPAQUE;
            pg8::Gemm g{WSP(bf16_t, WS_HN), WSP(bf16_t, WS_WO) + (size_t)ly * DM * DM, MROWS, DM, DM}; pg8::StaticOrder S; S.init(MROWS, DM, G, bx);
            pg8::EpiResid E{XL, CL, P.out, WSP(float, WS_CTX), MODL + 2 * DM, WSP(bf16_t, WS_HN2), P.in[7] + ly * DM, MODL + 4 * DM, WSP(float, WS_RS2), DRY(5), nullptr, false};
            pg8::gemm_phase<pg8::EpiResid, pg8::StaticOrder, true, true>(lds, g, S, E, wave);
        } break;
        case 7: { LANE_OPAQUE;
            pg8::Gemm g{WSP(bf16_t, WS_HN2), WSP(bf16_t, WS_W1) + (size_t)ly * FFN * DM, MROWS, FFN, DM}; pg8::StaticOrder S; S.init(MROWS, FFN, G, bx);
            pg8::EpiFc1 E{WSP(bf16_t, WS_H1), FFN, WSP(const float, WS_RS2), WSP(const float, WS_B1) + (size_t)ly * 9 * FFN};
            pg8::gemm_phase<pg8::EpiFc1, pg8::StaticOrder, true, true>(lds, g, S, E, wave);
        } break;
        case 8: { LANE_OPAQUE;
            pg8::Gemm g{WSP(bf16_t, WS_H1), WSP(bf16_t, WS_W2) + (size_t)ly * DM * FFN, MROWS, DM, FFN};
            if (ly == 0) {
                pg8::SplitOrder S; S.init(G, bx);
                pg8::EpiResid E{P.out, WSP(float, WS_CTX), P.out, WSP(float, WS_CTX), MODL + 5 * DM, WSP(bf16_t, WS_HN2), P.in[6] + DM, WSP(const float, WS_MOD) + (size_t)9 * MODW + DM, WSP(float, WS_RS1), DRY(8), (float*)ws, true};
                pg8::gemm_phase<pg8::EpiResid, pg8::SplitOrder, true, true>(lds, g, S, E, wave);
            } else {
                pg8::StaticOrder S; S.init(MROWS, DM, G, bx);
                pg8::EpiResid E{P.out, WSP(float, WS_CTX), P.out, WSP(float, WS_CTX), MODL + 5 * DM, (bf16_t*)nullptr, nullptr, nullptr, nullptr, DRY(8), nullptr, false};
                pg8::gemm_phase<pg8::EpiResid, pg8::StaticOrder, true, true>(lds, g, S, E, wave);
            }
        } break;
        default: { LANE_OPAQUE;
            ctx_rows_pass(ws, WSP(const float, WS_CTX), WSP(const float, WS_MOD) + (size_t)8 * MODW + 5 * DM, P.in[6] + DM, WSP(const float, WS_MOD) + (size_t)(9 + 8) * MODW + DM, WSP(bf16_t, WS_HN2), WSP(float, WS_RS1), gw, ngw, ln_);
        } break;
        }
        }
        for (int es_ = 0; es_ < EXTRA_SYNC; ++es_) GRID_SYNC();
        if (ph + 1 < ph_hi) GRID_SYNC();
        if (PROBE_PHASE >= 0 && ph == PROBE_PHASE && blockIdx.x == 0 && wave == 0 && pg8::lane_id() == 0) { const unsigned long long t_ = __builtin_amdgcn_s_memrealtime(); volatile LAS unsigned* pw_ = (volatile LAS unsigned*)(lds + LDS_ST_OFF + 32); pw_[2] = (unsigned)t_; pw_[3] = (unsigned)(t_ >> 32); }
#undef P
    }
    if (PROBE_PHASE >= 0 && blockIdx.x == 0 && wave == 0 && pg8::lane_id() == 0) {
        volatile LAS unsigned* pw_ = (volatile LAS unsigned*)(lds + LDS_ST_OFF + 32);
        const unsigned long long a_ = ((unsigned long long)pw_[1] << 32) | pw_[0], b_ = ((unsigned long long)pw_[3] << 32) | pw_[2];
        const unsigned long long span_ = (b_ - a_) * PROBE_MULT; const unsigned long long t0_ = __builtin_amdgcn_s_memrealtime();
        if (span_ < 100000000ull) while (__builtin_amdgcn_s_memrealtime() - t0_ < span_) __builtin_amdgcn_s_sleep(8);
    }
}

#ifndef MK_MULTI_LAUNCH
#define MK_MULTI_LAUNCH 0
#endif
extern "C" void kernel_launch(void* const* d_in, const int* in_sizes, int n_in, void* d_out, int out_size, void* d_ws, size_t ws_size, hipStream_t stream) {
    static int grid = 0;
    if (grid == 0) {
        if (n_in != 21 || out_size != MLAT * DM || ws_size < WS_END) { fprintf(stderr, "kernel_launch: unexpected shapes (n_in %d out %d ws %zu)\n", n_in, out_size, ws_size); grid = -1; return; }
        int dev = 0, cus = 0, per_cu = 0;
        if (hipGetDevice(&dev) != hipSuccess || hipDeviceGetAttribute(&cus, hipDeviceAttributeMultiprocessorCount, dev) != hipSuccess) { grid = -1; return; }
        if (hipFuncSetAttribute((const void*)fwd_kernel, hipFuncAttributeMaxDynamicSharedMemorySize, LDS_BYTES) != hipSuccess) { fprintf(stderr, "kernel_launch: hipFuncSetAttribute failed\n"); grid = -1; return; }
        if (hipOccupancyMaxActiveBlocksPerMultiprocessor(&per_cu, (const void*)fwd_kernel, 512, LDS_BYTES) != hipSuccess || per_cu < 1) { fprintf(stderr, "kernel_launch: occupancy query gave %d\n", per_cu); (void)hipGetLastError(); grid = -1; return; }
        grid = cus * per_cu;
    }
    if (grid < 0) return;
    Params p{};
    for (int i = 0; i < 21; ++i) p.in[i] = (const float*)d_in[i];
    p.out = (float*)d_out; p.ws = (unsigned char*)d_ws;
    if (hipMemsetAsync((char*)d_ws + WS_BAR, 0, XCD_BAR_WORDS * 4, stream) != hipSuccess) { fprintf(stderr, "kernel_launch: memset of the barrier words failed\n"); return; }
    void* args[] = {&p};
#if MK_MULTI_LAUNCH
    for (int ph = 0; ph < N_PHASES; ++ph) { p.ph_lo = ph; p.ph_hi = ph + 1;
        hipError_t e = hipLaunchCooperativeKernel((const void*)fwd_kernel, dim3(grid), dim3(512), args, LDS_BYTES, stream);
        if (e != hipSuccess) { fprintf(stderr, "launch %d failed: %s\n", ph, hipGetErrorString(e)); break; } }
#else
    p.ph_lo = 0; p.ph_hi = N_PHASES;
    hipError_t e = hipLaunchCooperativeKernel((const void*)fwd_kernel, dim3(grid), dim3(512), args, LDS_BYTES, stream);
    if (e != hipSuccess) fprintf(stderr, "cooperative launch failed: %s (grid %d)\n", hipGetErrorString(e), grid);
#endif
}
```

```cpp
#include <hip/hip_runtime.h>
#include <cstdio>
#include <cstdint>
namespace pg8 {
#define PG8_LAS __attribute__((address_space(3)))
typedef unsigned short bf16_t;
__device__ __forceinline__ int lane_id() { int r; asm volatile("v_mbcnt_lo_u32_b32 %0, -1, 0\n\tv_mbcnt_hi_u32_b32 %0, -1, %0" : "=v"(r)); return r; }
template <int K> __device__ __forceinline__ float shx(float v) { static_assert(K == 1 || K == 2 || K == 4 || K == 8 || K == 16, "xor mask"); return __builtin_bit_cast(float, __builtin_amdgcn_ds_swizzle(__builtin_bit_cast(int, v), 0x1f | (K << 10))); }
__device__ __forceinline__ void swap_halves(float& a, float& b) { asm("s_nop 1\n\tv_permlane32_swap_b32 %0, %1" : "+v"(a), "+v"(b)); }
__device__ __forceinline__ float sum_halves(float v) { float a = v, b = v; swap_halves(a, b); return a + b; }
__device__ __forceinline__ float max_halves(float v) { float a = v, b = v; swap_halves(a, b); return fmaxf(a, b); }
typedef short bf16x8 __attribute__((ext_vector_type(8)));
typedef float f32x4 __attribute__((ext_vector_type(4)));
typedef unsigned u32x4 __attribute__((ext_vector_type(4)));
constexpr int BM = 256, BK = 64, HALF = 128, HTB = HALF * BK * 2  , STAGE_BYTES = 8 * HTB, NXCD = 8, WGM = 8;

__host__ __device__ __forceinline__ int lds_byte(int r, int c) { const int st = (r >> 4) * 2 + (c >> 5), rr = r & 15, cc = c & 31, ob = rr * 64 + cc * 2; return st * 1024 + (ob ^ (((ob >> 9) & 1) << 5)); }
__host__ __device__ __forceinline__ void stage_rc(int b, int& R, int& C) { const int st = b / 1024, sb = b % 1024, swz = sb ^ (((sb >> 9) & 1) << 5); R = (st >> 1) * 16 + swz / 64; C = (st & 1) * 32 + (swz % 64) / 2; }
__host__ __device__ __forceinline__ int perm32(int rho) { const int n = rho >> 4, i = rho & 15; return 8 * (i >> 2) + 4 * n + (i & 3); }

struct Unit { int pm, pn, k0t, nt, ks; };
struct Gemm { const bf16_t* A; const bf16_t* Bt; int M, N, K; };

struct StaticOrder {
    int nM, nN, nwg, G, c;
    __host__ __device__ void init(int M, int N, int G_, int c_) { nM = M / BM; nN = N / BM; nwg = nM * nN; G = G_; c = c_; }
    __host__ __device__ __forceinline__ bool next(int i, Unit& u) const {
        const long L = (long)i * G + c; if (L >= nwg) { u.pm = 0; u.pn = 0; u.k0t = 0; u.nt = 0; u.ks = 0; return false; }
        int wgid = (int)L; { const int q = nwg / NXCD, r = nwg % NXCD, xcd = wgid % NXCD, off = wgid / NXCD; wgid = (xcd < r ? xcd * (q + 1) : r * (q + 1) + (xcd - r) * q) + off; }
        const int nig = WGM * nN, gid = wgid / nig, fm = gid * WGM, gsz = (nM - fm) < WGM ? (nM - fm) : WGM;
        u.pm = fm + ((wgid % nig) % gsz); u.pn = (wgid % nig) / gsz; u.k0t = 0; u.nt = 0; u.ks = 0; return true;
    }
    __device__ __forceinline__ void a_ready(const Unit&) const {}
    __device__ __forceinline__ void done(const Unit&) const {}
};
__device__ __forceinline__ unsigned cvt_pk_bf16(float lo, float hi) { unsigned r; asm volatile("v_cvt_pk_bf16_f32 %0, %1, %2" : "=v"(r) : "v"(lo), "v"(hi)); return r; }
typedef float f32x2 __attribute__((ext_vector_type(2)));
template <class Epi, class Sched, bool ALIGN_EPI = false, bool SP2 = false>
__device__ __forceinline__ void gemm_phase(PG8_LAS unsigned char* lds, const Gemm g, const Sched& S, const Epi& E, const int wid_in) {
    int tid_ = wid_in * 64 + lane_id(); asm volatile("" : "+v"(tid_));
    const int tid = tid_, wid = __builtin_amdgcn_readfirstlane(tid >> 6), lane = tid & 63, wr = wid >> 2, wc = wid & 3, fr = lane & 15, fq = lane >> 4;
    const int K = g.K, nt_all = K / BK;
    unsigned voffA[2], voffB[2];
#pragma unroll
    for (int i = 0; i < 2; ++i) { int R, C; stage_rc(tid * 16 + i * 8192, R, C); const int Rb = Epi::PERM ? ((R & ~31) + perm32(R & 31)) : R;
        voffA[i] = (unsigned)(R * K + C) * 2u; voffB[i] = (unsigned)(Rb * K + C) * 2u; }
    const size_t kstep = (size_t)(BK * 2);
    const size_t hstep = (size_t)HALF * K * 2;
    const size_t tstep = 2 * hstep;
    const unsigned ldsw = (unsigned)wid * 1024u;
    const int aoff = lds_byte(wr * 64 + fr, fq * 8), boff = lds_byte(wc * 32 + fr, fq * 8);
#define PG8_SA(b, h) (((b) * 2 + (h)) * HTB)
#define PG8_SB(b, h) ((4 + (b) * 2 + (h)) * HTB)
#define PG8_STAGE(bufoff, gbase, voff) do { _Pragma("unroll") for (int _i = 0; _i < 2; ++_i) \
        __builtin_amdgcn_global_load_lds((const unsigned*)((const char*)(gbase) + (voff)[_i]), (PG8_LAS unsigned*)(lds + (bufoff) + ldsw + _i * 8192), 16, 0, 0); } while (0)
#define PG8_LDA(dst, b, h) do { _Pragma("unroll") for (int m = 0; m < 4; ++m) _Pragma("unroll") for (int k = 0; k < 2; ++k) dst[m][k] = *(const PG8_LAS bf16x8*)(lds + PG8_SA(b, h) + aoff + m * 2048 + k * 1024); } while (0)
#define PG8_LDB(dst, b, h) do { _Pragma("unroll") for (int n = 0; n < 2; ++n) _Pragma("unroll") for (int k = 0; k < 2; ++k) dst[n][k] = *(const PG8_LAS bf16x8*)(lds + PG8_SB(b, h) + boff + n * 2048 + k * 1024); } while (0)
#define PG8_MMA(ai, bj, At, Bt) do { __builtin_amdgcn_s_setprio(1); _Pragma("unroll") for (int m = 0; m < 4; ++m) _Pragma("unroll") for (int n = 0; n < 2; ++n) _Pragma("unroll") for (int k = 0; k < 2; ++k) \
        acc[ai][bj][m][n] = __builtin_amdgcn_mfma_f32_16x16x32_bf16(Bt[n][k], At[m][k], acc[ai][bj][m][n], 0, 0, 0); __builtin_amdgcn_s_setprio(0); } while (0)
#define PG8_WAIT_V(n) asm volatile("s_waitcnt vmcnt(" #n ")" ::: "memory")
#define PG8_WAIT_L(n) asm volatile("s_waitcnt lgkmcnt(" #n ")" ::: "memory")
#define PG8_BAR __builtin_amdgcn_s_barrier()
#define PG8_SCHED __builtin_amdgcn_sched_barrier(0)
    Unit cur, nxt; int ui = 0;
    if (!S.next(0, cur)) return;
    f32x4 acc[2][2][4][2];
#pragma unroll
    for (int a = 0; a < 2; ++a)
#pragma unroll
        for (int b = 0; b < 2; ++b)
#pragma unroll
            for (int m = 0; m < 4; ++m)
#pragma unroll
                for (int n = 0; n < 2; ++n) acc[a][b][m][n] = (f32x4){0.f, 0.f, 0.f, 0.f};
    bf16x8 At[4][2], B0[2][2], B1[2][2];
    const char* cA = (const char*)g.A + (size_t)cur.pm * tstep + (size_t)cur.k0t * kstep; const char* cB = (const char*)g.Bt + (size_t)cur.pn * tstep + (size_t)cur.k0t * kstep;
    int nt = cur.nt ? cur.nt : nt_all;
    S.a_ready(cur);
    if constexpr (SP2) {
        PG8_STAGE(PG8_SB(0, 0), cB, voffB); PG8_STAGE(PG8_SB(0, 1), cB + hstep, voffB); PG8_STAGE(PG8_SA(0, 0), cA, voffA); PG8_STAGE(PG8_SA(0, 1), cA + hstep, voffA);
        if (wr == 1) PG8_BAR;
        PG8_WAIT_V(2); PG8_BAR;
        PG8_STAGE(PG8_SB(1, 0), cB + kstep, voffB); PG8_STAGE(PG8_SA(1, 0), cA + kstep, voffA); PG8_STAGE(PG8_SB(1, 1), cB + hstep + kstep, voffB);
        PG8_WAIT_V(6); PG8_BAR;
    } else {
        PG8_STAGE(PG8_SB(0, 0), cB, voffB); PG8_STAGE(PG8_SA(0, 0), cA, voffA); PG8_STAGE(PG8_SB(0, 1), cB + hstep, voffB); PG8_STAGE(PG8_SA(0, 1), cA + hstep, voffA);
        if (wr == 1) PG8_BAR;
        PG8_WAIT_V(4); PG8_BAR;
        PG8_STAGE(PG8_SB(1, 0), cB + kstep, voffB); PG8_STAGE(PG8_SA(1, 0), cA + kstep, voffA); PG8_STAGE(PG8_SB(1, 1), cB + hstep + kstep, voffB);
        PG8_WAIT_V(6); PG8_BAR;
    }
    for (;;) {
        const bool has_next = S.next(ui + 1, nxt);
        const char* nA = has_next ? (const char*)g.A + (size_t)nxt.pm * tstep + (size_t)nxt.k0t * kstep : cA; const char* nB = has_next ? (const char*)g.Bt + (size_t)nxt.pn * tstep + (size_t)nxt.k0t * kstep : cB;
        for (int t = 0; t < nt; t += 2) {
            const bool last = (t == nt - 2);
            const char* a1 = cA + (size_t)(t + 1) * kstep;
            const char* a2 = last ? nA : cA + (size_t)(t + 2) * kstep; const char* b2 = last ? nB : cB + (size_t)(t + 2) * kstep;
            const char* a3 = a2 + kstep; const char* b3 = b2 + kstep;
            if (last && has_next) S.a_ready(nxt);
            if constexpr (SP2) {
            PG8_LDB(B0, 0, 0); PG8_LDB(B1, 0, 1); PG8_SCHED; PG8_LDA(At, 0, 0); PG8_STAGE(PG8_SA(1, 1), a1 + hstep, voffA);
            PG8_WAIT_V(8); PG8_WAIT_L(0); PG8_BAR; PG8_MMA(0, 0, At, B0); PG8_MMA(0, 1, At, B1); PG8_BAR; PG8_SCHED;
            PG8_LDA(At, 0, 1); PG8_STAGE(PG8_SB(0, 0), b2, voffB); PG8_STAGE(PG8_SB(0, 1), b2 + hstep, voffB); PG8_STAGE(PG8_SA(0, 0), a2, voffA);
            PG8_WAIT_V(8); PG8_WAIT_L(0); PG8_BAR; PG8_MMA(1, 0, At, B0); PG8_MMA(1, 1, At, B1); PG8_BAR; PG8_SCHED;
            PG8_LDB(B0, 1, 0); PG8_LDB(B1, 1, 1); PG8_SCHED; PG8_LDA(At, 1, 0); PG8_STAGE(PG8_SA(0, 1), a2 + hstep, voffA);
            PG8_WAIT_V(8); PG8_WAIT_L(0); PG8_BAR; PG8_MMA(0, 0, At, B0); PG8_MMA(0, 1, At, B1); PG8_BAR; PG8_SCHED;
            PG8_LDA(At, 1, 1); PG8_STAGE(PG8_SB(1, 0), b3, voffB); PG8_STAGE(PG8_SB(1, 1), b3 + hstep, voffB); PG8_STAGE(PG8_SA(1, 0), a3, voffA);
            PG8_WAIT_V(8); PG8_WAIT_L(0); PG8_BAR; PG8_MMA(1, 0, At, B0); PG8_MMA(1, 1, At, B1); PG8_BAR; PG8_SCHED;
            } else {
            PG8_LDB(B0, 0, 0); PG8_SCHED; PG8_LDA(At, 0, 0); PG8_STAGE(PG8_SA(1, 1), a1 + hstep, voffA);
            PG8_WAIT_L(8); PG8_BAR; PG8_WAIT_L(0); PG8_MMA(0, 0, At, B0); PG8_BAR; PG8_SCHED;
            PG8_LDB(B1, 0, 1); PG8_STAGE(PG8_SB(0, 0), b2, voffB);
            PG8_BAR; PG8_WAIT_L(0); PG8_MMA(0, 1, At, B1); PG8_BAR;
            PG8_LDA(At, 0, 1); PG8_STAGE(PG8_SA(0, 0), a2, voffA);
            PG8_BAR; PG8_WAIT_L(0); PG8_MMA(1, 0, At, B0); PG8_BAR; PG8_SCHED;
            PG8_STAGE(PG8_SB(0, 1), b2 + hstep, voffB);
            PG8_WAIT_V(6); PG8_BAR; PG8_MMA(1, 1, At, B1); PG8_BAR;
            PG8_LDB(B0, 1, 0); PG8_SCHED; PG8_LDA(At, 1, 0); PG8_STAGE(PG8_SA(0, 1), a2 + hstep, voffA);
            PG8_WAIT_L(8); PG8_BAR; PG8_WAIT_L(0); PG8_MMA(0, 0, At, B0); PG8_BAR; PG8_SCHED;
            PG8_LDB(B1, 1, 1); PG8_STAGE(PG8_SB(1, 0), b3, voffB);
            PG8_BAR; PG8_WAIT_L(0); PG8_MMA(0, 1, At, B1); PG8_BAR;
            PG8_LDA(At, 1, 1); PG8_STAGE(PG8_SA(1, 0), a3, voffA);
            PG8_BAR; PG8_WAIT_L(0); PG8_MMA(1, 0, At, B0); PG8_BAR; PG8_SCHED;
            PG8_STAGE(PG8_SB(1, 1), b3 + hstep, voffB);
            PG8_WAIT_V(6); PG8_BAR; PG8_MMA(1, 1, At, B1); PG8_BAR;
            }
        }
        if constexpr (ALIGN_EPI) { if (wr == 0) PG8_BAR; }
        if constexpr (!Epi::AFTER_DRAIN) { E(acc, cur, wr, wc, fr, fq); S.done(cur); }
        if (!has_next) break;
#pragma unroll
        for (int a = 0; a < 2; ++a)
#pragma unroll
            for (int b = 0; b < 2; ++b)
#pragma unroll
                for (int m = 0; m < 4; ++m)
#pragma unroll
                    for (int n = 0; n < 2; ++n) acc[a][b][m][n] = (f32x4){0.f, 0.f, 0.f, 0.f};
        cur = nxt; cA = nA; cB = nB; ++ui; nt = cur.nt ? cur.nt : nt_all;
        if constexpr (ALIGN_EPI) { if (wr == 1) PG8_BAR; }
    }
    PG8_WAIT_V(0);
    if constexpr (!ALIGN_EPI) { if (wr == 0) PG8_BAR; }
    PG8_BAR;
    if constexpr (Epi::AFTER_DRAIN) { E.fused(acc, cur, wr, wc, fr, fq, lds, wid, lane); S.done(cur); }
#undef PG8_SA
#undef PG8_SB
#undef PG8_STAGE
#undef PG8_LDA
#undef PG8_LDB
#undef PG8_MMA
#undef PG8_WAIT_V
#undef PG8_WAIT_L
#undef PG8_BAR
#undef PG8_SCHED
}
}

namespace pg8 {
typedef unsigned u32x2 __attribute__((ext_vector_type(2)));
template <int ACT> struct EpiStore {
    static constexpr bool PERM = true, AFTER_DRAIN = false;
    bf16_t* O; int ldc;
    __device__ __forceinline__ void operator()(const f32x4 (&acc)[2][2][4][2], const Unit& u, int wr, int wc, int fr, int fq) const {
        const int row0 = u.pm * BM + wr * 64 + fr, col0 = u.pn * BM + wc * 32 + 8 * fq;
#pragma unroll
        for (int ai = 0; ai < 2; ++ai)
#pragma unroll
            for (int m = 0; m < 4; ++m) { bf16_t* rowp = O + (size_t)(row0 + ai * HALF + m * 16) * ldc + col0;
#pragma unroll
                for (int bj = 0; bj < 2; ++bj) { f32x4 v0 = acc[ai][bj][m][0], v1 = acc[ai][bj][m][1];
                    if (ACT == 2) {
#pragma unroll
                        for (int e = 0; e < 4; ++e) { const float a = fmaxf(v0[e], 0.f), b = fmaxf(v1[e], 0.f); v0[e] = a * a; v1[e] = b * b; } }
                    u32x4 w; w.x = cvt_pk_bf16(v0[0], v0[1]); w.y = cvt_pk_bf16(v0[2], v0[3]); w.z = cvt_pk_bf16(v1[0], v1[1]); w.w = cvt_pk_bf16(v1[2], v1[3]);
                    *(u32x4*)(rowp + bj * HALF) = w; } }
    }
};


__device__ __forceinline__ void rows_rstd(const float* rs, int row0, int fq, float (&rstd)[2][4]) {
    f32x4 p[2][4];
#pragma unroll
    for (int ai = 0; ai < 2; ++ai)
#pragma unroll
        for (int m = 0; m < 4; ++m) p[ai][m] = *(const f32x4*)(rs + (size_t)(row0 + ai * HALF + m * 16) * 16 + 4 * fq);
#pragma unroll
    for (int ai = 0; ai < 2; ++ai)
#pragma unroll
        for (int m = 0; m < 4; ++m) { float s = (p[ai][m][0] + p[ai][m][1]) + (p[ai][m][2] + p[ai][m][3]); s += shx<16>(s); s = sum_halves(s); rstd[ai][m] = 1.0f / sqrtf(s * (1.0f / 1024.0f) + 1e-6f); }
}
struct EpiFc1 {
    static constexpr bool PERM = true, AFTER_DRAIN = false;
    bf16_t* O; int ldc; const float* rs; const float* bias;
    __device__ __forceinline__ void operator()(const f32x4 (&acc)[2][2][4][2], const Unit& u, int wr, int wc, int fr_in, int fq_in) const {
        (void)fr_in; (void)fq_in; int ln_e = lane_id(); asm volatile("" : "+v"(ln_e)); const int fr = ln_e & 15, fq = ln_e >> 4;
        const int row0 = u.pm * BM + wr * 64 + fr, col0 = u.pn * BM + wc * 32 + 8 * fq; const int b = (u.pm < 64) ? (u.pm >> 3) : 8;
        f32x4 bv[2][2];
#pragma unroll
        for (int bj = 0; bj < 2; ++bj)
#pragma unroll
            for (int n = 0; n < 2; ++n) bv[bj][n] = *(const f32x4*)(bias + (size_t)b * ldc + col0 + bj * HALF + 4 * n);
        float rsd[2][4]; rows_rstd(rs, row0, fq, rsd);
#pragma unroll
        for (int ai = 0; ai < 2; ++ai)
#pragma unroll
            for (int m = 0; m < 4; ++m) { const int row = row0 + ai * HALF + m * 16; const float rstd = rsd[ai][m]; bf16_t* rowp = O + (size_t)row * ldc + col0;
#pragma unroll
                for (int bj = 0; bj < 2; ++bj) { f32x4 v0 = acc[ai][bj][m][0] * rstd + bv[bj][0], v1 = acc[ai][bj][m][1] * rstd + bv[bj][1];
#pragma unroll
                    for (int e = 0; e < 4; ++e) { const float a = fmaxf(v0[e], 0.f), c = fmaxf(v1[e], 0.f); v0[e] = a * a; v1[e] = c * c; }
                    u32x4 w; w.x = cvt_pk_bf16(v0[0], v0[1]); w.y = cvt_pk_bf16(v0[2], v0[3]); w.z = cvt_pk_bf16(v1[0], v1[1]); w.w = cvt_pk_bf16(v1[2], v1[3]);
                    *(u32x4*)(rowp + bj * HALF) = w; }
                asm volatile("" ::: "memory"); }
    }
};


__host__ __device__ __forceinline__ size_t slab_off(int i) { const size_t MiB_ = (size_t)1 << 20; return i < 36 ? 234 * MiB_ + (size_t)i * 262144 : i < 64 ? 249 * MiB_ + (size_t)(i - 36) * 262144 : 14 * MiB_ + (size_t)(i - 64) * 262144; }
struct SplitOrder {
    StaticOrder lat; int G, c;
    __host__ __device__ void init(int G_, int c_) { lat.init(64 * BM, 4 * BM, G_, c_); G = G_; c = c_; }
    __host__ __device__ __forceinline__ bool next(int i, Unit& u) const {
        const long L = (long)i * G + c;
        Unit t; const bool okl = lat.next(i, t);
        const int s = (int)(L - 256), unit = s >> 2; const bool isl = L < 256;
        u.pm = isl ? t.pm : 64 + (unit >> 2); u.pn = isl ? t.pn : (unit & 3); u.ks = isl ? 0 : (s & 3); u.k0t = isl ? 0 : (s & 3) * 16; u.nt = isl ? 0 : 16;
        return isl ? okl : (s < 128);
    }
    __device__ __forceinline__ void a_ready(const Unit&) const {}
    __device__ __forceinline__ void done(const Unit&) const {}
};

struct EpiResid {
    static constexpr bool PERM = true, AFTER_DRAIN = false;
    const float* base_lat; const float* base_ctx; float* out_lat; float* out_ctx; const float* gate;
    bf16_t* aout; const float* gn; const float* scn; float* rsout;
    bool dry;
    float* slab; bool split_ctx;
    __device__ __forceinline__ void operator()(const f32x4 (&acc)[2][2][4][2], const Unit& u, int wr, int wc, int fr_in, int fq_in) const {
        (void)fr_in; (void)fq_in; int ln_e = lane_id(); asm volatile("" : "+v"(ln_e)); const int fr = ln_e & 15, fq = ln_e >> 4;
        if (dry) return;
        const bool lat = u.pm < 64;
        const int b = lat ? (u.pm >> 3) : 8;
        const size_t roff = (size_t)(lat ? u.pm : u.pm - 64) * BM * 1024;
        const float* base = (lat ? base_lat : base_ctx) + roff; float* out = (lat ? out_lat : out_ctx) + roff;
        const int col0 = u.pn * BM + wc * 32 + 8 * fq;
        f32x4 gv[2][2];
#pragma unroll
        for (int bj = 0; bj < 2; ++bj)
#pragma unroll
            for (int n = 0; n < 2; ++n) gv[bj][n] = *(const f32x4*)(gate + (size_t)b * 6144 + col0 + bj * HALF + n * 4);
        if (u.ks != 0) {
            float* sp = (float*)((unsigned char*)slab + slab_off(((u.pm - 64) * 4 + u.pn) * 3 + (u.ks - 1))) + wc * 32 + 8 * fq;
#pragma unroll
            for (int ai = 0; ai < 2; ++ai)
#pragma unroll
                for (int m = 0; m < 4; ++m) { float* rp = sp + (size_t)(ai * HALF + wr * 64 + m * 16 + fr) * 256;
#pragma unroll
                    for (int bj = 0; bj < 2; ++bj) { *(f32x4*)(rp + bj * HALF) = acc[ai][bj][m][0]; *(f32x4*)(rp + bj * HALF + 4) = acc[ai][bj][m][1]; } }
            return;
        }
        if (aout == nullptr || (split_ctx && !lat)) {
#pragma unroll
            for (int ai = 0; ai < 2; ++ai)
#pragma unroll
                for (int m = 0; m < 4; ++m) { const size_t off = (size_t)(ai * HALF + wr * 64 + m * 16 + fr) * 1024 + col0;
#pragma unroll
                    for (int bj = 0; bj < 2; ++bj)
#pragma unroll
                        for (int n = 0; n < 2; ++n) { const f32x4 bs = *(const f32x4*)(base + off + bj * HALF + n * 4);
                            *(f32x4*)(out + off + bj * HALF + n * 4) = bs + gv[bj][n] * acc[ai][bj][m][n]; }
                    if (m & 1) asm volatile("" ::: "memory"); }
            return;
        }
        f32x4 Gv[2][2];
#pragma unroll
        for (int bj = 0; bj < 2; ++bj)
#pragma unroll
            for (int n = 0; n < 2; ++n) Gv[bj][n] = *(const f32x4*)(gn + col0 + bj * HALF + n * 4) * (*(const f32x4*)(scn + (size_t)b * 6144 + col0 + bj * HALF + n * 4) + 1.0f);
        const size_t grow0 = (size_t)u.pm * BM;
#pragma unroll
        for (int ai = 0; ai < 2; ++ai)
#pragma unroll
            for (int m = 0; m < 4; ++m) { const int rl = ai * HALF + wr * 64 + m * 16 + fr; const size_t off = (size_t)rl * 1024 + col0; float ss = 0.f;
                bf16_t* ap = aout + (grow0 + rl) * 1024 + col0;
#pragma unroll
                for (int bj = 0; bj < 2; ++bj) {
                    const f32x4 b0 = *(const f32x4*)(base + off + bj * HALF), b1 = *(const f32x4*)(base + off + bj * HALF + 4);
                    const f32x4 x0 = b0 + gv[bj][0] * acc[ai][bj][m][0], x1 = b1 + gv[bj][1] * acc[ai][bj][m][1];
                    *(f32x4*)(out + off + bj * HALF) = x0; *(f32x4*)(out + off + bj * HALF + 4) = x1;
                    ss += ((x0[0] * x0[0] + x0[1] * x0[1]) + (x0[2] * x0[2] + x0[3] * x0[3])) + ((x1[0] * x1[0] + x1[1] * x1[1]) + (x1[2] * x1[2] + x1[3] * x1[3]));
                    const f32x4 y0 = x0 * Gv[bj][0], y1 = x1 * Gv[bj][1];
                    u32x4 w; w.x = cvt_pk_bf16(y0[0], y0[1]); w.y = cvt_pk_bf16(y0[2], y0[3]); w.z = cvt_pk_bf16(y1[0], y1[1]); w.w = cvt_pk_bf16(y1[2], y1[3]);
                    *(u32x4*)(ap + bj * HALF) = w; }
                ss += shx<16>(ss); ss = sum_halves(ss);
                if (fq == 0) rsout[(grow0 + rl) * 16 + u.pn * 4 + wc] = ss;
                if (m & 1) asm volatile("" ::: "memory"); }
    }
};

struct EpiProj {
    static constexpr bool PERM = true, AFTER_DRAIN = false;
    bf16_t* O; const float* gains;
    const float* rs; const float* bias;
    __device__ __forceinline__ void operator()(const f32x4 (&acc)[2][2][4][2], const Unit& u, int wr, int wc, int fr_in, int fq_in) const {
        (void)fr_in; (void)fq_in; int ln_e = lane_id(); asm volatile("" : "+v"(ln_e)); const int fr = ln_e & 15, fq = ln_e >> 4;
        const int pn = u.pn; const int row0 = u.pm * BM + wr * 64 + fr; const int b = (u.pm < 64) ? (u.pm >> 3) : 8;
        f32x4 bv[2][2];
#pragma unroll
        for (int bj = 0; bj < 2; ++bj)
#pragma unroll
            for (int n = 0; n < 2; ++n) bv[bj][n] = *(const f32x4*)(bias + (size_t)b * 2304 + pn * BM + bj * HALF + wc * 32 + 8 * fq + 4 * n);
        float rsd[2][4]; rows_rstd(rs, row0, fq, rsd);
        if (pn >= 2 && pn <= 5) {
            const int col0 = pn * BM + wc * 32 + 8 * fq;
#pragma unroll
            for (int ai = 0; ai < 2; ++ai)
#pragma unroll
                for (int m = 0; m < 4; ++m) { bf16_t* rowp = O + (size_t)(row0 + ai * HALF + m * 16) * 2304 + col0; const float rstd = rsd[ai][m];
#pragma unroll
                    for (int bj = 0; bj < 2; ++bj) { const f32x4 v0 = acc[ai][bj][m][0] * rstd + bv[bj][0], v1 = acc[ai][bj][m][1] * rstd + bv[bj][1];
                        u32x4 w; w.x = cvt_pk_bf16(v0[0], v0[1]); w.y = cvt_pk_bf16(v0[2], v0[3]); w.z = cvt_pk_bf16(v1[0], v1[1]); w.w = cvt_pk_bf16(v1[2], v1[3]);
                        *(u32x4*)(rowp + bj * HALF) = w; } }
            return;
        }
        const int colh = pn * BM + wc * 64 + 8 * fq;
        const bool vhead = (pn == 8) && (wc >= 2);
        if (vhead) {
#pragma unroll
            for (int ai = 0; ai < 2; ++ai)
#pragma unroll
                for (int m = 0; m < 4; ++m) { bf16_t* rowp = O + (size_t)(row0 + ai * HALF + m * 16) * 2304 + colh; const float rstd = rsd[ai][m];
#pragma unroll
                    for (int bj = 0; bj < 2; ++bj) { const f32x4 v0 = acc[ai][bj][m][0] * rstd + bv[bj][0], v1 = acc[ai][bj][m][1] * rstd + bv[bj][1];
                        u32x4 w; w.x = cvt_pk_bf16(v0[0], v0[1]); w.y = cvt_pk_bf16(v0[2], v0[3]); w.z = cvt_pk_bf16(v1[0], v1[1]); w.w = cvt_pk_bf16(v1[2], v1[3]);
                        *(u32x4*)(rowp + bj * 32) = w; } }
            return;
        }
        const float* gp = gains + 64 * ((pn == 0) ? 0 : (pn == 1) ? 1 : (pn == 8) ? 3 : 2);
        const float qs = (pn == 1 || pn == 8) ? 1.0f : 0.18033688011112042f;
        const bool rope = (pn >= 6) && (u.pm < 64);
        f32x4 gv[2][2];
#pragma unroll
        for (int bj = 0; bj < 2; ++bj)
#pragma unroll
            for (int n = 0; n < 2; ++n) gv[bj][n] = *(const f32x4*)(gp + 32 * bj + 16 * n + 4 * fq);
        float invrev[4];
#pragma unroll
        for (int e = 0; e < 4; ++e) invrev[e] = __builtin_amdgcn_exp2f(-(float)(4 * fq + e) * (13.287712379549449f / 16.0f)) * 0.15915494309189535f;
#pragma unroll
        for (int ai = 0; ai < 2; ++ai)
#pragma unroll
            for (int m = 0; m < 4; ++m) {
                const int row = row0 + ai * HALF + m * 16; const float rstd0 = rsd[ai][m];
                f32x4 v[2][2]; float ss = 0.f;
#pragma unroll
                for (int bj = 0; bj < 2; ++bj)
#pragma unroll
                    for (int n = 0; n < 2; ++n) v[bj][n] = acc[ai][bj][m][n] * rstd0 + bv[bj][n];
                asm volatile("" : "+v"(v[0][0]), "+v"(v[0][1]), "+v"(v[1][0]), "+v"(v[1][1]));
#pragma unroll
                for (int bj = 0; bj < 2; ++bj)
#pragma unroll
                    for (int n = 0; n < 2; ++n) { const f32x4 x = v[bj][n]; ss += (x[0] * x[0] + x[1] * x[1]) + (x[2] * x[2] + x[3] * x[3]); }
                ss += shx<16>(ss); ss = sum_halves(ss);
                const float rstd = 1.0f / sqrtf(ss * (1.0f / 64.0f) + 1e-6f);
#pragma unroll
                for (int bj = 0; bj < 2; ++bj)
#pragma unroll
                    for (int n = 0; n < 2; ++n) v[bj][n] = v[bj][n] * rstd * gv[bj][n];
                if (rope) {
                    const int t = row & 2047;
#pragma unroll
                    for (int bj = 0; bj < 2; ++bj) { const float pos = (float)(bj == 0 ? (t >> 6) : (t & 63));
#pragma unroll
                        for (int e = 0; e < 4; ++e) { float rev = pos * invrev[e]; rev = rev - floorf(rev);
                            const float cs = __builtin_amdgcn_cosf(rev), sn = __builtin_amdgcn_sinf(rev);
                            const float u1 = v[bj][0][e], u2 = v[bj][1][e];
                            v[bj][0][e] = u1 * cs - u2 * sn; v[bj][1][e] = u2 * cs + u1 * sn; } }
                }
                bf16_t* rowp = O + (size_t)row * 2304 + colh;
#pragma unroll
                for (int bj = 0; bj < 2; ++bj) { const f32x4 v0 = v[bj][0] * qs, v1 = v[bj][1] * qs;
                    u32x4 w; w.x = cvt_pk_bf16(v0[0], v0[1]); w.y = cvt_pk_bf16(v0[2], v0[3]); w.z = cvt_pk_bf16(v1[0], v1[1]); w.w = cvt_pk_bf16(v1[2], v1[3]);
                    *(u32x4*)(rowp + bj * 32) = w; }
                asm volatile("" ::: "memory");
            }
    }
};
}

#define LAS __attribute__((address_space(3)))
typedef unsigned short bf16_t;
typedef short bf16x8 __attribute__((ext_vector_type(8)));
typedef short s16x4 __attribute__((ext_vector_type(4)));
typedef float f32x16 __attribute__((ext_vector_type(16)));
typedef float f32x4 __attribute__((ext_vector_type(4)));
typedef unsigned u32x4 __attribute__((ext_vector_type(4)));
typedef unsigned u32x2 __attribute__((ext_vector_type(2)));

constexpr int DM = 1024, NB = 8, SEQ = 2048, CTXL = 256, FFN = 4096, INW = 2304;
constexpr int MLAT = NB * SEQ, MCTX = NB * CTXL, MALL = MLAT + MCTX;
constexpr float EPSN = 1e-6f, LOG2E = 1.4426950408889634f, NEGBIG = -1e30f;
constexpr int MODW = 6 * DM;
constexpr size_t MiB = (size_t)1 << 20;
constexpr size_t WS_MOD = 0;
constexpr size_t WS_GAIN = 512 * 1024;
constexpr size_t WS_BAR = 768 * 1024;
constexpr size_t WS_WIN = 1 * MiB;
constexpr size_t WS_WO = 10 * MiB;
constexpr size_t WS_W1 = 14 * MiB;
constexpr size_t WS_W2 = 30 * MiB;
constexpr size_t WS_CTX = 46 * MiB;
constexpr size_t WS_HN2 = 54 * MiB;
constexpr size_t WS_HN = 207 * MiB;
constexpr size_t WS_H1 = 90 * MiB;
constexpr size_t WS_PROJ = 90 * MiB;
constexpr size_t WS_OB = 171 * MiB;
constexpr size_t WS_RS1 = 243 * MiB;
constexpr size_t WS_RS2 = 245 * MiB;
constexpr size_t WS_BIN = 247 * MiB;
constexpr size_t WS_B1 = 248 * MiB;
constexpr size_t WS_END = 256 * MiB;
static_assert(WS_W1 == 14 * MiB, "pg8::slab_off places 32 slabs in the first layer's fc1 weight copy");

__device__ __forceinline__ float half_sum(float v) { v += pg8::shx<1>(v); v += pg8::shx<2>(v); v += pg8::shx<4>(v); v += pg8::shx<8>(v); v += pg8::shx<16>(v); return v; }
__device__ __forceinline__ float wave_sum(float v) { return pg8::sum_halves(half_sum(v)); }
__device__ __forceinline__ unsigned f2bf(float f) { unsigned u = __builtin_bit_cast(unsigned, f); return (u + 0x7fffu + ((u >> 16) & 1u)) >> 16; }
__device__ __forceinline__ unsigned pk2(float lo, float hi) { return f2bf(lo) | (f2bf(hi) << 16); }
__device__ __forceinline__ float bf_lo(unsigned u) { return __builtin_bit_cast(float, u << 16); }
__device__ __forceinline__ float bf_hi(unsigned u) { return __builtin_bit_cast(float, u & 0xffff0000u); }

namespace att {
constexpr int KROWB = 144, VROWB = 128, WL_V = 64 * KROWB, WL_A = WL_V + 64 * VROWB, WL_TAB = WL_A + 128 + 192, WAVE_LDS = WL_TAB + 15 * 32 * 4;
typedef float f32x2_t __attribute__((ext_vector_type(2))); typedef __bf16 bf16x2_t __attribute__((ext_vector_type(2)));
typedef short v4i16_t __attribute__((ext_vector_type(4)));
__device__ __forceinline__ unsigned cvtpk(float lo, float hi) { f32x2_t v = {lo, hi}; bf16x2_t b = __builtin_convertvector(v, bf16x2_t); return __builtin_bit_cast(unsigned, b); }
__device__ __forceinline__ s16x4 vtr(LAS const unsigned char* p) { return __builtin_bit_cast(s16x4, __builtin_amdgcn_ds_read_tr16_b64_v4i16((LAS v4i16_t*)p)); }
struct AU { int qrow0, qcol, kcol, vcol, ocol, ctxrow0, nloc, locrow0, a0, a1; float negc, l0; const float* rpb; };
template <int KIND> __device__ __forceinline__ void attn_unit(LAS unsigned char* wl, const bf16_t* __restrict__ proj, bf16_t* __restrict__ obuf, const AU u, const int lane) {
    const int r32 = lane & 31, hi = lane >> 5;
    LAS float* sc = (LAS float*)(wl + WL_A);
    LAS float* tab = (LAS float*)(wl + WL_TAB);
    bf16x8 qr[4];
    { const bf16_t* qp = proj + (size_t)(u.qrow0 + r32) * INW + u.qcol + hi * 8;
#pragma unroll
      for (int d0 = 0; d0 < 4; ++d0) qr[d0] = *(const bf16x8*)(qp + d0 * 16); }
    if (KIND == 0) { for (int i = lane; i < 15 * 31; i += 64) { const int a = i / 31, b = i - a * 31; tab[a * 32 + b] = u.rpb[i] * LOG2E; } }
    f32x16 o0, o1;
#pragma unroll
    for (int r = 0; r < 16; ++r) { o0[r] = 0.f; o1[r] = 0.f; }
    float l = (hi == 0) ? u.l0 : 0.f;
    const int nt = 4 + u.nloc;
    const int lrow = lane >> 3, lch = lane & 7;
    u32x4 kreg[8], vreg[8];
#define ATT_LOAD_TILE(t) do { int row0_ = ((t) < 4) ? u.ctxrow0 + 64 * (t) : u.locrow0 + 64 * ((t) - 4); int step_ = 8, extra_ = 0; \
        if (KIND == 0 && (t) >= 4) { if ((t) < 8) { row0_ = u.locrow0 + 128 * ((t) - 4); extra_ = 32; } else { row0_ = u.locrow0 - u.a1 + (u.a1 ? 24 : 32); step_ = 64; } } \
        const bf16_t* bp_ = proj + (size_t)(row0_ + lrow) * INW + lch * 8; \
        _Pragma("unroll") for (int i_ = 0; i_ < 8; ++i_) { const size_t o_ = (size_t)(i_ * step_ + (i_ >= 4 ? extra_ : 0)) * INW; kreg[i_] = *(const u32x4*)(bp_ + o_ + u.kcol); vreg[i_] = *(const u32x4*)(bp_ + o_ + u.vcol); } } while (0)
    ATT_LOAD_TILE(0);
    LAS unsigned char* kw = wl + lrow * KROWB + lch * 16;
    LAS unsigned char* vw = wl + WL_V + lrow * VROWB + lch * 16;
    LAS const unsigned char* kf = wl + r32 * KROWB + hi * 16;
    LAS const unsigned char* vf = wl + WL_V + (4 * hi + ((lane & 15) >> 2)) * VROWB + ((lane >> 4) & 1) * 32 + (lane & 3) * 8;
    for (int t = 0; t < nt; ++t) {
#pragma unroll
        for (int i = 0; i < 8; ++i) { *(LAS u32x4*)(kw + i * 8 * KROWB) = kreg[i]; *(LAS u32x4*)(vw + i * 8 * VROWB) = vreg[i]; }
        if (t + 1 < nt) ATT_LOAD_TILE(t + 1);
        f32x16 p0, p1;
#pragma unroll
        for (int r = 0; r < 16; ++r) { p0[r] = 0.f; p1[r] = 0.f; }
#pragma unroll
        for (int d0 = 0; d0 < 4; ++d0) {
            const bf16x8 a0 = *(LAS const bf16x8*)(kf + d0 * 32), a1 = *(LAS const bf16x8*)(kf + 32 * KROWB + d0 * 32);
            p0 = __builtin_amdgcn_mfma_f32_32x32x16_bf16(a0, qr[d0], p0, 0, 0, 0);
            p1 = __builtin_amdgcn_mfma_f32_32x32x16_bf16(a1, qr[d0], p1, 0, 0, 0);
        }
        if (KIND == 0) { if (t >= 4) {
            const int qc = u.a1 + r32; const int cs = min(max(qc - 8, 0), 48);
            if (t < 8) {
                const int kb = u.a1 + 4 * hi - cs; const volatile LAS float* tb = tab + (u.a0 + 2 * (t - 4)) * 32 + 15 - qc + u.a1 + 4 * hi;
#pragma unroll
                for (int r = 0; r < 16; ++r) { const int kc = (r & 3) + 8 * (r >> 2);
                    const float b0_ = tb[kc], b1_ = tb[kc + 32]; const bool ok_ = (unsigned)(kb + kc) < 16u;
                    p0[r] = ok_ ? p0[r] + b0_ : NEGBIG; p1[r] = ok_ ? p1[r] + b1_ : NEGBIG; }
            } else {
                const int cs0 = u.a1 ? 24 : 32; const int kb = cs0 + 4 * hi - cs; const volatile LAS float* tb = tab + u.a0 * 32 + 15 - qc + cs0 + 4 * hi;
#pragma unroll
                for (int r = 0; r < 16; ++r) { const int e_ = (r >> 2) * 32 + (r & 3);
                    const float b0_ = tb[e_], b1_ = tb[e_ + 128]; const bool ok_ = (unsigned)(kb + (r & 3)) < 16u;
                    p0[r] = ok_ ? p0[r] + b0_ : NEGBIG; p1[r] = ok_ ? p1[r] + b1_ : NEGBIG; }
            } } }
        if (KIND == 1) { const int tb0_ = u.a0 + 64 * (t - 4);
          if (t >= 4 && (tb0_ < -97 || tb0_ > 65)) {
            const int d0_ = tb0_ + 4 * hi - r32 + 128;
#pragma unroll
            for (int r = 0; r < 16; ++r) { const int kc = (r & 3) + 8 * (r >> 2);
                p0[r] = ((unsigned)(d0_ + kc) <= 256u) ? p0[r] : NEGBIG;
                p1[r] = ((unsigned)(d0_ + kc + 32) <= 256u) ? p1[r] : NEGBIG; } } }
        if (u.negc != 0.f) {
#pragma unroll
            for (int r = 0; r < 16; ++r) { p0[r] += u.negc; p1[r] += u.negc; } }
        float rs = 0.f;
#pragma unroll
        for (int r = 0; r < 16; ++r) { p0[r] = __builtin_amdgcn_exp2f(p0[r]); p1[r] = __builtin_amdgcn_exp2f(p1[r]); rs += p0[r] + p1[r]; }
        l += rs;
        u32x4 pa[4];
#pragma unroll
        for (int j = 0; j < 4; ++j) { pa[0][j] = cvtpk(p0[2 * j], p0[2 * j + 1]); pa[1][j] = cvtpk(p0[8 + 2 * j], p0[8 + 2 * j + 1]); pa[2][j] = cvtpk(p1[2 * j], p1[2 * j + 1]); pa[3][j] = cvtpk(p1[8 + 2 * j], p1[8 + 2 * j + 1]); }
#pragma unroll
        for (int ks = 0; ks < 4; ++ks) {
            const s16x4 l0 = vtr(vf + ks * 16 * VROWB), h0 = vtr(vf + ks * 16 * VROWB + 8 * VROWB);
            const s16x4 l1 = vtr(vf + ks * 16 * VROWB + 64), h1 = vtr(vf + ks * 16 * VROWB + 8 * VROWB + 64);
            const bf16x8 b0 = (bf16x8){l0[0], l0[1], l0[2], l0[3], h0[0], h0[1], h0[2], h0[3]}, b1 = (bf16x8){l1[0], l1[1], l1[2], l1[3], h1[0], h1[1], h1[2], h1[3]};
            o0 = __builtin_amdgcn_mfma_f32_32x32x16_bf16(__builtin_bit_cast(bf16x8, pa[ks]), b0, o0, 0, 0, 0);
            o1 = __builtin_amdgcn_mfma_f32_32x32x16_bf16(__builtin_bit_cast(bf16x8, pa[ks]), b1, o1, 0, 0, 0);
        }
    }
#undef ATT_LOAD_TILE
    const float lt = pg8::sum_halves(l);
    if (hi == 0) sc[r32] = 1.0f / lt;
    bf16_t* ob = obuf + (size_t)u.qrow0 * DM + u.ocol + r32;
#pragma unroll
    for (int g = 0; g < 4; ++g) { const f32x4 a = *(LAS const f32x4*)(sc + 8 * g + 4 * hi);
#pragma unroll
        for (int i = 0; i < 4; ++i) { const int q = i + 8 * g + 4 * hi; bf16_t* op = ob + (size_t)q * DM;
            op[0] = (bf16_t)f2bf(o0[4 * g + i] * a[i]); op[32] = (bf16_t)f2bf(o1[4 * g + i] * a[i]); } }
}

__device__ __forceinline__ void attn_phase(LAS unsigned char* wl, const bf16_t* proj, bf16_t* obuf, const float* rpb_l, const float* sink_l, const float* cb_l, bool with_ctx, int gw, int ngw, int lane) {
    const float cb_na = fmaxf(cb_l[0] - 64.f, 0.f), cb_wa = fmaxf(cb_l[1] - 64.f, 0.f);
    const bool spread = (ngw == 2048);
    const int total = 2048 + 4096 + (with_ctx ? (spread ? 2048 : 768) : 0);
    for (int i0 = gw; i0 < total; i0 += ngw) {
        int i = i0; AU u;
        if (i < 2048) {
            const int half = i & 1, h = (i >> 1) & 3, r = (i >> 3) & 31, b = i >> 8; const int rs = min(max(r - 4, 0), 24);
            u.qrow0 = b * SEQ + r * 64 + 32 * half; u.qcol = 64 * h; u.kcol = 256 + 64 * h; u.vcol = 512 + 64 * h; u.ocol = 64 * h; u.ctxrow0 = MLAT + b * CTXL;
            u.nloc = 5; u.locrow0 = b * SEQ + rs * 64 + 32 * half; u.a0 = rs - r + 7; u.a1 = 32 * half; u.negc = -cb_na; u.l0 = 0.f; u.rpb = rpb_l + h * (15 * 31);
            attn_unit<0>(wl, proj, obuf, u, lane);
            continue;
        }
        i -= 2048;
        if (i < 4096) {
            const int ch = i & 63, h = (i >> 6) & 7, b = i >> 9; const int qpos0 = 32 * ch;
            const int kt0 = max(0, (qpos0 - 128) >> 6), kt1 = min(31, (qpos0 + 159) >> 6);
            u.qrow0 = b * SEQ + qpos0; u.qcol = 1536 + 64 * h; u.kcol = 2048 + 64 * (h >> 2); u.vcol = 2176 + 64 * (h >> 2); u.ocol = 512 + 64 * h; u.ctxrow0 = MLAT + b * CTXL;
            u.nloc = kt1 - kt0 + 1; u.locrow0 = b * SEQ + 64 * kt0; u.a0 = 64 * kt0 - qpos0; u.a1 = 0; u.negc = -cb_wa; u.l0 = __builtin_amdgcn_exp2f(sink_l[h] * LOG2E - cb_wa); u.rpb = nullptr;
            attn_unit<1>(wl, proj, obuf, u, lane);
            continue;
        }
        i -= 4096;
        if (spread) { const int w_ = i & 7; if (w_ >= 3) continue; i = (i >> 3) * 3 + w_; }
        if (i < 256) {
            const int ch = i & 7, h = (i >> 3) & 3, b = i >> 5;
            u.qrow0 = MLAT + b * CTXL + 32 * ch; u.qcol = 64 * h; u.kcol = 256 + 64 * h; u.vcol = 512 + 64 * h; u.ocol = 64 * h; u.negc = -cb_na; u.l0 = 0.f; u.ctxrow0 = MLAT + b * CTXL;
        } else {
            i -= 256; const int ch = i & 7, h = (i >> 3) & 7, b = i >> 6;
            u.qrow0 = MLAT + b * CTXL + 32 * ch; u.qcol = 1536 + 64 * h; u.kcol = 2048 + 64 * (h >> 2); u.vcol = 2176 + 64 * (h >> 2); u.ocol = 512 + 64 * h; u.negc = -cb_wa; u.l0 = __builtin_amdgcn_exp2f(sink_l[h] * LOG2E - cb_wa); u.ctxrow0 = MLAT + b * CTXL;
        }
        u.nloc = 0; u.locrow0 = 0; u.a0 = 0; u.a1 = 0; u.rpb = nullptr;
        attn_unit<2>(wl, proj, obuf, u, lane);
    }
}
}

__device__ __forceinline__ void prep_pass(const float* __restrict__ xlat, const float* __restrict__ xctx, const float* __restrict__ g, const float* __restrict__ modl, int scoff, bf16_t* __restrict__ hn, float* __restrict__ rs, int m_begin, int m_end, int m_step, int lane) {
#pragma unroll 2
    for (int m = m_begin; m < m_end; m += m_step) {
        const bool lat = m < MLAT; const float* xr = lat ? xlat + (size_t)m * DM : xctx + (size_t)(m - MLAT) * DM; const int b = lat ? (m >> 11) : 8;
        f32x4 v[4]; float ss = 0.f;
#pragma unroll
        for (int j = 0; j < 4; ++j) { v[j] = *(const f32x4*)(xr + 4 * lane + 256 * j); ss += (v[j][0] * v[j][0] + v[j][1] * v[j][1]) + (v[j][2] * v[j][2] + v[j][3] * v[j][3]); }
        ss = wave_sum(ss);
        if (lane < 16) rs[(size_t)m * 16 + lane] = (lane == 0) ? ss : 0.f;
        const float* mb = modl + (size_t)b * MODW;
#pragma unroll
        for (int j = 0; j < 4; ++j) { const int c = 4 * lane + 256 * j;
            const f32x4 gg = *(const f32x4*)(g + c), scv = *(const f32x4*)(mb + scoff + c);
            const f32x4 y = v[j] * gg * (scv + 1.0f);
            u32x2 w; w.x = pk2(y[0], y[1]); w.y = pk2(y[2], y[3]);
            *(u32x2*)(hn + (size_t)m * DM + c) = w; }
    }
}
__device__ __forceinline__ void ctx_rows_pass(const unsigned char* ws, const float* ctxbuf, const float* gate, const float* gn, const float* scn, bf16_t* hn2, float* rs, int gw, int ngw, int lane) {
    for (int r = gw; r < MCTX; r += ngw) {
        const int pmc = r >> 8, rl = r & 255; f32x4 x[4]; float ss = 0.f;
#pragma unroll
        for (int j = 0; j < 4; ++j) { const int c = 4 * lane + 256 * j; f32x4 p = {0.f, 0.f, 0.f, 0.f};
#pragma unroll
            for (int ks = 0; ks < 3; ++ks) p += *(const f32x4*)((const float*)(ws + pg8::slab_off((pmc * 4 + j) * 3 + ks)) + (size_t)rl * 256 + 4 * lane);
            x[j] = *(const f32x4*)(ctxbuf + (size_t)r * DM + c) + *(const f32x4*)(gate + c) * p;
            ss += (x[j][0] * x[j][0] + x[j][1] * x[j][1]) + (x[j][2] * x[j][2] + x[j][3] * x[j][3]); }
        ss = wave_sum(ss);
        const int m = MLAT + r;
        if (lane < 16) rs[(size_t)m * 16 + lane] = (lane == 0) ? ss : 0.f;
#pragma unroll
        for (int j = 0; j < 4; ++j) { const int c = 4 * lane + 256 * j;
            const f32x4 y = x[j] * (*(const f32x4*)(gn + c)) * (*(const f32x4*)(scn + c) + 1.0f);
            u32x2 w; w.x = pk2(y[0], y[1]); w.y = pk2(y[2], y[3]);
            *(u32x2*)(hn2 + (size_t)m * DM + c) = w; }
    }
}

__device__ __forceinline__ void mix_pass(const bf16_t* __restrict__ proj, const bf16_t* __restrict__ obuf, const float* __restrict__ convw, const float* __restrict__ convb, const float* __restrict__ gout, bf16_t* __restrict__ abuf, int nrows, int gw, int ngw, int lane) {
#pragma unroll 2
    for (int m = gw; m < nrows; m += ngw) {
        float va[8];
        if (lane < 32) {
            const u32x4 raw = *(const u32x4*)(obuf + (size_t)m * DM + 8 * lane);
#pragma unroll
            for (int j = 0; j < 4; ++j) { va[2 * j] = bf_lo(raw[j]); va[2 * j + 1] = bf_hi(raw[j]); }
        } else {
            const int c = 8 * (lane - 32); const bool lat = m < MLAT; const int t = lat ? (m & (SEQ - 1)) : ((m - MLAT) & (CTXL - 1)); const int L = lat ? SEQ : CTXL;
            const bf16_t* pr = proj + (size_t)m * INW;
            const u32x4 cx = *(const u32x4*)(pr + 768 + c), cb = *(const u32x4*)(pr + 1024 + c), cc = *(const u32x4*)(pr + 1280 + c);
            u32x4 pxm = {0u, 0u, 0u, 0u}, pcm = {0u, 0u, 0u, 0u}, pxp = {0u, 0u, 0u, 0u}, pcp = {0u, 0u, 0u, 0u};
            if (t > 0) { pxm = *(const u32x4*)(pr - INW + 768 + c); pcm = *(const u32x4*)(pr - INW + 1280 + c); }
            if (t < L - 1) { pxp = *(const u32x4*)(pr + INW + 768 + c); pcp = *(const u32x4*)(pr + INW + 1280 + c); }
            const f32x4 w0a = *(const f32x4*)(convw + c), w0b = *(const f32x4*)(convw + c + 4), w1a = *(const f32x4*)(convw + 256 + c), w1b = *(const f32x4*)(convw + 256 + c + 4),
                        w2a = *(const f32x4*)(convw + 512 + c), w2b = *(const f32x4*)(convw + 512 + c + 4), bba = *(const f32x4*)(convb + c), bbb = *(const f32x4*)(convb + c + 4);
#pragma unroll
            for (int j = 0; j < 4; ++j) {
                const float w0l = j < 2 ? w0a[2 * j] : w0b[2 * j - 4], w0h = j < 2 ? w0a[2 * j + 1] : w0b[2 * j - 3];
                const float w1l = j < 2 ? w1a[2 * j] : w1b[2 * j - 4], w1h = j < 2 ? w1a[2 * j + 1] : w1b[2 * j - 3];
                const float w2l = j < 2 ? w2a[2 * j] : w2b[2 * j - 4], w2h = j < 2 ? w2a[2 * j + 1] : w2b[2 * j - 3];
                const float bl = j < 2 ? bba[2 * j] : bbb[2 * j - 4], bh = j < 2 ? bba[2 * j + 1] : bbb[2 * j - 3];
                const float ul = bf_lo(cc[j]) * bf_lo(cx[j]), uh = bf_hi(cc[j]) * bf_hi(cx[j]);
                const float uml = bf_lo(pcm[j]) * bf_lo(pxm[j]), umh = bf_hi(pcm[j]) * bf_hi(pxm[j]);
                const float upl = bf_lo(pcp[j]) * bf_lo(pxp[j]), uph = bf_hi(pcp[j]) * bf_hi(pxp[j]);
                va[2 * j] = bf_lo(cb[j]) * (bl + w0l * uml + w1l * ul + w2l * upl);
                va[2 * j + 1] = bf_hi(cb[j]) * (bh + w0h * umh + w1h * uh + w2h * uph);
            }
        }
        float ssa = 0.f;
#pragma unroll
        for (int j = 0; j < 8; ++j) ssa += va[j] * va[j];
        ssa = half_sum(ssa); const float rsa = 1.0f / sqrtf(ssa * (1.0f / 256.0f) + EPSN);
        { const f32x4 g0 = *(const f32x4*)(gout + 8 * lane), g1 = *(const f32x4*)(gout + 8 * lane + 4);
          u32x4 w; w.x = pk2(va[0] * rsa * g0[0], va[1] * rsa * g0[1]); w.y = pk2(va[2] * rsa * g0[2], va[3] * rsa * g0[3]); w.z = pk2(va[4] * rsa * g1[0], va[5] * rsa * g1[1]); w.w = pk2(va[6] * rsa * g1[2], va[7] * rsa * g1[3]);
          *(u32x4*)(abuf + (size_t)m * DM + 8 * lane) = w; }
        float vb[8];
        { const u32x4 raw = *(const u32x4*)(obuf + (size_t)m * DM + 512 + 8 * lane);
#pragma unroll
          for (int j = 0; j < 4; ++j) { vb[2 * j] = bf_lo(raw[j]); vb[2 * j + 1] = bf_hi(raw[j]); } }
        float ssb = 0.f;
#pragma unroll
        for (int j = 0; j < 8; ++j) ssb += vb[j] * vb[j];
        ssb = wave_sum(ssb); const float rsb = 1.0f / sqrtf(ssb * (1.0f / 512.0f) + EPSN);
        { const f32x4 g0 = *(const f32x4*)(gout + 512 + 8 * lane), g1 = *(const f32x4*)(gout + 512 + 8 * lane + 4);
          u32x4 w; w.x = pk2(vb[0] * rsb * g0[0], vb[1] * rsb * g0[1]); w.y = pk2(vb[2] * rsb * g0[2], vb[3] * rsb * g0[3]); w.z = pk2(vb[4] * rsb * g1[0], vb[5] * rsb * g1[1]); w.w = pk2(vb[6] * rsb * g1[2], vb[7] * rsb * g1[3]);
          *(u32x4*)(abuf + (size_t)m * DM + 512 + 8 * lane) = w; }
    }
}

__device__ __forceinline__ void mod_item(int item, const float* c, const float* cctx, const float* wmod, const float* bmod, float* mod, LAS unsigned char* lds, int tid, int wave, int lane) {
    LAS float* sl = (LAS float*)lds;
    LAS float* red = (LAS float*)(lds + 9 * 1024 * 4);
    const int l = item / 96, n0 = (item % 96) * 64;
    for (int i = tid; i < 9 * 1024; i += 512) { const int r = i >> 10, k = i & 1023; const float v = r < 8 ? c[r * 1024 + k] : cctx[k]; sl[i] = v / (1.0f + __expf(-v)); }
    __syncthreads();
    float acc[9];
#pragma unroll
    for (int r = 0; r < 9; ++r) acc[r] = 0.f;
    const float* wp = wmod + ((size_t)l * 1024 + wave * 128) * MODW + n0 + lane;
#pragma unroll 4
    for (int k = 0; k < 128; k += 4) {
        const float w0 = wp[(size_t)k * MODW], w1 = wp[(size_t)(k + 1) * MODW], w2 = wp[(size_t)(k + 2) * MODW], w3 = wp[(size_t)(k + 3) * MODW];
#pragma unroll
        for (int r = 0; r < 9; ++r) { const f32x4 s4 = *(LAS const f32x4*)(sl + r * 1024 + wave * 128 + k); acc[r] += (s4[0] * w0 + s4[1] * w1) + (s4[2] * w2 + s4[3] * w3); } }
#pragma unroll
    for (int r = 0; r < 9; ++r) red[(wave * 9 + r) * 64 + lane] = acc[r];
    __syncthreads();
    for (int i = tid; i < 9 * 64; i += 512) { const int r = i >> 6, ln = i & 63; float s = bmod[l * MODW + n0 + ln];
#pragma unroll
        for (int w = 0; w < 8; ++w) s += red[(w * 9 + r) * 64 + ln];
        mod[((size_t)l * 9 + r) * MODW + n0 + ln] = s; }
    __syncthreads();
}
__device__ __forceinline__ int rowmap_in(int c) {
    const int pn = c >> 8; if (pn >= 2 && pn <= 5) return c;
    const int wc = (c >> 6) & 3, d = c & 63, bj = d >> 5; const bool vhead = (pn == 8) && (wc >= 2);
    int n, fq; const int e = d & 3;
    if (!vhead) { n = (d >> 4) & 1; fq = (d >> 2) & 3; } else { fq = (d >> 3) & 3; n = (d >> 2) & 1; }
    return pn * 256 + bj * 128 + wc * 32 + fq * 8 + n * 4 + e;
}
template <bool MAPIN> __device__ __forceinline__ void bias_item(const float* W, int ldw, int n0, const float* shrows  , float* out  , LAS unsigned char* lds, int tid, int wave, int lane) {
    LAS float* sl = (LAS float*)lds;
    LAS float* red = (LAS float*)(lds + 9 * 1024 * 4);
    for (int i = tid; i < 9 * 1024; i += 512) { const int r = i >> 10, k = i & 1023; sl[i] = shrows[(size_t)r * MODW + k]; }
    __syncthreads();
    float acc[9];
#pragma unroll
    for (int r = 0; r < 9; ++r) acc[r] = 0.f;
    const float* wp = W + (size_t)(wave * 128) * ldw + n0 + lane;
#pragma unroll 4
    for (int k = 0; k < 128; k += 4) {
        const float w0 = wp[(size_t)k * ldw], w1 = wp[(size_t)(k + 1) * ldw], w2 = wp[(size_t)(k + 2) * ldw], w3 = wp[(size_t)(k + 3) * ldw];
#pragma unroll
        for (int r = 0; r < 9; ++r) { const f32x4 s4 = *(LAS const f32x4*)(sl + r * 1024 + wave * 128 + k); acc[r] += (s4[0] * w0 + s4[1] * w1) + (s4[2] * w2 + s4[3] * w3); } }
#pragma unroll
    for (int r = 0; r < 9; ++r) red[(wave * 9 + r) * 64 + lane] = acc[r];
    __syncthreads();
    for (int i = tid; i < 9 * 64; i += 512) { const int r = i >> 6, ln = i & 63; float s = 0.f;
#pragma unroll
        for (int w = 0; w < 8; ++w) s += red[(w * 9 + r) * 64 + ln];
        const int n = n0 + ln; out[(size_t)r * ldw + (MAPIN ? rowmap_in(n) : n)] = s; }
    __syncthreads();
}
template <bool MAPIN> __device__ __forceinline__ void transpose_item(const float* W, int K, int N, bf16_t* WT, LAS float* scr, int item, int lane) {
    const int nblk = N / 32, kb = item / nblk, nb = item % nblk, k0 = 64 * kb, n0 = 32 * nb;
#pragma unroll
    for (int i = 0; i < 32; ++i) { const int kk = 2 * i + (lane >> 5); scr[kk * 33 + (lane & 31)] = W[(size_t)(k0 + kk) * N + n0 + (lane & 31)]; }
    asm volatile("s_waitcnt lgkmcnt(0)" ::: "memory");
    const int c = lane & 7;
#pragma unroll
    for (int j = 0; j < 4; ++j) { const int n = (lane >> 3) + 8 * j; const LAS float* s = scr + (8 * c) * 33 + n;
        u32x4 o; o.x = pk2(s[0 * 33], s[1 * 33]); o.y = pk2(s[2 * 33], s[3 * 33]); o.z = pk2(s[4 * 33], s[5 * 33]); o.w = pk2(s[6 * 33], s[7 * 33]);
        const int orow = MAPIN ? rowmap_in(n0 + n) : (n0 + n);
        *(u32x4*)(WT + (size_t)orow * K + k0 + 8 * c) = o; }
    asm volatile("s_waitcnt lgkmcnt(0)" ::: "memory");
}

#define XB_TMO      128
#define XB_XCNT(j)  (256  + 64 * (j))
#define XB_XSUB(j)  (1280 + 64 * (j))
#define XB_XGEN(j)  (2304 + 64 * (j))
#define XB_TOP      3328
#define XB_TOPGEN   3392
#define XCD_BAR_WORDS 3456
#define XB_SPIN_CAP (1u << 18)

__device__ __forceinline__ unsigned xb_ld(unsigned* p)              { return __hip_atomic_load(p, __ATOMIC_RELAXED, __HIP_MEMORY_SCOPE_AGENT); }
__device__ __forceinline__ unsigned xb_add(unsigned* p, unsigned v) { return __hip_atomic_fetch_add(p, v, __ATOMIC_RELAXED, __HIP_MEMORY_SCOPE_AGENT); }
__device__ __forceinline__ unsigned xb_xcc_id() { return (unsigned)__builtin_amdgcn_s_getreg((3 << 11) | 20) & 0xFu; }
#define XB_SPIN(cond, bar) do { unsigned _sp = 0; while (cond) { __builtin_amdgcn_s_sleep(1); \
    if ((++_sp & 255u) == 0u) { if (xb_ld(&(bar)[XB_TMO])) break; if (_sp > XB_SPIN_CAP) { atomicAdd(&(bar)[XB_TMO], 1u); break; } } } } while (0)

struct XcdBarrier {
    unsigned* bar; unsigned x; bool t0;
    volatile LAS unsigned* st;
};

__device__ __forceinline__ XcdBarrier xcd_barrier_post(unsigned* bar, volatile LAS unsigned* st) {
    XcdBarrier b; b.bar = bar; b.x = xb_xcc_id(); b.st = st; b.t0 = (threadIdx.x == 0);
    if (threadIdx.x == 0) (void)xb_add(&bar[XB_XCNT(b.x)], 1u);
    return b;
}
__device__ __forceinline__ void xcd_barrier_complete(unsigned* bar, unsigned x, unsigned& nloc, unsigned& nx) {
    const unsigned G = gridDim.x * gridDim.y * gridDim.z;
    unsigned sum, cnt, mine, sp = 0u;
    for (;;) {
        sum = 0u; cnt = 0u; mine = 0u;
#pragma unroll
        for (unsigned j = 0; j < 16; ++j) { const unsigned c = xb_ld(&bar[XB_XCNT(j)]); sum += c; cnt += (c > 0u) ? 1u : 0u; mine = (j == x) ? c : mine; }
        if (sum == G) break;
        __builtin_amdgcn_s_sleep(1);
        if ((++sp & 255u) == 0u) { if (xb_ld(&bar[XB_TMO])) break; if (sp > XB_SPIN_CAP) { atomicAdd(&bar[XB_TMO], 1u); break; } }
    }
    nloc = mine > 0u ? mine : 1u; nx = cnt > 0u ? cnt : 1u;
}

__device__ __forceinline__ void xcd_barrier(const XcdBarrier& b) {
    asm volatile("s_waitcnt vmcnt(0)" ::: "memory");
    __syncthreads();
    if (b.t0) {
        unsigned* bar = b.bar;
        __builtin_amdgcn_s_waitcnt(0);
        unsigned nloc = b.st[0], nx = b.st[1];
        if (nloc == 0u) { xcd_barrier_complete(bar, b.x, nloc, nx); b.st[0] = nloc; b.st[1] = nx; }
        const unsigned old = xb_add(&bar[XB_XSUB(b.x)], 1u);
        const unsigned gen = old / nloc;
        if (old + 1u == (gen + 1u) * nloc) {
            __builtin_amdgcn_fence(__ATOMIC_RELEASE, "agent");
            asm volatile("s_waitcnt vmcnt(0)" ::: "memory");
            const unsigned og = xb_add(&bar[XB_TOP], 1u);
            const unsigned tg = og / nx;
            if (og + 1u == (tg + 1u) * nx) xb_add(&bar[XB_TOPGEN], 1u);
            else XB_SPIN(xb_ld(&bar[XB_TOPGEN]) == tg, bar);
            __builtin_amdgcn_fence(__ATOMIC_ACQUIRE, "agent");
            xb_add(&bar[XB_XGEN(b.x)], 1u);
            asm volatile("s_waitcnt vmcnt(0)" ::: "memory");
        } else {
            XB_SPIN(xb_ld(&bar[XB_XGEN(b.x)]) == gen, bar);
            __builtin_amdgcn_fence(__ATOMIC_ACQUIRE, "agent");
            asm volatile("s_waitcnt vmcnt(0)" ::: "memory");
        }
    }
    __syncthreads();
}

constexpr int LDS_ST_OFF = 8 * att::WAVE_LDS + 512;
constexpr int LDS_BYTES = LDS_ST_OFF + 64;
static_assert(LDS_BYTES <= 160 * 1024 && LDS_BYTES >= pg8::STAGE_BYTES, "LDS budget");
constexpr int N_PHASES = 14;
struct Params { const float* in[21]; float* out; unsigned char* ws; int ph_lo, ph_hi; };

__device__ __forceinline__ void stagger_start(int nwg, int G, int c, unsigned ticks) {
    const int nmax = (nwg + G - 1) / G, nmine = (c < nwg) ? (nwg - c + G - 1) / G : 0;
    if (nmine < nmax) { const unsigned long long t0 = __builtin_amdgcn_s_memrealtime(); while (__builtin_amdgcn_s_memrealtime() - t0 < ticks) __builtin_amdgcn_s_sleep(16); }
}
#ifndef REPMASK
#define REPMASK 0
#endif
#ifndef DRYMASK
#define DRYMASK 0
#endif
#define DRY(k) ((((DRYMASK) >> (k)) & 1) && rep_ == 0)
#ifndef PROBE_PHASE
#define PROBE_PHASE (-1)
#endif
#define PROBE_MULT 8
#ifndef EXTRA_SYNC
#define EXTRA_SYNC 0
#endif
__global__ void __launch_bounds__(512, 2) fwd_kernel(Params P) {
    extern __shared__ __attribute__((aligned(16))) unsigned char lds_raw[];
    LAS unsigned char* lds = (LAS unsigned char*)lds_raw;
    {   volatile LAS unsigned* bst0 = (volatile LAS unsigned*)(lds + LDS_ST_OFF);
        if (threadIdx.x < 16) bst0[threadIdx.x] = 0u;
        __syncthreads();
        (void)xcd_barrier_post((unsigned*)(P.ws + WS_BAR), bst0); }
#define GRID_SYNC() do { unsigned* bp_ = (unsigned*)(P.ws + WS_BAR); asm volatile("" : "+s"(bp_)); XcdBarrier b_; b_.bar = bp_; b_.x = xb_xcc_id(); b_.st = (volatile LAS unsigned*)(lds + LDS_ST_OFF); b_.t0 = (wave == 0) && (pg8::lane_id() == 0); xcd_barrier(b_); } while (0)
#define LANE_OPAQUE int ln_ = pg8::lane_id(); asm volatile("" : "+v"(ln_)); const int tid_ = wave * 64 + ln_; (void)tid_
#define WSP(T, off) ((T*)(ws + (off)))
#define MODL (WSP(const float, WS_MOD) + (size_t)ly * 9 * MODW)
#define XL ((ly == 0) ? P.in[0] : (const float*)P.out)
#define CL ((ly == 0) ? P.in[2] : WSP(const float, WS_CTX))
#define MROWS ((ly == 0) ? MALL : MLAT)
    const int ph_hi = P.ph_hi;
    const int wave = __builtin_amdgcn_readfirstlane(threadIdx.x >> 6);
#pragma unroll 1
    for (int ph = P.ph_lo; ph < ph_hi; ++ph) {
        int phv = ph; asm volatile("" : "+s"(phv));
        const __attribute__((address_space(4))) Params* pp_ = (const __attribute__((address_space(4))) Params*)__builtin_amdgcn_kernarg_segment_ptr(); asm volatile("" : "+s"(pp_));
#define P (*pp_)
        int kind = 0, ly = 0;
        if (phv >= 1) { const int idx = phv - 1; if (idx < 7) { kind = idx + 2 + (idx >= 4 ? 1 : 0); } else { const int j = idx - 7; ly = 1; kind = j + 2 + (j >= 4 ? 1 : 0); } }
        int G_ = gridDim.x, bx_ = blockIdx.x; asm volatile("" : "+s"(G_), "+s"(bx_));
        const int G = G_, bx = bx_; const int vcu = (G % 8 == 0) ? (bx % 8) * (G / 8) + bx / 8 : bx; const int gw = vcu * 8 + wave, ngw = G * 8;
        unsigned char* ws = P.ws;
        if (PROBE_PHASE >= 0 && ph == PROBE_PHASE && blockIdx.x == 0 && wave == 0 && pg8::lane_id() == 0) { const unsigned long long t_ = __builtin_amdgcn_s_memrealtime(); volatile LAS unsigned* pw_ = (volatile LAS unsigned*)(lds + LDS_ST_OFF + 32); pw_[0] = (unsigned)t_; pw_[1] = (unsigned)(t_ >> 32); }
#pragma unroll 1
        for (int rep_ = 0; rep_ <= (((REPMASK | DRYMASK) >> kind) & 1); ++rep_) {
        if (rep_) GRID_SYNC();
        switch (kind) {
        case 0: { LANE_OPAQUE;
            if (bx == G - 1) {
                LAS unsigned* red = (LAS unsigned*)lds;
                if (tid_ < 16) red[tid_] = 0u;
                __syncthreads();
                for (int l2 = 0; l2 < 2; ++l2) {
                    if (tid_ < 256) { const int k = tid_ >> 6, d = tid_ & 63; const float* src = P.in[k == 0 ? 9 : k == 1 ? 10 : k == 2 ? 14 : 15]; atomicMax((unsigned*)(red + l2 * 5 + k), __builtin_bit_cast(unsigned, fabsf(src[l2 * 64 + d]))); }
                    for (int i = tid_; i < 4 * 15 * 31; i += 512) atomicMax((unsigned*)(red + l2 * 5 + 4), __builtin_bit_cast(unsigned, fabsf(P.in[11][(size_t)l2 * 4 * 15 * 31 + i])));
                }
                __syncthreads();
                if (tid_ < 2) { const int l2 = tid_; const float gq = __builtin_bit_cast(float, red[l2 * 5 + 0]), gk = __builtin_bit_cast(float, red[l2 * 5 + 1]), wq = __builtin_bit_cast(float, red[l2 * 5 + 2]), wk = __builtin_bit_cast(float, red[l2 * 5 + 3]), rb = __builtin_bit_cast(float, red[l2 * 5 + 4]);
                    WSP(float, WS_GAIN)[512 + 2 * l2] = 11.5416f * gq * gk + rb * LOG2E + 0.25f; WSP(float, WS_GAIN)[512 + 2 * l2 + 1] = 11.5416f * wq * wk + 0.25f; }
                __syncthreads();
            }
            if (bx == G - 1) { for (int i = tid_; i < 512; i += 512) { const int l2 = i >> 8, k = (i >> 6) & 3, d = i & 63; const float* src = P.in[k == 0 ? 9 : k == 1 ? 10 : k == 2 ? 14 : 15]; WSP(float, WS_GAIN)[i] = src[l2 * 64 + d]; } }
            unsigned* modcnt = (unsigned*)(ws + WS_BAR) + 64;
            if (bx < 192) { mod_item(bx, P.in[1], P.in[3], P.in[4], P.in[5], WSP(float, WS_MOD), lds, tid_, wave, ln_);
                asm volatile("s_waitcnt vmcnt(0)" ::: "memory"); __syncthreads();
                if (tid_ == 0) { __builtin_amdgcn_fence(__ATOMIC_RELEASE, "agent"); asm volatile("s_waitcnt vmcnt(0)" ::: "memory"); (void)xb_add(modcnt, 1u); } }
            LAS float* scr = (LAS float*)(lds + wave * 16384);
            constexpr int I_IN = 16 * (INW / 32), I_O = 16 * (DM / 32), I_1 = 16 * (FFN / 32), I_2 = 64 * (DM / 32), I_L = I_IN + I_O + I_1 + I_2;
            const bool bal_ = (G == 256); const int it0 = bal_ ? ((bx < 192) ? 33 * bx : 6336 + 81 * (bx - 192)) + wave : gw, it1 = bal_ ? ((bx < 192) ? 33 * bx + 33 : 6336 + 81 * (bx - 192) + 81) : 2 * I_L, its = bal_ ? 8 : ngw;
            static_assert(192 * 33 + 64 * 81 == 2 * I_L, "transpose item split");
            for (int it = it0; it < it1; it += its) {
                const int l2 = it / I_L; int r = it - l2 * I_L;
                if (r < I_IN) { transpose_item<true>(P.in[8] + (size_t)l2 * DM * INW, DM, INW, WSP(bf16_t, WS_WIN) + (size_t)l2 * INW * DM, scr, r, ln_); continue; } r -= I_IN;
                if (r < I_O) { transpose_item<false>(P.in[18] + (size_t)l2 * DM * DM, DM, DM, WSP(bf16_t, WS_WO) + (size_t)l2 * DM * DM, scr, r, ln_); continue; } r -= I_O;
                if (r < I_1) { transpose_item<false>(P.in[19] + (size_t)l2 * DM * FFN, DM, FFN, WSP(bf16_t, WS_W1) + (size_t)l2 * FFN * DM, scr, r, ln_); continue; } r -= I_1;
                transpose_item<false>(P.in[20] + (size_t)l2 * FFN * DM, FFN, DM, WSP(bf16_t, WS_W2) + (size_t)l2 * DM * FFN, scr, r, ln_);
            }
            if (tid_ == 0) { const unsigned want = (unsigned)min(192, G); unsigned sp_ = 0u;
                while (xb_ld(modcnt) < want) { __builtin_amdgcn_s_sleep(2); if (++sp_ > (1u << 22)) break; }
                __builtin_amdgcn_fence(__ATOMIC_ACQUIRE, "agent"); asm volatile("s_waitcnt vmcnt(0)" ::: "memory"); }
            __syncthreads();
            for (int it = bx; it < 200; it += G) { const int l2 = it / 100, c = it % 100; const float* m2 = WSP(const float, WS_MOD) + (size_t)l2 * 9 * MODW;
                if (c < 36) bias_item<true>(P.in[8] + (size_t)l2 * DM * INW, INW, c * 64, m2, WSP(float, WS_BIN) + (size_t)l2 * 9 * INW, lds, tid_, wave, ln_);
                else bias_item<false>(P.in[19] + (size_t)l2 * DM * FFN, FFN, (c - 36) * 64, m2 + 3 * DM, WSP(float, WS_B1) + (size_t)l2 * 9 * FFN, lds, tid_, wave, ln_); }
            if (G == 256) { const int rb = (bx < 200) ? 59 * bx : min(MALL, 11800 + 119 * (bx - 200)), re = (bx < 200) ? rb + 59 : min(MALL, rb + 119);
                prep_pass(P.in[0], P.in[2], P.in[6], WSP(const float, WS_MOD), DM, WSP(bf16_t, WS_HN2), WSP(float, WS_RS1), rb + wave, re, 8, ln_); }
            else prep_pass(P.in[0], P.in[2], P.in[6], WSP(const float, WS_MOD), DM, WSP(bf16_t, WS_HN2), WSP(float, WS_RS1), gw, MALL, ngw, ln_);
        } break;
        case 2: { LANE_OPAQUE;
            pg8::Gemm g{WSP(bf16_t, WS_HN2), WSP(bf16_t, WS_WIN) + (size_t)ly * INW * DM, MALL, INW, DM}; pg8::StaticOrder S; S.init(MALL, INW, G, bx);
            pg8::EpiProj E{WSP(bf16_t, WS_PROJ), WSP(const float, WS_GAIN) + ly * 256, WSP(const float, WS_RS1), WSP(const float, WS_BIN) + (size_t)ly * 9 * INW};
            pg8::gemm_phase<pg8::EpiProj, pg8::StaticOrder, true, true>(lds, g, S, E, wave);
        } break;
        case 3: { LANE_OPAQUE;
            att::attn_phase(lds + wave * att::WAVE_LDS + 256, WSP(bf16_t, WS_PROJ), WSP(bf16_t, WS_OB), P.in[11] + (size_t)ly * 4 * 15 * 31, P.in[16] + ly * 8, WSP(const float, WS_GAIN) + 512 + 2 * ly, ly == 0, gw, ngw, ln_);
        } break;
        case 4: { LANE_OPAQUE;
            mix_pass(WSP(bf16_t, WS_PROJ), WSP(bf16_t, WS_OB), P.in[12] + (size_t)ly * 3 * 256, P.in[13] + ly * 256, P.in[17] + ly * DM, WSP(bf16_t, WS_HN), MROWS, gw, ngw, ln_);
        } break;
        case 5: { LANE_OPAQUE;
            pg8::Gemm g{WSP(bf16_t, WS_HN), WSP(bf16_t, WS_WO) + (size_t)ly * DM * DM, MROWS, DM, DM}; pg8::StaticOrder S; S.init(MROWS, DM, G, bx);
            pg8::EpiResid E{XL, CL, P.out, WSP(float, WS_CTX), MODL + 2 * DM, WSP(bf16_t, WS_HN2), P.in[7] + ly * DM, MODL + 4 * DM, WSP(float, WS_RS2), DRY(5), nullptr, false};
            pg8::gemm_phase<pg8::EpiResid, pg8::StaticOrder, true, true>(lds, g, S, E, wave);
        } break;
        case 7: { LANE_OPAQUE;
            pg8::Gemm g{WSP(bf16_t, WS_HN2), WSP(bf16_t, WS_W1) + (size_t)ly * FFN * DM, MROWS, FFN, DM}; pg8::StaticOrder S; S.init(MROWS, FFN, G, bx);
            pg8::EpiFc1 E{WSP(bf16_t, WS_H1), FFN, WSP(const float, WS_RS2), WSP(const float, WS_B1) + (size_t)ly * 9 * FFN};
            pg8::gemm_phase<pg8::EpiFc1, pg8::StaticOrder, true, true>(lds, g, S, E, wave);
        } break;
        case 8: { LANE_OPAQUE;
            pg8::Gemm g{WSP(bf16_t, WS_H1), WSP(bf16_t, WS_W2) + (size_t)ly * DM * FFN, MROWS, DM, FFN};
            if (ly == 0) {
                pg8::SplitOrder S; S.init(G, bx);
                pg8::EpiResid E{P.out, WSP(float, WS_CTX), P.out, WSP(float, WS_CTX), MODL + 5 * DM, WSP(bf16_t, WS_HN2), P.in[6] + DM, WSP(const float, WS_MOD) + (size_t)9 * MODW + DM, WSP(float, WS_RS1), DRY(8), (float*)ws, true};
                pg8::gemm_phase<pg8::EpiResid, pg8::SplitOrder, true, true>(lds, g, S, E, wave);
            } else {
                pg8::StaticOrder S; S.init(MROWS, DM, G, bx);
                pg8::EpiResid E{P.out, WSP(float, WS_CTX), P.out, WSP(float, WS_CTX), MODL + 5 * DM, (bf16_t*)nullptr, nullptr, nullptr, nullptr, DRY(8), nullptr, false};
                pg8::gemm_phase<pg8::EpiResid, pg8::StaticOrder, true, true>(lds, g, S, E, wave);
            }
        } break;
        default: { LANE_OPAQUE;
            ctx_rows_pass(ws, WSP(const float, WS_CTX), WSP(const float, WS_MOD) + (size_t)8 * MODW + 5 * DM, P.in[6] + DM, WSP(const float, WS_MOD) + (size_t)(9 + 8) * MODW + DM, WSP(bf16_t, WS_HN2), WSP(float, WS_RS1), gw, ngw, ln_);
        } break;
        }
        }
        for (int es_ = 0; es_ < EXTRA_SYNC; ++es_) GRID_SYNC();
        if (ph + 1 < ph_hi) GRID_SYNC();
        if (PROBE_PHASE >= 0 && ph == PROBE_PHASE && blockIdx.x == 0 && wave == 0 && pg8::lane_id() == 0) { const unsigned long long t_ = __builtin_amdgcn_s_memrealtime(); volatile LAS unsigned* pw_ = (volatile LAS unsigned*)(lds + LDS_ST_OFF + 32); pw_[2] = (unsigned)t_; pw_[3] = (unsigned)(t_ >> 32); }
#undef P
    }
    if (PROBE_PHASE >= 0 && blockIdx.x == 0 && wave == 0 && pg8::lane_id() == 0) {
        volatile LAS unsigned* pw_ = (volatile LAS unsigned*)(lds + LDS_ST_OFF + 32);
        const unsigned long long a_ = ((unsigned long long)pw_[1] << 32) | pw_[0], b_ = ((unsigned long long)pw_[3] << 32) | pw_[2];
        const unsigned long long span_ = (b_ - a_) * PROBE_MULT; const unsigned long long t0_ = __builtin_amdgcn_s_memrealtime();
        if (span_ < 100000000ull) while (__builtin_amdgcn_s_memrealtime() - t0_ < span_) __builtin_amdgcn_s_sleep(8);
    }
}

#ifndef MK_MULTI_LAUNCH
#define MK_MULTI_LAUNCH 0
#endif
extern "C" void kernel_launch(void* const* d_in, const int* in_sizes, int n_in, void* d_out, int out_size, void* d_ws, size_t ws_size, hipStream_t stream) {
    static int grid = 0;
    if (grid == 0) {
        if (n_in != 21 || out_size != MLAT * DM || ws_size < WS_END) { fprintf(stderr, "kernel_launch: unexpected shapes (n_in %d out %d ws %zu)\n", n_in, out_size, ws_size); grid = -1; return; }
        int dev = 0, cus = 0, per_cu = 0;
        if (hipGetDevice(&dev) != hipSuccess || hipDeviceGetAttribute(&cus, hipDeviceAttributeMultiprocessorCount, dev) != hipSuccess) { grid = -1; return; }
        if (hipFuncSetAttribute((const void*)fwd_kernel, hipFuncAttributeMaxDynamicSharedMemorySize, LDS_BYTES) != hipSuccess) { fprintf(stderr, "kernel_launch: hipFuncSetAttribute failed\n"); grid = -1; return; }
        if (hipOccupancyMaxActiveBlocksPerMultiprocessor(&per_cu, (const void*)fwd_kernel, 512, LDS_BYTES) != hipSuccess || per_cu < 1) { fprintf(stderr, "kernel_launch: occupancy query gave %d\n", per_cu); (void)hipGetLastError(); grid = -1; return; }
        grid = cus * per_cu;
    }
    if (grid < 0) return;
    Params p{};
    for (int i = 0; i < 21; ++i) p.in[i] = (const float*)d_in[i];
    p.out = (float*)d_out; p.ws = (unsigned char*)d_ws;
    if (hipMemsetAsync((char*)d_ws + WS_BAR, 0, XCD_BAR_WORDS * 4, stream) != hipSuccess) { fprintf(stderr, "kernel_launch: memset of the barrier words failed\n"); return; }
    void* args[] = {&p};
#if MK_MULTI_LAUNCH
    for (int ph = 0; ph < N_PHASES; ++ph) { p.ph_lo = ph; p.ph_hi = ph + 1;
        hipError_t e = hipLaunchCooperativeKernel((const void*)fwd_kernel, dim3(grid), dim3(512), args, LDS_BYTES, stream);
        if (e != hipSuccess) { fprintf(stderr, "launch %d failed: %s\n", ph, hipGetErrorString(e)); break; } }
#else
    p.ph_lo = 0; p.ph_hi = N_PHASES;
    hipError_t e = hipLaunchCooperativeKernel((const void*)fwd_kernel, dim3(grid), dim3(512), args, LDS_BYTES, stream);
    if (e != hipSuccess) fprintf(stderr, "cooperative launch failed: %s (grid %d)\n", hipGetErrorString(e), grid);
#endif
}
```
